# Optimizing an MI355X kernel written in HIP

```python
import math
import jax
import jax.numpy as jnp
from jax import lax
import numpy as np

D_MODEL = 1024
BATCH = 1
SEQ = 16384
DEPTH = 2

MEM_LEN = 256
LN_EPS = 1e-5
DN_ALPHA = (2 * DEPTH) ** 0.25
DN_BETA = (8 * DEPTH) ** -0.25

GLA_HEADS = 4
GLA_DK = D_MODEL // 16
GLA_DV = D_MODEL // 8
GLA_QK = GLA_HEADS * GLA_DK
GLA_V = GLA_HEADS * GLA_DV
GLA_LR = 16
GLA_TAU = 16.0
GLA_CHUNK = 64

RWKV_HD = 64
RWKV_HEADS = D_MODEL // 2 // RWKV_HD
RWKV_D = RWKV_HEADS * RWKV_HD
RWKV_W_LR = 64
RWKV_A_LR = 64
RWKV_G_LR = 128
RWKV_COLS = 3 * RWKV_D + RWKV_W_LR + RWKV_A_LR + RWKV_G_LR
RWKV_DECAY_SCALE = math.exp(-0.5)
RWKV_GN_EPS = 64e-5

EVEN_WIDTHS = (GLA_QK, GLA_QK, GLA_V, GLA_V, GLA_LR, RWKV_COLS)
EVEN_IN = sum(EVEN_WIDTHS)
EVEN_OUT = GLA_V + RWKV_D

SSD_HD = 64
SSD_HEADS = D_MODEL // SSD_HD
SSD_INNER = SSD_HEADS * SSD_HD
SSD_GROUPS = 2
SSD_STATE = 128
SSD_BC = SSD_GROUPS * SSD_STATE
SSD_CONV = 4
SSD_CONV_CH = SSD_INNER + 2 * SSD_BC
SSD_CHUNK = 128

MOBA_HD = 64
MOBA_HEADS = 8
MOBA_D = MOBA_HEADS * MOBA_HD
MOBA_BLOCK = 256
MOBA_TOPK = 3
MOBA_QBLOCK = 128

ODD_WIDTHS = (SSD_INNER, SSD_CONV_CH, SSD_HEADS, MOBA_D, MOBA_D, MOBA_D)
ODD_IN = sum(ODD_WIDTHS)
ODD_OUT = SSD_INNER + MOBA_D

XATTN_HEADS = 4
XATTN_HD = D_MODEL // XATTN_HEADS

D_FF = 2816
N_EXPERTS = 8
TOP_K = 2
EXPERT_FF = 2816
MOE_BLOCK = 128

kernel_name = 'hybrid_gla_rwkv7_ssd_moba_deepnorm'


def _offsets(widths):
    return [int(v) for v in np.cumsum(widths)[:-1]]


def layer_norm(x, g, b):
    xf = x.astype(jnp.float32)
    mu = jnp.mean(xf, -1, keepdims=True)
    var = jnp.mean(jnp.square(xf - mu), -1, keepdims=True)
    return ((xf - mu) * lax.rsqrt(var + LN_EPS) * g + b).astype(x.dtype)


def rms_norm(x, g, eps):
    xf = x.astype(jnp.float32)
    return xf * lax.rsqrt(jnp.mean(jnp.square(xf), -1, keepdims=True) + eps) * g


def post_norm(x, f, g, b):
    return layer_norm(DN_ALPHA * x + f, g, b)


def token_shift(p):
    return jnp.pad(p[:, :-1], ((0, 0), (1, 0), (0, 0)))


def alibi_slopes(n):
    return jnp.exp2(-8.0 * jnp.arange(1, n + 1, dtype=jnp.float32) / n)


def causal_depthwise_conv(x, w, b):
    K, C = w.shape
    y = lax.conv_general_dilated(x, w[:, None, :].astype(x.dtype), window_strides=(1,),
                                 padding=[(K - 1, 0)], dimension_numbers=('NWC', 'WIO', 'NWC'),
                                 feature_group_count=C)
    return y + b


def segsum_exp(a):
    L = a.shape[-1]
    cs = jnp.cumsum(a, -1)
    mask = jnp.tril(jnp.ones((L, L), bool))
    return jnp.exp(jnp.where(mask, cs[..., :, None] - cs[..., None, :], -jnp.inf))


def gla_mixer(q, k, v, g, a_lr, wa2, ba, norm_g):
    Bsz, S, _ = q.shape
    H, dk, dv, C = GLA_HEADS, GLA_DK, GLA_DV, GLA_CHUNK
    nc = S // C
    log_a = jax.nn.log_sigmoid((a_lr @ wa2 + ba).astype(jnp.float32)) / GLA_TAU

    def chunks(t, d):
        return t.reshape(Bsz, nc, C, H, d).transpose(0, 3, 1, 2, 4).astype(jnp.float32)

    qc = chunks(q, dk) * dk ** -0.5
    kc = chunks(k, dk)
    vc = chunks(v, dv)
    b = jnp.cumsum(chunks(log_a, dk), axis=3)
    b_last = b[:, :, :, -1:, :]
    q_dec = qc * jnp.exp(b)
    k_dec = kc * jnp.exp(-b)
    causal = jnp.tril(jnp.ones((C, C), bool))
    attn = jnp.where(causal, jnp.einsum('bhnid,bhnjd->bhnij', q_dec, k_dec), 0.0)
    o_intra = jnp.einsum('bhnij,bhnjv->bhniv', attn, vc)
    kv_chunk = jnp.einsum('bhncd,bhncv->bhndv', kc * jnp.exp(b_last - b), vc)
    decay_chunk = jnp.exp(b_last[:, :, :, 0, :])

    def step(state, inp):
        dec, kv = inp
        return dec[..., None] * state + kv, state

    init = jnp.zeros((Bsz, H, dk, dv), jnp.float32)
    _, s_prev = lax.scan(step, init, (jnp.moveaxis(decay_chunk, 2, 0), jnp.moveaxis(kv_chunk, 2, 0)))
    s_prev = jnp.moveaxis(s_prev, 0, 2)
    o = o_intra + jnp.einsum('bhncd,bhndv->bhncv', q_dec, s_prev)
    o = o.transpose(0, 2, 3, 1, 4).reshape(Bsz, S, H, dv)
    o = rms_norm(o, norm_g.reshape(H, dv), 1e-5)
    o = o * jax.nn.silu(g.astype(jnp.float32).reshape(Bsz, S, H, dv))
    return o.reshape(Bsz, S, H * dv)


def rwkv7_mixer(p, mu, w0, w2, a0, a2, g2, k_k, k_a, r_k, ln_w, ln_b):
    Bsz, S, _ = p.shape
    H, N, D = RWKV_HEADS, RWKV_HD, RWKV_D
    p = p.astype(jnp.float32)
    p = p + mu * (token_shift(p) - p)
    r, k, v, xw, xa, xg = jnp.split(p, _offsets((D, D, D, RWKV_W_LR, RWKV_A_LR, RWKV_G_LR)), axis=-1)
    log_w = -RWKV_DECAY_SCALE * jax.nn.sigmoid(w0 + jnp.tanh(xw) @ w2)
    a = jax.nn.sigmoid(a0 + xa @ a2)
    g = jax.nn.sigmoid(xg) @ g2

    def heads(t):
        return t.reshape(Bsz, S, H, N)

    kk = heads(k * k_k)
    kk = kk * lax.rsqrt(jnp.maximum(jnp.sum(kk * kk, -1, keepdims=True), 1e-24))
    k = k * (1.0 + (a - 1.0) * k_a)
    r_h, w_h, k_h, v_h, a_h = heads(r), jnp.exp(heads(log_w)), heads(k), heads(v), heads(a)

    def step(state, inp):
        r_t, w_t, k_t, v_t, kk_t, a_t = inp
        sk = jnp.einsum('bhvk,bhk->bhv', state, kk_t)
        state = (state * w_t[:, :, None, :]
                 - sk[..., None] * (kk_t * a_t)[:, :, None, :]
                 + v_t[..., None] * k_t[:, :, None, :])
        return state, jnp.einsum('bhvk,bhk->bhv', state, r_t)

    xs = tuple(jnp.moveaxis(t, 1, 0) for t in (r_h, w_h, k_h, v_h, kk, a_h))
    _, o = lax.scan(step, jnp.zeros((Bsz, H, N, N), jnp.float32), xs)
    o = jnp.moveaxis(o, 0, 1)
    mean = jnp.mean(o, -1, keepdims=True)
    var = jnp.mean(jnp.square(o - mean), -1, keepdims=True)
    o = (o - mean) * lax.rsqrt(var + RWKV_GN_EPS) * ln_w.reshape(H, N) + ln_b.reshape(H, N)
    bonus = jnp.sum(r_h * k_h * r_k.reshape(H, N), -1, keepdims=True) * v_h
    return (o + bonus).reshape(Bsz, S, D) * g


def ssd_scan(x, dt, A, Bm, Cm):
    Bsz, S, H, P = x.shape
    G, N = Bm.shape[2], Bm.shape[3]
    HG = H // G
    L = SSD_CHUNK
    nc = S // L
    xd = (x * dt[..., None]).reshape(Bsz, nc, L, G, HG, P)
    a = (dt * A).reshape(Bsz, nc, L, G, HG).transpose(0, 3, 4, 1, 2)
    Bc = Bm.reshape(Bsz, nc, L, G, N)
    Cc = Cm.reshape(Bsz, nc, L, G, N)
    a_cs = jnp.cumsum(a, -1)
    cb = jnp.einsum('bclgn,bcsgn->bgcls', Cc, Bc)
    y_diag = jnp.einsum('bgcls,bghcls,bcsghp->bclghp', cb, segsum_exp(a), xd)
    decay_states = jnp.exp(a_cs[..., -1:] - a_cs)
    states = jnp.einsum('bcsgn,bghcs,bcsghp->bcghpn', Bc, decay_states, xd)
    chunk_decay = jnp.exp(a_cs[..., -1])

    def step(h, inp):
        dec, st = inp
        return dec[..., None, None] * h + st, h

    init = jnp.zeros((Bsz, G, HG, P, N), jnp.float32)
    _, prev = lax.scan(step, init, (jnp.moveaxis(chunk_decay, 3, 0), jnp.moveaxis(states, 1, 0)))
    prev = jnp.moveaxis(prev, 0, 1)
    y_off = jnp.einsum('bclgn,bcghpn,bghcl->bclghp', Cc, prev, jnp.exp(a_cs))
    return (y_diag + y_off).reshape(Bsz, S, H, P)


def ssd_mixer(z, xbc, dt_raw, conv_w, conv_b, dt_bias, a_log, d_skip, norm_g):
    Bsz, S, _ = z.shape
    xbc = jax.nn.silu(causal_depthwise_conv(xbc, conv_w, conv_b)).astype(jnp.float32)
    xs, Bm, Cm = jnp.split(xbc, [SSD_INNER, SSD_INNER + SSD_BC], axis=-1)
    x_h = xs.reshape(Bsz, S, SSD_HEADS, SSD_HD)
    dt = jax.nn.softplus(dt_raw.astype(jnp.float32) + dt_bias.astype(jnp.float32))
    A = -jnp.exp(a_log.astype(jnp.float32))
    y = ssd_scan(x_h, dt, A, Bm.reshape(Bsz, S, SSD_GROUPS, SSD_STATE), Cm.reshape(Bsz, S, SSD_GROUPS, SSD_STATE))
    y = y + d_skip.astype(jnp.float32)[:, None] * x_h
    y = y.reshape(Bsz, S, SSD_INNER) * jax.nn.silu(z.astype(jnp.float32))
    y = rms_norm(y.reshape(Bsz, S, SSD_GROUPS, SSD_INNER // SSD_GROUPS),
                 norm_g.reshape(SSD_GROUPS, SSD_INNER // SSD_GROUPS), 1e-5)
    return y.reshape(Bsz, S, SSD_INNER)


def moba_attention(q, k, v):
    Bsz, S, _ = q.shape
    H, dh, BS, QB, K = MOBA_HEADS, MOBA_HD, MOBA_BLOCK, MOBA_QBLOCK, MOBA_TOPK
    nb = max(-(-S // BS), K + 1)
    pad = nb * BS - S

    def heads(t):
        return t.reshape(Bsz, S, H, dh).transpose(0, 2, 1, 3).astype(jnp.float32)

    qh = heads(q) * dh ** -0.5
    kb = jnp.pad(heads(k), ((0, 0), (0, 0), (0, pad), (0, 0))).reshape(Bsz, H, nb, BS, dh)
    vb = jnp.pad(heads(v), ((0, 0), (0, 0), (0, pad), (0, 0))).reshape(Bsz, H, nb, BS, dh)
    kmean = jnp.mean(kb, axis=3)
    slopes = alibi_slopes(H)
    gather = jax.vmap(jax.vmap(lambda blocks, idx: blocks[idx]))

    def query_block(qi):
        q_blk = lax.dynamic_slice_in_dim(qh, qi * QB, QB, axis=2)
        own = (qi * QB) // BS
        t_pos = qi * QB + jnp.arange(QB)
        gate = jnp.einsum('bhqd,bhnd->bhqn', q_blk, kmean)
        gate = jnp.where(jnp.arange(nb) < own, gate, -jnp.inf)
        _, sel = lax.top_k(gate, K)
        valid = jnp.arange(K) < own
        k_sel = gather(kb, sel)
        v_sel = gather(vb, sel)
        s_pos = sel[..., None] * BS + jnp.arange(BS)
        dist_sel = (t_pos[:, None, None] - s_pos).astype(jnp.float32)
        s_sel = jnp.einsum('bhqd,bhqjkd->bhqjk', q_blk, k_sel) - slopes[:, None, None, None] * dist_sel
        s_sel = jnp.where(valid[:, None], s_sel, -jnp.inf)
        k_own = lax.dynamic_index_in_dim(kb, own, axis=2, keepdims=False)
        v_own = lax.dynamic_index_in_dim(vb, own, axis=2, keepdims=False)
        dist_own = t_pos[:, None] - (own * BS + jnp.arange(BS))[None, :]
        s_own = jnp.einsum('bhqd,bhkd->bhqk', q_blk, k_own) - slopes[:, None, None] * dist_own.astype(jnp.float32)
        s_own = jnp.where(dist_own >= 0, s_own, -jnp.inf)
        logits = jnp.concatenate([s_own, s_sel.reshape(Bsz, H, QB, K * BS)], axis=-1)
        prob = jax.nn.softmax(logits, axis=-1)
        p_own = prob[..., :BS]
        p_sel = prob[..., BS:].reshape(Bsz, H, QB, K, BS)
        return (jnp.einsum('bhqk,bhkd->bhqd', p_own, v_own)
                + jnp.einsum('bhqjk,bhqjkd->bhqd', p_sel, v_sel))

    out = lax.map(query_block, jnp.arange(S // QB))
    return out.transpose(1, 0, 3, 2, 4).reshape(Bsz, S, H * dh)


def gla_rwkv_mixer(h, w_in, gla_wa2, gla_ba, gla_norm, rwkv_mu, rwkv_w0, rwkv_w2, rwkv_a0, rwkv_a2,
                   rwkv_g2, rwkv_kk, rwkv_ka, rwkv_rk, rwkv_lnw, rwkv_lnb, w_out):
    p = h @ w_in
    q, k, v, g, a_lr, p_rwkv = jnp.split(p, _offsets(EVEN_WIDTHS), axis=-1)
    o_gla = gla_mixer(q, k, v, g, a_lr, gla_wa2, gla_ba, gla_norm)
    o_rwkv = rwkv7_mixer(p_rwkv, rwkv_mu, rwkv_w0, rwkv_w2, rwkv_a0, rwkv_a2, rwkv_g2,
                         rwkv_kk, rwkv_ka, rwkv_rk, rwkv_lnw, rwkv_lnb)
    return jnp.concatenate([o_gla, o_rwkv], axis=-1).astype(h.dtype) @ w_out


def ssd_moba_mixer(h, w_in, conv_w, conv_b, dt_bias, a_log, d_skip, ssd_norm, w_out):
    p = h @ w_in
    z, xbc, dt_raw, mq, mk, mv = jnp.split(p, _offsets(ODD_WIDTHS), axis=-1)
    o_ssd = ssd_mixer(z, xbc, dt_raw, conv_w, conv_b, dt_bias, a_log, d_skip, ssd_norm)
    o_moba = moba_attention(mq, mk, mv)
    return jnp.concatenate([o_ssd, o_moba], axis=-1).astype(h.dtype) @ w_out


def memory_cross_attention(x, mem, wq, wk, wv, wo):
    Bsz, S, _ = x.shape
    M = mem.shape[1]
    q = (x @ wq).reshape(Bsz, S, XATTN_HEADS, XATTN_HD)
    k = (mem @ wk).reshape(Bsz, M, XATTN_HEADS, XATTN_HD)
    v = (mem @ wv).reshape(Bsz, M, XATTN_HEADS, XATTN_HD)
    s = jnp.einsum('bshd,bmhd->bhsm', q, k).astype(jnp.float32) * XATTN_HD ** -0.5
    prob = jax.nn.softmax(s, axis=-1).astype(v.dtype)
    o = jnp.einsum('bhsm,bmhd->bshd', prob, v).reshape(Bsz, S, D_MODEL)
    return o @ wo


def swiglu(h, wg, wu, wd):
    return (jax.nn.silu(h @ wg) * (h @ wu)) @ wd


def moe_swiglu(x, w_router, b_router, wg, wu, wd):
    Bsz, S, D = x.shape
    T = Bsz * S
    xt = x.reshape(T, D)
    logits = (xt @ w_router).astype(jnp.float32) + b_router.astype(jnp.float32)
    top_logit, top_e = lax.top_k(logits, TOP_K)
    gates = jax.nn.softmax(top_logit, axis=-1)
    flat_e = top_e.reshape(-1)
    flat_tok = jnp.repeat(jnp.arange(T, dtype=jnp.int32), TOP_K)
    flat_gate = gates.reshape(-1)
    order = jnp.argsort(flat_e)
    se = flat_e[order]
    counts = jnp.bincount(flat_e, length=N_EXPERTS)
    padded = (counts + MOE_BLOCK - 1) // MOE_BLOCK * MOE_BLOCK
    start = jnp.cumsum(counts) - counts
    pend = jnp.cumsum(padded)
    pstart = pend - padded
    dest = pstart[se] + jnp.arange(T * TOP_K) - start[se]
    n_rows = T * TOP_K + N_EXPERTS * MOE_BLOCK
    n_blocks = n_rows // MOE_BLOCK
    row_tok = jnp.full((n_rows,), T, jnp.int32).at[dest].set(flat_tok[order])
    row_gate = jnp.zeros((n_rows,), jnp.float32).at[dest].set(flat_gate[order])
    block_e = jnp.minimum(jnp.searchsorted(pend, jnp.arange(n_blocks) * MOE_BLOCK, side='right'), N_EXPERTS - 1)
    x_rows = jnp.take(xt, row_tok, axis=0, mode='fill', fill_value=0).reshape(n_blocks, MOE_BLOCK, D)

    def expert_block(args):
        xb, e = args
        return (jax.nn.silu(xb @ wg[e]) * (xb @ wu[e])) @ wd[e]

    y_rows = lax.map(expert_block, (x_rows, block_e)).reshape(n_rows, D)
    y = jnp.zeros((T, D), jnp.float32).at[row_tok].add(y_rows.astype(jnp.float32) * row_gate[:, None], mode='drop')
    return y.reshape(Bsz, S, D).astype(x.dtype)


def setup_inputs(seed: int = 0) -> dict:
    key = jax.random.key(seed)
    keys = iter(jax.random.split(key, 96))

    def normal(shape, scale):
        return jax.random.normal(next(keys), shape, jnp.float32) * scale

    def gain(n):
        return 1.0 + normal((n,), 0.02)

    d = D_MODEL
    inp = {}
    inp['x'] = normal((BATCH, SEQ, d), 1.0)
    inp['mem'] = normal((BATCH, MEM_LEN, d), 1.0)
    inp['l0_w_in'] = normal((d, EVEN_IN), d ** -0.5)
    inp['l0_gla_wa2'] = normal((GLA_LR, GLA_QK), GLA_LR ** -0.5)
    inp['l0_gla_ba'] = normal((GLA_QK,), 0.1)
    inp['l0_gla_norm'] = gain(GLA_V)
    inp['l0_rwkv_mu'] = jax.random.uniform(next(keys), (RWKV_COLS,), jnp.float32)
    inp['l0_rwkv_w0'] = normal((RWKV_D,), 0.5)
    inp['l0_rwkv_w2'] = normal((RWKV_W_LR, RWKV_D), 0.5 * RWKV_W_LR ** -0.5)
    inp['l0_rwkv_a0'] = normal((RWKV_D,), 0.5)
    inp['l0_rwkv_a2'] = normal((RWKV_A_LR, RWKV_D), 0.5 * RWKV_A_LR ** -0.5)
    inp['l0_rwkv_g2'] = normal((RWKV_G_LR, RWKV_D), RWKV_G_LR ** -0.5)
    inp['l0_rwkv_kk'] = 0.85 + normal((RWKV_D,), 0.02)
    inp['l0_rwkv_ka'] = 1.0 + normal((RWKV_D,), 0.02)
    inp['l0_rwkv_rk'] = normal((RWKV_D,), 0.1)
    inp['l0_rwkv_lnw'] = gain(RWKV_D)
    inp['l0_rwkv_lnb'] = normal((RWKV_D,), 0.02)
    inp['l0_w_out'] = normal((EVEN_OUT, d), EVEN_OUT ** -0.5 * DN_BETA)
    inp['l0_ln1_g'] = gain(d)
    inp['l0_ln1_b'] = normal((d,), 0.02)
    inp['l0_xq'] = normal((d, d), d ** -0.5)
    inp['l0_xk'] = normal((d, d), d ** -0.5)
    inp['l0_xv'] = normal((d, d), d ** -0.5)
    inp['l0_xo'] = normal((d, d), d ** -0.5 * DN_BETA)
    inp['l0_ln2_g'] = gain(d)
    inp['l0_ln2_b'] = normal((d,), 0.02)
    inp['l0_ffn_wg'] = normal((d, D_FF), d ** -0.5)
    inp['l0_ffn_wu'] = normal((d, D_FF), d ** -0.5)
    inp['l0_ffn_wd'] = normal((D_FF, d), D_FF ** -0.5 * DN_BETA)
    inp['l0_ln3_g'] = gain(d)
    inp['l0_ln3_b'] = normal((d,), 0.02)
    inp['l1_w_in'] = normal((d, ODD_IN), d ** -0.5)
    inp['l1_conv_w'] = normal((SSD_CONV, SSD_CONV_CH), SSD_CONV ** -0.5)
    inp['l1_conv_b'] = normal((SSD_CONV_CH,), 0.02)
    dt0 = jnp.exp(jax.random.uniform(next(keys), (SSD_HEADS,), jnp.float32,
                                     minval=math.log(1e-3), maxval=math.log(1e-1)))
    inp['l1_dt_bias'] = dt0 + jnp.log(-jnp.expm1(-dt0))
    inp['l1_a_log'] = jnp.log(jax.random.uniform(next(keys), (SSD_HEADS,), jnp.float32, minval=1.0, maxval=16.0))
    inp['l1_d_skip'] = 1.0 + normal((SSD_HEADS,), 0.1)
    inp['l1_ssd_norm'] = gain(SSD_INNER)
    inp['l1_w_out'] = normal((ODD_OUT, d), ODD_OUT ** -0.5 * DN_BETA)
    inp['l1_ln1_g'] = gain(d)
    inp['l1_ln1_b'] = normal((d,), 0.02)
    inp['l1_xq'] = normal((d, d), d ** -0.5)
    inp['l1_xk'] = normal((d, d), d ** -0.5)
    inp['l1_xv'] = normal((d, d), d ** -0.5)
    inp['l1_xo'] = normal((d, d), d ** -0.5 * DN_BETA)
    inp['l1_ln2_g'] = gain(d)
    inp['l1_ln2_b'] = normal((d,), 0.02)
    inp['l1_router'] = normal((d, N_EXPERTS), d ** -0.5)
    inp['l1_router_b'] = normal((N_EXPERTS,), 0.01)
    inp['l1_exp_wg'] = normal((N_EXPERTS, d, EXPERT_FF), d ** -0.5)
    inp['l1_exp_wu'] = normal((N_EXPERTS, d, EXPERT_FF), d ** -0.5)
    inp['l1_exp_wd'] = normal((N_EXPERTS, EXPERT_FF, d), EXPERT_FF ** -0.5 * DN_BETA)
    inp['l1_ln3_g'] = gain(d)
    inp['l1_ln3_b'] = normal((d,), 0.02)
    return inp


def reference(x, mem,
              l0_w_in, l0_gla_wa2, l0_gla_ba, l0_gla_norm,
              l0_rwkv_mu, l0_rwkv_w0, l0_rwkv_w2, l0_rwkv_a0, l0_rwkv_a2, l0_rwkv_g2,
              l0_rwkv_kk, l0_rwkv_ka, l0_rwkv_rk, l0_rwkv_lnw, l0_rwkv_lnb,
              l0_w_out, l0_ln1_g, l0_ln1_b,
              l0_xq, l0_xk, l0_xv, l0_xo, l0_ln2_g, l0_ln2_b,
              l0_ffn_wg, l0_ffn_wu, l0_ffn_wd, l0_ln3_g, l0_ln3_b,
              l1_w_in, l1_conv_w, l1_conv_b, l1_dt_bias, l1_a_log, l1_d_skip, l1_ssd_norm,
              l1_w_out, l1_ln1_g, l1_ln1_b,
              l1_xq, l1_xk, l1_xv, l1_xo, l1_ln2_g, l1_ln2_b,
              l1_router, l1_router_b, l1_exp_wg, l1_exp_wu, l1_exp_wd, l1_ln3_g, l1_ln3_b):
    token_mixers = (
        lambda h: gla_rwkv_mixer(h, l0_w_in, l0_gla_wa2, l0_gla_ba, l0_gla_norm, l0_rwkv_mu, l0_rwkv_w0,
                                 l0_rwkv_w2, l0_rwkv_a0, l0_rwkv_a2, l0_rwkv_g2, l0_rwkv_kk, l0_rwkv_ka,
                                 l0_rwkv_rk, l0_rwkv_lnw, l0_rwkv_lnb, l0_w_out),
        lambda h: ssd_moba_mixer(h, l1_w_in, l1_conv_w, l1_conv_b, l1_dt_bias, l1_a_log, l1_d_skip,
                                 l1_ssd_norm, l1_w_out),
    )
    cross = ((l0_xq, l0_xk, l0_xv, l0_xo), (l1_xq, l1_xk, l1_xv, l1_xo))
    channel_mixers = (
        lambda h: swiglu(h, l0_ffn_wg, l0_ffn_wu, l0_ffn_wd),
        lambda h: moe_swiglu(h, l1_router, l1_router_b, l1_exp_wg, l1_exp_wu, l1_exp_wd),
    )
    norms = (((l0_ln1_g, l0_ln1_b), (l0_ln2_g, l0_ln2_b), (l0_ln3_g, l0_ln3_b)),
             ((l1_ln1_g, l1_ln1_b), (l1_ln2_g, l1_ln2_b), (l1_ln3_g, l1_ln3_b)))
    for layer in range(DEPTH):
        x = post_norm(x, token_mixers[layer](x), *norms[layer][0])
        x = post_norm(x, memory_cross_attention(x, mem, *cross[layer]), *norms[layer][1])
        x = post_norm(x, channel_mixers[layer](x), *norms[layer][2])
    return x
```

```cpp
#include <hip/hip_runtime.h>
#include <cstdio>
#include <cstdint>
#include <cstddef>

typedef unsigned short bf16;

namespace {
constexpr int M = 16384, D = 1024;
constexpr int NP0 = 3584, NP1 = 4352;
constexpr float ALPHA = 1.4142135623730951f;
constexpr int RMAX = 34816;
constexpr size_t MiB = 1ull << 20;
constexpr size_t WS_CTL = 0, WS_XFA = 1 * MiB, WS_XB = 65 * MiB, WS_P = 97 * MiB, WS_OMIX = 233 * MiB, WS_SCR = 281 * MiB, WS_END = 433 * MiB;

__device__ __forceinline__ float bf2f(bf16 v) { return __uint_as_float(((unsigned)v) << 16); }
__device__ __forceinline__ bf16 f2bf(float f) { unsigned u = __float_as_uint(f); u += 0x7fffu + ((u >> 16) & 1u); return (bf16)(u >> 16); }
__device__ __forceinline__ float sigm(float x) { return 1.f / (1.f + expf(-x)); }
__device__ __forceinline__ float siluf(float x) { return x * sigm(x); }
__device__ __forceinline__ float wave_sum(float v) {
#pragma unroll
    for (int o = 1; o < 64; o <<= 1) v += __shfl_xor(v, o);
    return v;
}
__device__ __forceinline__ float wave_max(float v) {
#pragma unroll
    for (int o = 1; o < 64; o <<= 1) v = fmaxf(v, __shfl_xor(v, o));
    return v;
}

struct ALBf { const bf16* A; int lda; int zoff; __device__ bool active(int) const { return true; } __device__ float a(int m, int k, int z) const { return bf2f(A[(size_t)m * lda + z * zoff + k]); } };
struct ALF32 { const float* A; int lda; int pad; __device__ bool active(int) const { return true; } __device__ float a(int m, int k, int) const { return A[(size_t)m * lda + k]; } };
struct ALBfLim { const bf16* A; const int* nrows; int lda; int pad; __device__ bool active(int m0) const { return m0 < *nrows; } __device__ float a(int m, int k, int) const { return bf2f(A[(size_t)m * lda + k]); } };
struct BLW { const float* W; int ldw; int pad; __device__ float b(int k, int n, int, int, int) const { return W[(size_t)k * ldw + n]; } };
struct BLW2 { const float* W0; const float* W1; int ldw; int pad; __device__ float b(int k, int n, int, int, int nb) const { return (nb ? W1 : W0)[(size_t)k * ldw + n]; } };
struct BLBt { const bf16* Bt; int ldb; int zrow; int zcol; int pad; __device__ float b(int k, int n, int z, int, int) const { return bf2f(Bt[(size_t)(z * zrow + n) * ldb + z * zcol + k]); } };
struct BLExp { const float* W0; const float* W1; const int* tile_e; size_t es; int ldw; int pad; __device__ float b(int k, int n, int, int m0, int nb) const { const int e = tile_e[m0 >> 8]; return (nb ? W1 : W0)[(size_t)e * es + (size_t)k * ldw + n]; } };

struct EPP0 { bf16* P; __device__ void operator()(int m, int n, int, float a, float) const { const int c = n < 1552 ? n : n + 240; P[(size_t)m * NP0 + c] = f2bf(a); } };
struct EPP1 { bf16* P; __device__ void operator()(int m, int n, int, float a, float) const { const int c = n < 2560 ? n : (n < 2576 ? 4096 + (n - 2560) : n - 16); P[(size_t)m * NP1 + c] = f2bf(a); } };
struct EPRes { const float* base; float* out; __device__ void operator()(int m, int n, int, float a, float) const { const size_t i = (size_t)m * D + n; out[i] = ALPHA * base[i] + a; } };
struct EPBf { bf16* O; int ldo; int zoff; float scale; int pad; __device__ void operator()(int m, int n, int z, float a, float) const { O[(size_t)m * ldo + z * zoff + n] = f2bf(a * scale); } };
struct EPBfT { bf16* O; int ldo; int pad; __device__ void operator()(int m, int n, int, float a, float) const { O[(size_t)n * ldo + m] = f2bf(a); } };
struct EPF32 { float* O; int ldo; int zoff; __device__ void operator()(int m, int n, int z, float a, float) const { O[(size_t)m * ldo + z * zoff + n] = a; } };
struct EPSilu { bf16* O; int ldo; int pad; __device__ void operator()(int m, int n, int, float a, float b) const { O[(size_t)m * ldo + n] = f2bf(siluf(a) * b); } };
struct EPYR { bf16* YR; const int* row_tok; const int* tile_e; const int* meta; __device__ void operator()(int m, int n, int, float a, float) const {
    if (row_tok[m] >= 0) { const int e = tile_e[m >> 8]; YR[(size_t)(m - meta[8 + e]) * D + n] = f2bf(a); } } };

template <int NB, class AL, class BL, class EP>
__global__ __launch_bounds__(256) void gemm_naive(int N, int K, AL al, BL bl, EP ep) {
    __shared__ float As[16][68];
    __shared__ float Bs[NB][16][68];
    const int z = blockIdx.z, m0 = blockIdx.y * 64, n0 = blockIdx.x * 64, tid = threadIdx.x;
    if (!al.active(m0)) return;
    const int ty = tid >> 4, tx = tid & 15;
    float acc[NB][4][4];
#pragma unroll
    for (int nb = 0; nb < NB; ++nb)
#pragma unroll
        for (int i = 0; i < 4; ++i)
#pragma unroll
            for (int j = 0; j < 4; ++j) acc[nb][i][j] = 0.f;
    for (int k0 = 0; k0 < K; k0 += 16) {
#pragma unroll
        for (int i = 0; i < 4; ++i) { const int idx = tid + 256 * i, r = idx >> 4, kk = idx & 15; As[kk][r] = al.a(m0 + r, k0 + kk, z); }
#pragma unroll
        for (int i = 0; i < 4; ++i) { const int idx = tid + 256 * i, kk = idx >> 6, n = idx & 63;
#pragma unroll
            for (int nb = 0; nb < NB; ++nb) Bs[nb][kk][n] = (n0 + n < N) ? bl.b(k0 + kk, n0 + n, z, m0, nb) : 0.f; }
        __syncthreads();
#pragma unroll
        for (int kk = 0; kk < 16; ++kk) {
            float a[4];
#pragma unroll
            for (int i = 0; i < 4; ++i) a[i] = As[kk][ty * 4 + i];
#pragma unroll
            for (int nb = 0; nb < NB; ++nb) {
                float b[4];
#pragma unroll
                for (int j = 0; j < 4; ++j) b[j] = Bs[nb][kk][tx * 4 + j];
#pragma unroll
                for (int i = 0; i < 4; ++i)
#pragma unroll
                    for (int j = 0; j < 4; ++j) acc[nb][i][j] += a[i] * b[j];
            }
        }
        __syncthreads();
    }
#pragma unroll
    for (int i = 0; i < 4; ++i)
#pragma unroll
        for (int j = 0; j < 4; ++j) { const int m = m0 + ty * 4 + i, n = n0 + tx * 4 + j; if (n < N) ep(m, n, z, acc[0][i][j], NB == 2 ? acc[NB - 1][i][j] : 0.f); }
}
template <int NB, class AL, class BL, class EP>
void run_gemm(hipStream_t st, int Mr, int N, int K, int Z, AL al, BL bl, EP ep) {
    dim3 grid((N + 63) / 64, Mr / 64, Z);
    hipLaunchKernelGGL((gemm_naive<NB, AL, BL, EP>), grid, dim3(256), 0, st, N, K, al, bl, ep);
}

__global__ void cvt_bf16_kernel(const float* in, bf16* out, size_t n) {
    for (size_t i = (size_t)blockIdx.x * blockDim.x + threadIdx.x; i < n; i += (size_t)gridDim.x * blockDim.x) out[i] = f2bf(in[i]);
}
__global__ __launch_bounds__(256) void ln_kernel(const float* in, float* outf, bf16* outb, const float* g, const float* b) {
    const int row = blockIdx.x * 4 + (threadIdx.x >> 6), lane = threadIdx.x & 63;
    const float4* p = (const float4*)(in + (size_t)row * D) + lane;
    float4 v[4]; float s = 0.f;
#pragma unroll
    for (int j = 0; j < 4; ++j) { v[j] = p[64 * j]; s += (v[j].x + v[j].y) + (v[j].z + v[j].w); }
    const float mean = wave_sum(s) * (1.f / D); float q = 0.f;
#pragma unroll
    for (int j = 0; j < 4; ++j) { v[j].x -= mean; v[j].y -= mean; v[j].z -= mean; v[j].w -= mean; q += (v[j].x * v[j].x + v[j].y * v[j].y) + (v[j].z * v[j].z + v[j].w * v[j].w); }
    const float rstd = 1.f / sqrtf(wave_sum(q) * (1.f / D) + 1e-5f);
#pragma unroll
    for (int j = 0; j < 4; ++j) {
        const int col = 4 * (lane + 64 * j);
        const float4 gg = *(const float4*)(g + col), bb = *(const float4*)(b + col);
        float4 o; o.x = v[j].x * rstd * gg.x + bb.x; o.y = v[j].y * rstd * gg.y + bb.y; o.z = v[j].z * rstd * gg.z + bb.z; o.w = v[j].w * rstd * gg.w + bb.w;
        *(float4*)(outf + (size_t)row * D + col) = o;
        if (outb) { bf16* ob = outb + (size_t)row * D + col; ob[0] = f2bf(o.x); ob[1] = f2bf(o.y); ob[2] = f2bf(o.z); ob[3] = f2bf(o.w); }
    }
}

__global__ void gla_prep(const bf16* P, const float* wa2, const float* ba, float* EA) {
    const int idx = blockIdx.x * 256 + threadIdx.x, t = idx >> 8, c = idx & 255;
    float s = ba[c];
#pragma unroll
    for (int r = 0; r < 16; ++r) s += bf2f(P[(size_t)t * NP0 + 1536 + r]) * wa2[r * 256 + c];
    const float ls = fminf(s, 0.f) - log1pf(expf(-fabsf(s)));
    EA[idx] = expf(ls * (1.f / 16.f));
}
__global__ __launch_bounds__(64) void gla_scan(const bf16* P, const float* EA, float* ORAW) {
    const int h = blockIdx.x >> 1, j = (blockIdx.x & 1) * 64 + threadIdx.x;
    float S[64];
#pragma unroll
    for (int i = 0; i < 64; ++i) S[i] = 0.f;
    for (int t = 0; t < M; ++t) {
        const bf16* pr = P + (size_t)t * NP0;
        const float vj = bf2f(pr[512 + h * 128 + j]);
        const float* ea = EA + (size_t)t * 256 + h * 64;
        float o = 0.f;
#pragma unroll
        for (int i = 0; i < 64; ++i) {
            const float k = bf2f(pr[256 + h * 64 + i]), q = bf2f(pr[h * 64 + i]);
            S[i] = ea[i] * S[i] + k * vj; o += q * S[i];
        }
        ORAW[(size_t)t * 512 + h * 128 + j] = o * 0.125f;
    }
}
__global__ __launch_bounds__(256) void gla_fin(const bf16* P, const float* ORAW, const float* norm_g, bf16* OMIX) {
    const int w = blockIdx.x * 4 + (threadIdx.x >> 6), t = w >> 2, h = w & 3, lane = threadIdx.x & 63;
    const float o0 = ORAW[(size_t)t * 512 + h * 128 + lane], o1 = ORAW[(size_t)t * 512 + h * 128 + 64 + lane];
    const float r = 1.f / sqrtf(wave_sum(o0 * o0 + o1 * o1) * (1.f / 128.f) + 1e-5f);
#pragma unroll
    for (int u = 0; u < 2; ++u) {
        const int j = lane + 64 * u; const float o = u ? o1 : o0;
        const float g = bf2f(P[(size_t)t * NP0 + 1024 + h * 128 + j]);
        OMIX[(size_t)t * 1024 + h * 128 + j] = f2bf(o * r * norm_g[h * 128 + j] * siluf(g));
    }
}

__global__ __launch_bounds__(512) void rwkv_prep(const bf16* P, const float* mu, const float* w0, const float* w2, const float* a0, const float* a2, const float* g2,
                                                 const float* kkw, const float* kaw, const float* rkw, float* VEC, float* R, bf16* G, float* BON) {
    __shared__ float ps[1792];
    const int t = blockIdx.x, c = threadIdx.x;
    for (int i = c; i < 1792; i += 512) {
        const float p = bf2f(P[(size_t)t * NP0 + 1792 + i]);
        const float pp = t > 0 ? bf2f(P[(size_t)(t - 1) * NP0 + 1792 + i]) : 0.f;
        ps[i] = p + mu[i] * (pp - p);
    }
    __syncthreads();
    if (c < 64) ps[1536 + c] = tanhf(ps[1536 + c]);
    else if (c >= 128 && c < 256) ps[1664 + c - 128] = sigm(ps[1664 + c - 128]);
    __syncthreads();
    float lw = w0[c];
#pragma unroll 4
    for (int i = 0; i < 64; ++i) lw += ps[1536 + i] * w2[i * 512 + c];
    float aa = a0[c];
#pragma unroll 4
    for (int i = 0; i < 64; ++i) aa += ps[1600 + i] * a2[i * 512 + c];
    aa = sigm(aa);
    float gg = 0.f;
#pragma unroll 4
    for (int i = 0; i < 128; ++i) gg += ps[1664 + i] * g2[i * 512 + c];
    const float w = expf(-0.6065306597126334f * sigm(lw));
    const float r = ps[c], k = ps[512 + c];
    const float kr = k * kkw[c];
    const float ss = wave_sum(kr * kr);
    const float kk = kr * (1.f / sqrtf(fmaxf(ss, 1e-24f)));
    const float k2 = k * (1.f + (aa - 1.f) * kaw[c]);
    const float b = kk * aa;
    const float bon = wave_sum(r * k2 * rkw[c]);
    const int h = c >> 6, l = c & 63;
    float* ve = VEC + ((size_t)t * 8 + h) * 256;
    ve[l] = k2; ve[64 + l] = w; ve[128 + l] = kk; ve[192 + l] = b;
    R[(size_t)t * 512 + c] = r;
    G[(size_t)t * 512 + c] = f2bf(gg);
    if (l == 0) BON[t * 8 + h] = bon;
}
__global__ __launch_bounds__(64) void rwkv_scan(const bf16* P, const float* mu, const float* VEC, const float* R, float* ORAW) {
    const int h = blockIdx.x, v = threadIdx.x;
    float S[64];
#pragma unroll
    for (int i = 0; i < 64; ++i) S[i] = 0.f;
    const float muv = mu[1024 + h * 64 + v];
    float pp = 0.f;
    for (int t = 0; t < M; ++t) {
        const float* ve = VEC + ((size_t)t * 8 + h) * 256;
        const float* rr = R + (size_t)t * 512 + h * 64;
        const float p = bf2f(P[(size_t)t * NP0 + 1792 + 1024 + h * 64 + v]);
        const float vv = p + muv * (pp - p); pp = p;
        float sk = 0.f;
#pragma unroll
        for (int i = 0; i < 64; ++i) sk += S[i] * ve[128 + i];
        float o = 0.f;
#pragma unroll
        for (int i = 0; i < 64; ++i) { S[i] = S[i] * ve[64 + i] - sk * ve[192 + i] + vv * ve[i]; o += S[i] * rr[i]; }
        ORAW[(size_t)t * 512 + h * 64 + v] = o;
    }
}
__global__ __launch_bounds__(256) void rwkv_fin(const bf16* P, const float* mu, const float* ORAW, const bf16* G, const float* BON, const float* lnw, const float* lnb, bf16* OMIX) {
    const int w = blockIdx.x * 4 + (threadIdx.x >> 6), t = w >> 3, h = w & 7, lane = threadIdx.x & 63, c = h * 64 + lane;
    const float o = ORAW[(size_t)t * 512 + c];
    const float mean = wave_sum(o) * (1.f / 64.f), d = o - mean;
    const float var = wave_sum(d * d) * (1.f / 64.f);
    const float on = d * (1.f / sqrtf(var + 64e-5f)) * lnw[c] + lnb[c];
    const float p = bf2f(P[(size_t)t * NP0 + 1792 + 1024 + c]);
    const float pp = t > 0 ? bf2f(P[(size_t)(t - 1) * NP0 + 1792 + 1024 + c]) : 0.f;
    const float vv = p + mu[1024 + c] * (pp - p);
    OMIX[(size_t)t * 1024 + 512 + c] = f2bf((on + BON[t * 8 + h] * vv) * bf2f(G[(size_t)t * 512 + c]));
}

__global__ void ssd_prep(const bf16* P, const float* conv_w, const float* conv_b, float* XBC) {
    const size_t idx = (size_t)blockIdx.x * 256 + threadIdx.x; const int t = (int)(idx / 1536), c = (int)(idx % 1536);
    float y = conv_b[c];
#pragma unroll
    for (int i = 0; i < 4; ++i) { const int tt = t - 3 + i; if (tt >= 0) y += conv_w[i * 1536 + c] * bf2f(P[(size_t)tt * NP1 + 1024 + c]); }
    XBC[idx] = siluf(y);
}
__global__ void ssd_dt(const bf16* P, const float* dt_bias, const float* a_log, float* DT, float* DA) {
    const int idx = blockIdx.x * 256 + threadIdx.x, t = idx >> 4, h = idx & 15;
    const float x = bf2f(P[(size_t)t * NP1 + 4096 + h]) + dt_bias[h];
    const float dt = x > 20.f ? x : log1pf(expf(x));
    DT[idx] = dt; DA[idx] = expf(-dt * expf(a_log[h]));
}
__global__ __launch_bounds__(64) void ssd_scan(const float* XBC, const float* DT, const float* DA, const float* d_skip, float* Y) {
    const int h = blockIdx.x, p = threadIdx.x, g = h >> 3;
    float hs[128];
#pragma unroll
    for (int n = 0; n < 128; ++n) hs[n] = 0.f;
    const float dsk = d_skip[h];
    for (int t = 0; t < M; ++t) {
        const float* xr = XBC + (size_t)t * 1536;
        const float x = xr[h * 64 + p], dt = DT[t * 16 + h], dA = DA[t * 16 + h], xd = x * dt;
        const float* Bv = xr + 1024 + g * 128; const float* Cv = xr + 1280 + g * 128;
        float y = 0.f;
#pragma unroll
        for (int n = 0; n < 128; ++n) { hs[n] = dA * hs[n] + xd * Bv[n]; y += Cv[n] * hs[n]; }
        Y[(size_t)t * 1024 + h * 64 + p] = y + dsk * x;
    }
}
__global__ __launch_bounds__(256) void ssd_fin(const bf16* P, const float* Y, const float* norm_g, bf16* OMIX) {
    const int w = blockIdx.x * 4 + (threadIdx.x >> 6), t = w >> 1, g = w & 1, lane = threadIdx.x & 63;
    float val[8]; float ss = 0.f;
#pragma unroll
    for (int u = 0; u < 8; ++u) { const int i = g * 512 + lane + 64 * u; val[u] = Y[(size_t)t * 1024 + i] * siluf(bf2f(P[(size_t)t * NP1 + i])); ss += val[u] * val[u]; }
    const float r = 1.f / sqrtf(wave_sum(ss) * (1.f / 512.f) + 1e-5f);
#pragma unroll
    for (int u = 0; u < 8; ++u) { const int i = g * 512 + lane + 64 * u; OMIX[(size_t)t * 1536 + i] = f2bf(val[u] * r * norm_g[i]); }
}

__global__ void moba_kmean(const bf16* P, float* KM) {
    const int idx = blockIdx.x * 256 + threadIdx.x, d = idx & 63, j = (idx >> 6) & 63, h = idx >> 12;
    float s = 0.f;
    for (int i = 0; i < 256; ++i) s += bf2f(P[(size_t)(j * 256 + i) * NP1 + 3072 + h * 64 + d]);
    KM[idx] = s * (1.f / 256.f);
}
__global__ __launch_bounds__(64) void moba_naive(const bf16* P, const float* KM, bf16* OMIX) {
    const int idx = blockIdx.x * 64 + threadIdx.x, h = idx & 7, t = idx >> 3;
    float q[64];
#pragma unroll
    for (int d = 0; d < 64; ++d) q[d] = bf2f(P[(size_t)t * NP1 + 2560 + h * 64 + d]) * 0.125f;
    const int own = t >> 8;
    float b0 = -INFINITY, b1 = -INFINITY, b2 = -INFINITY; int i0 = 0, i1 = 0, i2 = 0;
    for (int j = 0; j < own; ++j) {
        const float* km = KM + (size_t)(h * 64 + j) * 64; float g = 0.f;
#pragma unroll
        for (int d = 0; d < 64; ++d) g += q[d] * km[d];
        if (g > b0) { b2 = b1; i2 = i1; b1 = b0; i1 = i0; b0 = g; i0 = j; }
        else if (g > b1) { b2 = b1; i2 = i1; b1 = g; i1 = j; }
        else if (g > b2) { b2 = g; i2 = j; }
    }
    const int nsel = own < 3 ? own : 3;
    const float slope = exp2f(-(float)(h + 1));
    float mx = -INFINITY, l = 0.f, o[64];
#pragma unroll
    for (int d = 0; d < 64; ++d) o[d] = 0.f;
    for (int u = 0; u <= nsel; ++u) {
        int s0, s1;
        if (u == 0) { s0 = own * 256; s1 = t; } else { const int j = (u == 1) ? i0 : (u == 2 ? i1 : i2); s0 = j * 256; s1 = s0 + 255; }
        for (int s = s0; s <= s1; ++s) {
            const bf16* kr = P + (size_t)s * NP1 + 3072 + h * 64; const bf16* vr = kr + 512;
            float sc = 0.f;
#pragma unroll
            for (int d = 0; d < 64; ++d) sc += q[d] * bf2f(kr[d]);
            sc -= slope * (float)(t - s);
            const float mn = fmaxf(mx, sc), corr = expf(mx - mn), pe = expf(sc - mn);
            l = l * corr + pe; mx = mn;
#pragma unroll
            for (int d = 0; d < 64; ++d) o[d] = o[d] * corr + pe * bf2f(vr[d]);
        }
    }
    const float inv = 1.f / l;
#pragma unroll
    for (int d = 0; d < 64; ++d) OMIX[(size_t)t * 1536 + 1024 + h * 64 + d] = f2bf(o[d] * inv);
}

__global__ __launch_bounds__(256) void softmax256(const float* S, bf16* PATT) {
    const int w = blockIdx.x * 4 + (threadIdx.x >> 6), lane = threadIdx.x & 63;
    const float4 v = *((const float4*)(S + (size_t)w * 256) + lane);
    const float mx = wave_max(fmaxf(fmaxf(v.x, v.y), fmaxf(v.z, v.w)));
    const float e0 = expf(v.x - mx), e1 = expf(v.y - mx), e2 = expf(v.z - mx), e3 = expf(v.w - mx);
    const float inv = 1.f / wave_sum((e0 + e1) + (e2 + e3));
    bf16* o = PATT + (size_t)w * 256 + lane * 4;
    o[0] = f2bf(e0 * inv); o[1] = f2bf(e1 * inv); o[2] = f2bf(e2 * inv); o[3] = f2bf(e3 * inv);
}

__global__ __launch_bounds__(256) void moe_router(const float* XF, const float* wr, const float* br, int* TOPE, float* GATE) {
    const int t = blockIdx.x * 4 + (threadIdx.x >> 6), lane = threadIdx.x & 63;
    float acc[8];
#pragma unroll
    for (int e = 0; e < 8; ++e) acc[e] = 0.f;
    for (int k = lane; k < D; k += 64) { const float x = XF[(size_t)t * D + k];
#pragma unroll
        for (int e = 0; e < 8; ++e) acc[e] += x * wr[k * 8 + e]; }
#pragma unroll
    for (int e = 0; e < 8; ++e) acc[e] = wave_sum(acc[e]) + br[e];
    if (lane == 0) {
        int e0 = 0; float l0 = acc[0];
#pragma unroll
        for (int e = 1; e < 8; ++e) if (acc[e] > l0) { l0 = acc[e]; e0 = e; }
        int e1 = -1; float l1 = -INFINITY;
#pragma unroll
        for (int e = 0; e < 8; ++e) if (e != e0 && acc[e] > l1) { l1 = acc[e]; e1 = e; }
        const float ex = expf(l1 - l0), g0 = 1.f / (1.f + ex);
        TOPE[2 * t] = e0; TOPE[2 * t + 1] = e1; GATE[2 * t] = g0; GATE[2 * t + 1] = ex * g0;
    }
}
__global__ __launch_bounds__(1024) void moe_sort(const int* TOPE, int* row_tok, int* slot_row, int* tile_e, int* meta) {
    __shared__ int cnt[8], pst[9], cur[8];
    const int tid = threadIdx.x;
    if (tid < 8) { cnt[tid] = 0; cur[tid] = 0; }
    __syncthreads();
    for (int i = tid; i < 2 * M; i += 1024) atomicAdd(&cnt[TOPE[i]], 1);
    __syncthreads();
    if (tid == 0) {
        int p = 0, us = 0;
        for (int e = 0; e < 8; ++e) { pst[e] = p; meta[e] = p; meta[8 + e] = p - us; p += (cnt[e] + 255) / 256 * 256; us += cnt[e]; }
        pst[8] = p; meta[16] = p;
    }
    __syncthreads();
    for (int r = tid; r < RMAX; r += 1024) row_tok[r] = -1;
    for (int tl = tid; tl < RMAX / 256; tl += 1024) { int e = 7; for (int x = 0; x < 8; ++x) if (tl * 256 >= pst[x] && tl * 256 < pst[x + 1]) e = x; tile_e[tl] = e; }
    __syncthreads();
    for (int i = tid; i < 2 * M; i += 1024) { const int e = TOPE[i]; const int pos = pst[e] + atomicAdd(&cur[e], 1); row_tok[pos] = i >> 1; slot_row[i] = pos; }
}
__global__ __launch_bounds__(256) void moe_gather(const bf16* XB, const int* row_tok, const int* meta, bf16* XG) {
    const int r = blockIdx.x * 4 + (threadIdx.x >> 6), lane = threadIdx.x & 63;
    if (r >= meta[16]) return;
    const int t = row_tok[r];
    uint4* dst = (uint4*)(XG + (size_t)r * D);
    if (t >= 0) { const uint4* src = (const uint4*)(XB + (size_t)t * D); dst[lane] = src[lane]; dst[lane + 64] = src[lane + 64]; }
    else { const uint4 zz = {0u, 0u, 0u, 0u}; dst[lane] = zz; dst[lane + 64] = zz; }
}
__global__ __launch_bounds__(256) void moe_final(const float* XF, const bf16* YR, const int* TOPE, const float* GATE, const int* slot_row, const int* meta, const float* g, const float* b, float* out) {
    const int t = blockIdx.x * 4 + (threadIdx.x >> 6), lane = threadIdx.x & 63;
    const int e0 = TOPE[2 * t], e1 = TOPE[2 * t + 1];
    const float g0 = GATE[2 * t], g1 = GATE[2 * t + 1];
    const bf16* y0 = YR + (size_t)(slot_row[2 * t] - meta[8 + e0]) * D; const bf16* y1 = YR + (size_t)(slot_row[2 * t + 1] - meta[8 + e1]) * D;
    float v[16]; float s = 0.f;
#pragma unroll
    for (int j = 0; j < 4; ++j)
#pragma unroll
        for (int u = 0; u < 4; ++u) { const int col = 4 * (lane + 64 * j) + u; const float x = ALPHA * XF[(size_t)t * D + col] + g0 * bf2f(y0[col]) + g1 * bf2f(y1[col]); v[j * 4 + u] = x; s += x; }
    const float mean = wave_sum(s) * (1.f / D); float q = 0.f;
#pragma unroll
    for (int i = 0; i < 16; ++i) { v[i] -= mean; q += v[i] * v[i]; }
    const float rstd = 1.f / sqrtf(wave_sum(q) * (1.f / D) + 1e-5f);
#pragma unroll
    for (int j = 0; j < 4; ++j)
#pragma unroll
        for (int u = 0; u < 4; ++u) { const int col = 4 * (lane + 64 * j) + u; out[(size_t)t * D + col] = v[j * 4 + u] * rstd * g[col] + b[col]; }
}
}

extern "C" void kernel_launch(void* const* d_in, const int* in_sizes, int n_in, void* d_out, int out_size, void* d_ws, size_t ws_size, hipStream_t stream) {
    if (n_in != 54 || ws_size < WS_END) { fprintf(stderr, "kernel_launch: unexpected n_in %d / ws_size %zu (need %zu)\n", n_in, ws_size, (size_t)WS_END); return; }
    auto F = [&](int i) { return (const float*)d_in[i]; };
    unsigned char* ws = (unsigned char*)d_ws;
    float* XFA = (float*)(ws + WS_XFA); float* XFB = (float*)d_out;
    bf16* XB = (bf16*)(ws + WS_XB); bf16* P = (bf16*)(ws + WS_P); bf16* OMIX = (bf16*)(ws + WS_OMIX);
    unsigned char* SCR = ws + WS_SCR;
    float* BON = (float*)(ws + WS_CTL + 512 * 1024);
    bf16* Q = (bf16*)(ws + WS_P); bf16* PATT = (bf16*)(ws + WS_P + 32 * MiB); bf16* OX = (bf16*)(ws + WS_P + 64 * MiB);
    float* S = (float*)SCR; bf16* KMEM = (bf16*)(SCR + 100 * MiB); bf16* VT = (bf16*)(SCR + 101 * MiB);
    bf16* H = (bf16*)(ws + WS_P);

    auto ln = [&](float* buf, const float* g, const float* b) { hipLaunchKernelGGL(ln_kernel, dim3(M / 4), dim3(256), 0, stream, buf, buf, XB, g, b); };
    auto xattn = [&](int base_in, const float* xbase, float* xout) {
        run_gemm<1>(stream, 256, D, D, 1, ALF32{F(1), D}, BLW{F(base_in + 1), D}, EPBf{KMEM, D, 0, 1.f});
        run_gemm<1>(stream, 256, D, D, 1, ALF32{F(1), D}, BLW{F(base_in + 2), D}, EPBfT{VT, 256});
        run_gemm<1>(stream, M, D, D, 1, ALBf{XB, D, 0}, BLW{F(base_in), D}, EPBf{Q, D, 0, 0.0625f});
        run_gemm<1>(stream, M, 256, 256, 4, ALBf{Q, D, 256}, BLBt{KMEM, D, 0, 256}, EPF32{S, D, 256});
        hipLaunchKernelGGL(softmax256, dim3(M * 4 / 4), dim3(256), 0, stream, S, PATT);
        run_gemm<1>(stream, M, 256, 256, 4, ALBf{PATT, D, 256}, BLBt{VT, 256, 256, 0}, EPBf{OX, D, 256, 1.f});
        run_gemm<1>(stream, M, D, D, 1, ALBf{OX, D, 0}, BLW{F(base_in + 3), D}, EPRes{xbase, xout});
    };

    hipLaunchKernelGGL(cvt_bf16_kernel, dim3(2048), dim3(256), 0, stream, F(0), XB, (size_t)M * D);
    run_gemm<1>(stream, M, 3344, D, 1, ALBf{XB, D, 0}, BLW{F(2), 3344}, EPP0{P});
    {
        float* EA = (float*)(ws + WS_XB); float* ORAW = (float*)(ws + WS_XFA);
        hipLaunchKernelGGL(gla_prep, dim3(M * 256 / 256), dim3(256), 0, stream, P, F(3), F(4), EA);
        hipLaunchKernelGGL(gla_scan, dim3(8), dim3(64), 0, stream, P, EA, ORAW);
        hipLaunchKernelGGL(gla_fin, dim3(M * 4 / 4), dim3(256), 0, stream, P, ORAW, F(5), OMIX);
    }
    {
        float* VEC = (float*)SCR; float* R = (float*)(ws + WS_XFA); float* ORAW = (float*)(ws + WS_XFA + 32 * MiB); bf16* G = (bf16*)(ws + WS_XB + 16 * MiB);
        hipLaunchKernelGGL(rwkv_prep, dim3(M), dim3(512), 0, stream, P, F(6), F(7), F(8), F(9), F(10), F(11), F(12), F(13), F(14), VEC, R, G, BON);
        hipLaunchKernelGGL(rwkv_scan, dim3(8), dim3(64), 0, stream, P, F(6), VEC, R, ORAW);
        hipLaunchKernelGGL(rwkv_fin, dim3(M * 8 / 4), dim3(256), 0, stream, P, F(6), ORAW, G, BON, F(15), F(16), OMIX);
    }
    run_gemm<1>(stream, M, D, D, 1, ALBf{OMIX, D, 0}, BLW{F(17), D}, EPRes{F(0), XFA});
    ln(XFA, F(18), F(19));
    xattn(20, XFA, XFB);
    ln(XFB, F(24), F(25));
    run_gemm<2>(stream, M, 2816, D, 1, ALBf{XB, D, 0}, BLW2{F(26), F(27), 2816}, EPSilu{H, 2816});
    run_gemm<1>(stream, M, D, 2816, 1, ALBf{H, 2816, 0}, BLW{F(28), D}, EPRes{XFB, XFA});
    ln(XFA, F(29), F(30));
    run_gemm<1>(stream, M, 4112, D, 1, ALBf{XB, D, 0}, BLW{F(31), 4112}, EPP1{P});
    {
        float* XBC = (float*)SCR; float* DT = (float*)(SCR + 96 * MiB); float* DA = (float*)(SCR + 97 * MiB); float* Y = XFB;
        hipLaunchKernelGGL(ssd_prep, dim3(M * 1536 / 256), dim3(256), 0, stream, P, F(32), F(33), XBC);
        hipLaunchKernelGGL(ssd_dt, dim3(M * 16 / 256), dim3(256), 0, stream, P, F(34), F(35), DT, DA);
        hipLaunchKernelGGL(ssd_scan, dim3(16), dim3(64), 0, stream, XBC, DT, DA, F(36), Y);
        hipLaunchKernelGGL(ssd_fin, dim3(M * 2 / 4), dim3(256), 0, stream, P, Y, F(37), OMIX);
    }
    {
        float* KM = (float*)(SCR + 98 * MiB);
        hipLaunchKernelGGL(moba_kmean, dim3(8 * 64 * 64 / 256), dim3(256), 0, stream, P, KM);
        hipLaunchKernelGGL(moba_naive, dim3(M * 8 / 64), dim3(64), 0, stream, P, KM, OMIX);
    }
    run_gemm<1>(stream, M, D, 1536, 1, ALBf{OMIX, 1536, 0}, BLW{F(38), D}, EPRes{XFA, XFB});
    ln(XFB, F(39), F(40));
    xattn(41, XFB, XFA);
    ln(XFA, F(45), F(46));
    {
        bf16* HM = (bf16*)(ws + 97 * MiB); bf16* XG = (bf16*)(ws + 284 * MiB);
        unsigned char* RT = ws + 352 * MiB;
        int* TOPE = (int*)RT; float* GATE = (float*)(RT + 128 * 1024); int* ROW_TOK = (int*)(RT + 256 * 1024); int* SLOT_ROW = (int*)(RT + 512 * 1024);
        int* TILE_E = (int*)(RT + 640 * 1024); int* META = (int*)(RT + 704 * 1024);
        bf16* YR = (bf16*)(ws + 353 * MiB);
        hipLaunchKernelGGL(moe_router, dim3(M / 4), dim3(256), 0, stream, XFA, F(47), F(48), TOPE, GATE);
        hipLaunchKernelGGL(moe_sort, dim3(1), dim3(1024), 0, stream, TOPE, ROW_TOK, SLOT_ROW, TILE_E, META);
        hipLaunchKernelGGL(moe_gather, dim3(RMAX / 4), dim3(256), 0, stream, XB, ROW_TOK, META, XG);
        run_gemm<2>(stream, RMAX, 2816, D, 1, ALBfLim{XG, META + 16, D, 0}, BLExp{F(49), F(50), TILE_E, (size_t)D * 2816, 2816, 0}, EPSilu{HM, 2816});
        run_gemm<1>(stream, RMAX, D, 2816, 1, ALBfLim{HM, META + 16, 2816, 0}, BLExp{F(51), F(51), TILE_E, (size_t)2816 * D, D, 0}, EPYR{YR, ROW_TOK, TILE_E, META});
        hipLaunchKernelGGL(moe_final, dim3(M / 4), dim3(256), 0, stream, XFA, YR, TOPE, GATE, SLOT_ROW, META, F(52), F(53), (float*)d_out);
    }
}
```

```cpp
#include <hip/hip_runtime.h>
#include <cstdio>
#include <cstdint>
#include <cstddef>

typedef unsigned short bf16;
#define LAS __attribute__((address_space(3)))

namespace {
constexpr int M = 16384, D = 1024;
constexpr int NP0 = 3584, NP1 = 4352;
constexpr float ALPHA = 1.4142135623730951f;
constexpr int RMAX = 34816;
constexpr size_t MiB = 1ull << 20;
constexpr size_t WS_CTL = 0, WS_XFA = 1 * MiB, WS_XB = 65 * MiB, WS_P = 97 * MiB, WS_OMIX = 233 * MiB, WS_SCR = 281 * MiB, WS_END = 433 * MiB;

__device__ __forceinline__ float bf2f(bf16 v) { return __uint_as_float(((unsigned)v) << 16); }
__device__ __forceinline__ bf16 f2bf(float f) { unsigned u = __float_as_uint(f); u += 0x7fffu + ((u >> 16) & 1u); return (bf16)(u >> 16); }
__device__ __forceinline__ float sigm(float x) { return 1.f / (1.f + expf(-x)); }
__device__ __forceinline__ float siluf(float x) { return x * sigm(x); }
__device__ __forceinline__ float wave_sum(float v) {
#pragma unroll
    for (int o = 1; o < 64; o <<= 1) v += __shfl_xor(v, o);
    return v;
}
__device__ __forceinline__ float wave_max(float v) {
#pragma unroll
    for (int o = 1; o < 64; o <<= 1) v = fmaxf(v, __shfl_xor(v, o));
    return v;
}

__device__ __forceinline__ void gla_prep_item(int idx, const bf16* P, const float* wa2, const float* ba, float* EA) {
    const int t = idx >> 8, c = idx & 255;
    float s = ba[c];
#pragma unroll
    for (int r = 0; r < 16; ++r) s += bf2f(P[(size_t)t * NP0 + 1536 + r]) * wa2[r * 256 + c];
    const float ls = fminf(s, 0.f) - log1pf(expf(-fabsf(s)));
    EA[idx] = expf(ls * (1.f / 16.f));
}
__device__ __forceinline__ void gla_scan_item(int item, int lane, const bf16* P, const float* EA, float* ORAW) {
    const int h = item >> 1, j = (item & 1) * 64 + lane;
    float S[64];
#pragma unroll
    for (int i = 0; i < 64; ++i) S[i] = 0.f;
    for (int t = 0; t < M; ++t) {
        const bf16* pr = P + (size_t)t * NP0;
        const float vj = bf2f(pr[512 + h * 128 + j]);
        const float* ea = EA + (size_t)t * 256 + h * 64;
        float o = 0.f;
#pragma unroll
        for (int i = 0; i < 64; ++i) {
            const float k = bf2f(pr[256 + h * 64 + i]), q = bf2f(pr[h * 64 + i]);
            S[i] = ea[i] * S[i] + k * vj; o += q * S[i];
        }
        ORAW[(size_t)t * 512 + h * 128 + j] = o * 0.125f;
    }
}
__device__ __forceinline__ void gla_fin_item(int w, int lane, const bf16* P, const float* ORAW, const float* norm_g, bf16* OMIX) {
    const int t = w >> 2, h = w & 3;
    const float o0 = ORAW[(size_t)t * 512 + h * 128 + lane], o1 = ORAW[(size_t)t * 512 + h * 128 + 64 + lane];
    const float r = 1.f / sqrtf(wave_sum(o0 * o0 + o1 * o1) * (1.f / 128.f) + 1e-5f);
#pragma unroll
    for (int u = 0; u < 2; ++u) {
        const int j = lane + 64 * u; const float o = u ? o1 : o0;
        const float g = bf2f(P[(size_t)t * NP0 + 1024 + h * 128 + j]);
        OMIX[(size_t)t * 1024 + h * 128 + j] = f2bf(o * r * norm_g[h * 128 + j] * siluf(g));
    }
}
__device__ __forceinline__ void rwkv_prep_token(int t, int c, LAS float* ps, const bf16* P, const float* mu, const float* w0, const float* w2, const float* a0, const float* a2, const float* g2,
                                                const float* kkw, const float* kaw, const float* rkw, float* VEC, float* R, bf16* G, float* BON) {
    for (int i = c; i < 1792; i += 512) {
        const float p = bf2f(P[(size_t)t * NP0 + 1792 + i]);
        const float pp = t > 0 ? bf2f(P[(size_t)(t - 1) * NP0 + 1792 + i]) : 0.f;
        ps[i] = p + mu[i] * (pp - p);
    }
    __syncthreads();
    if (c < 64) ps[1536 + c] = tanhf(ps[1536 + c]);
    else if (c >= 128 && c < 256) ps[1664 + c - 128] = sigm(ps[1664 + c - 128]);
    __syncthreads();
    float lw = w0[c];
#pragma unroll 4
    for (int i = 0; i < 64; ++i) lw += ps[1536 + i] * w2[i * 512 + c];
    float aa = a0[c];
#pragma unroll 4
    for (int i = 0; i < 64; ++i) aa += ps[1600 + i] * a2[i * 512 + c];
    aa = sigm(aa);
    float gg = 0.f;
#pragma unroll 4
    for (int i = 0; i < 128; ++i) gg += ps[1664 + i] * g2[i * 512 + c];
    const float w = expf(-0.6065306597126334f * sigm(lw));
    const float r = ps[c], k = ps[512 + c];
    const float kr = k * kkw[c];
    const float ss = wave_sum(kr * kr);
    const float kk = kr * (1.f / sqrtf(fmaxf(ss, 1e-24f)));
    const float k2 = k * (1.f + (aa - 1.f) * kaw[c]);
    const float b = kk * aa;
    const float bon = wave_sum(r * k2 * rkw[c]);
    const int h = c >> 6, l = c & 63;
    float* ve = VEC + ((size_t)t * 8 + h) * 256;
    ve[l] = k2; ve[64 + l] = w; ve[128 + l] = kk; ve[192 + l] = b;
    R[(size_t)t * 512 + c] = r;
    G[(size_t)t * 512 + c] = f2bf(gg);
    if (l == 0) BON[t * 8 + h] = bon;
    __syncthreads();
}
__device__ __forceinline__ void rwkv_scan_item(int h, int v, const bf16* P, const float* mu, const float* VEC, const float* R, float* ORAW) {
    float S[64];
#pragma unroll
    for (int i = 0; i < 64; ++i) S[i] = 0.f;
    const float muv = mu[1024 + h * 64 + v];
    float pp = 0.f;
    for (int t = 0; t < M; ++t) {
        const float* ve = VEC + ((size_t)t * 8 + h) * 256;
        const float* rr = R + (size_t)t * 512 + h * 64;
        const float p = bf2f(P[(size_t)t * NP0 + 1792 + 1024 + h * 64 + v]);
        const float vv = p + muv * (pp - p); pp = p;
        float sk = 0.f;
#pragma unroll
        for (int i = 0; i < 64; ++i) sk += S[i] * ve[128 + i];
        float o = 0.f;
#pragma unroll
        for (int i = 0; i < 64; ++i) { S[i] = S[i] * ve[64 + i] - sk * ve[192 + i] + vv * ve[i]; o += S[i] * rr[i]; }
        ORAW[(size_t)t * 512 + h * 64 + v] = o;
    }
}
__device__ __forceinline__ void rwkv_fin_item(int w, int lane, const bf16* P, const float* mu, const float* ORAW, const bf16* G, const float* BON, const float* lnw, const float* lnb, bf16* OMIX) {
    const int t = w >> 3, h = w & 7, c = h * 64 + lane;
    const float o = ORAW[(size_t)t * 512 + c];
    const float mean = wave_sum(o) * (1.f / 64.f), d = o - mean;
    const float var = wave_sum(d * d) * (1.f / 64.f);
    const float on = d * (1.f / sqrtf(var + 64e-5f)) * lnw[c] + lnb[c];
    const float p = bf2f(P[(size_t)t * NP0 + 1792 + 1024 + c]);
    const float pp = t > 0 ? bf2f(P[(size_t)(t - 1) * NP0 + 1792 + 1024 + c]) : 0.f;
    const float vv = p + mu[1024 + c] * (pp - p);
    OMIX[(size_t)t * 1024 + 512 + c] = f2bf((on + BON[t * 8 + h] * vv) * bf2f(G[(size_t)t * 512 + c]));
}
__device__ __forceinline__ void ssd_prep_item(size_t idx, const bf16* P, const float* conv_w, const float* conv_b, float* XBC) {
    const int t = (int)(idx / 1536), c = (int)(idx % 1536);
    float y = conv_b[c];
#pragma unroll
    for (int i = 0; i < 4; ++i) { const int tt = t - 3 + i; if (tt >= 0) y += conv_w[i * 1536 + c] * bf2f(P[(size_t)tt * NP1 + 1024 + c]); }
    XBC[idx] = siluf(y);
}
__device__ __forceinline__ void ssd_dt_item(int idx, const bf16* P, const float* dt_bias, const float* a_log, float* DT, float* DA) {
    const int t = idx >> 4, h = idx & 15;
    const float x = bf2f(P[(size_t)t * NP1 + 4096 + h]) + dt_bias[h];
    const float dt = x > 20.f ? x : log1pf(expf(x));
    DT[idx] = dt; DA[idx] = expf(-dt * expf(a_log[h]));
}
__device__ __forceinline__ void ssd_scan_item(int h, int p, const float* XBC, const float* DT, const float* DA, const float* d_skip, float* Y) {
    const int g = h >> 3;
    float hs[128];
#pragma unroll
    for (int n = 0; n < 128; ++n) hs[n] = 0.f;
    const float dsk = d_skip[h];
    for (int t = 0; t < M; ++t) {
        const float* xr = XBC + (size_t)t * 1536;
        const float x = xr[h * 64 + p], dt = DT[t * 16 + h], dA = DA[t * 16 + h], xd = x * dt;
        const float* Bv = xr + 1024 + g * 128; const float* Cv = xr + 1280 + g * 128;
        float y = 0.f;
#pragma unroll
        for (int n = 0; n < 128; ++n) { hs[n] = dA * hs[n] + xd * Bv[n]; y += Cv[n] * hs[n]; }
        Y[(size_t)t * 1024 + h * 64 + p] = y + dsk * x;
    }
}
__device__ __forceinline__ void ssd_fin_item(int w, int lane, const bf16* P, const float* Y, const float* norm_g, bf16* OMIX) {
    const int t = w >> 1, g = w & 1;
    float val[8]; float ss = 0.f;
#pragma unroll
    for (int u = 0; u < 8; ++u) { const int i = g * 512 + lane + 64 * u; val[u] = Y[(size_t)t * 1024 + i] * siluf(bf2f(P[(size_t)t * NP1 + i])); ss += val[u] * val[u]; }
    const float r = 1.f / sqrtf(wave_sum(ss) * (1.f / 512.f) + 1e-5f);
#pragma unroll
    for (int u = 0; u < 8; ++u) { const int i = g * 512 + lane + 64 * u; OMIX[(size_t)t * 1536 + i] = f2bf(val[u] * r * norm_g[i]); }
}
__device__ __forceinline__ void moba_kmean_item(int idx, const bf16* P, float* KM) {
    const int d = idx & 63, j = (idx >> 6) & 63, h = idx >> 12;
    float s = 0.f;
    for (int i = 0; i < 256; ++i) s += bf2f(P[(size_t)(j * 256 + i) * NP1 + 3072 + h * 64 + d]);
    KM[idx] = s * (1.f / 256.f);
}
__device__ __forceinline__ void moba_item(int idx, const bf16* P, const float* KM, bf16* OMIX) {
    const int h = idx & 7, t = idx >> 3;
    float q[64];
#pragma unroll
    for (int d = 0; d < 64; ++d) q[d] = bf2f(P[(size_t)t * NP1 + 2560 + h * 64 + d]) * 0.125f;
    const int own = t >> 8;
    float b0 = -INFINITY, b1 = -INFINITY, b2 = -INFINITY; int i0 = 0, i1 = 0, i2 = 0;
    for (int j = 0; j < own; ++j) {
        const float* km = KM + (size_t)(h * 64 + j) * 64; float g = 0.f;
#pragma unroll
        for (int d = 0; d < 64; ++d) g += q[d] * km[d];
        if (g > b0) { b2 = b1; i2 = i1; b1 = b0; i1 = i0; b0 = g; i0 = j; }
        else if (g > b1) { b2 = b1; i2 = i1; b1 = g; i1 = j; }
        else if (g > b2) { b2 = g; i2 = j; }
    }
    const int nsel = own < 3 ? own : 3;
    const float slope = exp2f(-(float)(h + 1));
    float mx = -INFINITY, l = 0.f, o[64];
#pragma unroll
    for (int d = 0; d < 64; ++d) o[d] = 0.f;
    for (int u = 0; u <= nsel; ++u) {
        int s0, s1;
        if (u == 0) { s0 = own * 256; s1 = t; } else { const int j = (u == 1) ? i0 : (u == 2 ? i1 : i2); s0 = j * 256; s1 = s0 + 255; }
        for (int s = s0; s <= s1; ++s) {
            const bf16* kr = P + (size_t)s * NP1 + 3072 + h * 64; const bf16* vr = kr + 512;
            float sc = 0.f;
#pragma unroll
            for (int d = 0; d < 64; ++d) sc += q[d] * bf2f(kr[d]);
            sc -= slope * (float)(t - s);
            const float mn = fmaxf(mx, sc), corr = expf(mx - mn), pe = expf(sc - mn);
            l = l * corr + pe; mx = mn;
#pragma unroll
            for (int d = 0; d < 64; ++d) o[d] = o[d] * corr + pe * bf2f(vr[d]);
        }
    }
    const float inv = 1.f / l;
#pragma unroll
    for (int d = 0; d < 64; ++d) OMIX[(size_t)t * 1536 + 1024 + h * 64 + d] = f2bf(o[d] * inv);
}

namespace pg8 {
typedef short bf16x8 __attribute__((ext_vector_type(8)));
typedef float f32x4 __attribute__((ext_vector_type(4)));
typedef unsigned u32x4 __attribute__((ext_vector_type(4)));
constexpr int BM = 256, BK = 64, HALF = 128, HTB = HALF * BK * 2, STAGE_BYTES = 8 * HTB, NXCD = 8, WGM = 8;
__host__ __device__ __forceinline__ int lds_byte(int r, int c) { const int st = (r >> 4) * 2 + (c >> 5), rr = r & 15, cc = c & 31, ob = rr * 64 + cc * 2; return st * 1024 + (ob ^ (((ob >> 9) & 1) << 5)); }
__host__ __device__ __forceinline__ void stage_rc(int b, int& R, int& C) { const int st = b / 1024, sb = b % 1024, swz = sb ^ (((sb >> 9) & 1) << 5); R = (st >> 1) * 16 + swz / 64; C = (st & 1) * 32 + (swz % 64) / 2; }
__host__ __device__ __forceinline__ int perm32(int rho) { const int n = rho >> 4, i = rho & 15; return 8 * (i >> 2) + 4 * n + (i & 3); }
struct Unit { int pm, pn; };
struct Gemm { const bf16* A; const bf16* Bt; const int* tile_e; size_t a_pn_step, b_tstep, b_estep; int lda, ldb, K, pad; };
struct StaticOrder {
    int nM, nN, nwg, G, c;
    __device__ void init(int Mr, int N, int G_, int c_) { nM = Mr / BM; nN = N / BM; nwg = nM * nN; G = G_; c = c_; }
    __device__ bool next(int i, Unit& u) const {
        const long L = (long)i * G + c; if (L >= nwg) return false;
        int wgid = (int)L; { const int q = nwg / NXCD, r = nwg % NXCD, xcd = wgid % NXCD, off = wgid / NXCD; wgid = (xcd < r ? xcd * (q + 1) : r * (q + 1) + (xcd - r) * q) + off; }
        const int nig = WGM * nN, gid = wgid / nig, fm = gid * WGM, gsz = (nM - fm) < WGM ? (nM - fm) : WGM;
        u.pm = fm + ((wgid % nig) % gsz); u.pn = (wgid % nig) / gsz; return true;
    }
    __device__ __forceinline__ void a_ready(const Unit&) const {}
    __device__ __forceinline__ void done(const Unit&) const {}
};
__device__ __forceinline__ unsigned cvt_pk_bf16(float lo, float hi) { unsigned r; asm volatile("v_cvt_pk_bf16_f32 %0, %1, %2" : "=v"(r) : "v"(lo), "v"(hi)); return r; }
__device__ __forceinline__ u32x4 pack8(const f32x4 v0, const f32x4 v1) { u32x4 w; w.x = cvt_pk_bf16(v0[0], v0[1]); w.y = cvt_pk_bf16(v0[2], v0[3]); w.z = cvt_pk_bf16(v1[0], v1[1]); w.w = cvt_pk_bf16(v1[2], v1[3]); return w; }
struct EpBf {
    static constexpr bool PERM = true, AFTER_DRAIN = false;
    bf16* O; int ldc; float scale;
    __device__ __forceinline__ void operator()(const f32x4 (&acc)[2][2][4][2], const Unit& u, int wr, int wc, int fr, int fq) const {
        const int row0 = u.pm * BM + wr * 64 + fr, col0 = u.pn * BM + wc * 32 + 8 * fq;
#pragma unroll
        for (int ai = 0; ai < 2; ++ai)
#pragma unroll
            for (int m = 0; m < 4; ++m) { bf16* rowp = O + (size_t)(row0 + ai * HALF + m * 16) * ldc + col0;
#pragma unroll
                for (int bj = 0; bj < 2; ++bj) *(u32x4*)(rowp + bj * HALF) = pack8(acc[ai][bj][m][0] * scale, acc[ai][bj][m][1] * scale); }
    }
};
struct EpRes {
    static constexpr bool PERM = false, AFTER_DRAIN = false;
    const float* base; float* out;
    __device__ __forceinline__ void operator()(const f32x4 (&acc)[2][2][4][2], const Unit& u, int wr, int wc, int fr, int fq) const {
        const int row0 = u.pm * BM + wr * 64 + fr, col0 = u.pn * BM + wc * 32 + 4 * fq;
#pragma unroll
        for (int ai = 0; ai < 2; ++ai)
#pragma unroll
            for (int m = 0; m < 4; ++m) { const size_t off = (size_t)(row0 + ai * HALF + m * 16) * D + col0;
#pragma unroll
                for (int bj = 0; bj < 2; ++bj)
#pragma unroll
                    for (int n = 0; n < 2; ++n) { const f32x4 bs = *(const f32x4*)(base + off + bj * HALF + n * 16); *(f32x4*)(out + off + bj * HALF + n * 16) = bs * ALPHA + acc[ai][bj][m][n]; } }
    }
};
struct EpSilu {
    static constexpr bool PERM = true, AFTER_DRAIN = false;
    bf16* O; int ldc; int pad;
    __device__ __forceinline__ void operator()(const f32x4 (&acc)[2][2][4][2], const Unit& u, int wr, int wc, int fr, int fq) const {
        const int row0 = u.pm * BM + wr * 64 + fr, col0 = u.pn * HALF + wc * 32 + 8 * fq;
#pragma unroll
        for (int ai = 0; ai < 2; ++ai)
#pragma unroll
            for (int m = 0; m < 4; ++m) { f32x4 h[2];
#pragma unroll
                for (int n = 0; n < 2; ++n)
#pragma unroll
                    for (int j = 0; j < 4; ++j) { const float g = acc[ai][0][m][n][j]; h[n][j] = g / (1.f + __expf(-g)) * acc[ai][1][m][n][j]; }
                *(u32x4*)(O + (size_t)(row0 + ai * HALF + m * 16) * ldc + col0) = pack8(h[0], h[1]); }
    }
};
struct EpYR {
    static constexpr bool PERM = true, AFTER_DRAIN = false;
    bf16* YR; const int* row_tok; const int* tile_e; const int* meta; int row_off; int pad;
    __device__ __forceinline__ void operator()(const f32x4 (&acc)[2][2][4][2], const Unit& u, int wr, int wc, int fr, int fq) const {
        const int row0 = u.pm * BM + wr * 64 + fr, col0 = u.pn * BM + wc * 32 + 8 * fq;
        const int shift = row_off - meta[8 + tile_e[u.pm]];
#pragma unroll
        for (int ai = 0; ai < 2; ++ai)
#pragma unroll
            for (int m = 0; m < 4; ++m) { const int r = row0 + ai * HALF + m * 16;
                if (row_tok[r] >= 0) { bf16* rowp = YR + (size_t)(r + shift) * D + col0;
#pragma unroll
                    for (int bj = 0; bj < 2; ++bj) *(u32x4*)(rowp + bj * HALF) = pack8(acc[ai][bj][m][0], acc[ai][bj][m][1]); } }
    }
};
struct EpSoftmax {
    static constexpr bool PERM = true, AFTER_DRAIN = true;
    bf16* O; int ldc; int pad;
    __device__ __forceinline__ void fused(f32x4 (&acc)[2][2][4][2], const Unit& u, int wr, int wc, int fr, int fq, LAS unsigned char* lds, int wid, int lane) const {
        LAS float* T1 = (LAS float*)lds; LAS float* T2 = T1 + 1024;
#pragma unroll
        for (int ai = 0; ai < 2; ++ai)
#pragma unroll
            for (int m = 0; m < 4; ++m) { float v = -INFINITY;
#pragma unroll
                for (int bj = 0; bj < 2; ++bj)
#pragma unroll
                    for (int n = 0; n < 2; ++n) { const f32x4 x = acc[ai][bj][m][n]; v = fmaxf(v, fmaxf(fmaxf(x[0], x[1]), fmaxf(x[2], x[3]))); }
                v = fmaxf(v, __shfl_xor(v, 16)); v = fmaxf(v, __shfl_xor(v, 32));
                if (fq == 0) T1[(ai * HALF + wr * 64 + m * 16 + fr) * 4 + wc] = v; }
        asm volatile("s_waitcnt lgkmcnt(0)" ::: "memory"); __builtin_amdgcn_s_barrier(); asm volatile("" ::: "memory");
#pragma unroll
        for (int ai = 0; ai < 2; ++ai)
#pragma unroll
            for (int m = 0; m < 4; ++m) { const int r = ai * HALF + wr * 64 + m * 16 + fr; const f32x4 t = *(const LAS f32x4*)(T1 + r * 4);
                const float mx = fmaxf(fmaxf(t[0], t[1]), fmaxf(t[2], t[3])); float s = 0.f;
#pragma unroll
                for (int bj = 0; bj < 2; ++bj)
#pragma unroll
                    for (int n = 0; n < 2; ++n)
#pragma unroll
                        for (int j = 0; j < 4; ++j) { const float e = __expf(acc[ai][bj][m][n][j] - mx); acc[ai][bj][m][n][j] = e; s += e; }
                s += __shfl_xor(s, 16); s += __shfl_xor(s, 32);
                if (fq == 0) T2[r * 4 + wc] = s; }
        asm volatile("s_waitcnt lgkmcnt(0)" ::: "memory"); __builtin_amdgcn_s_barrier(); asm volatile("" ::: "memory");
        const int row0 = u.pm * BM + wr * 64 + fr, col0 = u.pn * BM + wc * 32 + 8 * fq;
#pragma unroll
        for (int ai = 0; ai < 2; ++ai)
#pragma unroll
            for (int m = 0; m < 4; ++m) { const int r = ai * HALF + wr * 64 + m * 16 + fr; const f32x4 t = *(const LAS f32x4*)(T2 + r * 4);
                const float inv = 1.f / ((t[0] + t[1]) + (t[2] + t[3]));
                bf16* rowp = O + (size_t)(row0 + ai * HALF + m * 16) * ldc + col0;
#pragma unroll
                for (int bj = 0; bj < 2; ++bj) *(u32x4*)(rowp + bj * HALF) = pack8(acc[ai][bj][m][0] * inv, acc[ai][bj][m][1] * inv); }
        asm volatile("s_waitcnt lgkmcnt(0)" ::: "memory"); __builtin_amdgcn_s_barrier(); asm volatile("" ::: "memory");
    }
};

template <class Epi, class Sched, bool ALIGN_EPI, bool SP2>
__device__ __forceinline__ void gemm_phase(LAS unsigned char* lds, const Gemm g, const Sched& S, const Epi& E, const int tid) {
    const int wid = __builtin_amdgcn_readfirstlane(tid >> 6), lane = tid & 63, wr = wid >> 2, wc = wid & 3, fr = lane & 15, fq = lane >> 4;
    const int K = g.K, nt = K / BK;
    unsigned voffA[2], voffB[2];
#pragma unroll
    for (int i = 0; i < 2; ++i) { int R, C; stage_rc(tid * 16 + i * 8192, R, C); const int Rb = Epi::PERM ? ((R & ~31) + perm32(R & 31)) : R;
        voffA[i] = (unsigned)(R * g.lda + C) * 2u; voffB[i] = (unsigned)(Rb * g.ldb + C) * 2u; }
    const size_t kstep = (size_t)(BK * 2);
    const size_t hstepA = (size_t)HALF * g.lda * 2, hstepB = (size_t)HALF * g.ldb * 2;
    const size_t tstepA = 2 * hstepA;
    const unsigned ldsw = (unsigned)wid * 1024u;
    const int aoff = lds_byte(wr * 64 + fr, fq * 8), boff = lds_byte(wc * 32 + fr, fq * 8);
#define PG8_SA(b, h) (((b) * 2 + (h)) * HTB)
#define PG8_SB(b, h) ((4 + (b) * 2 + (h)) * HTB)
#define PG8_STAGE(bufoff, gbase, voff) do { _Pragma("unroll") for (int _i = 0; _i < 2; ++_i) \
        __builtin_amdgcn_global_load_lds((const unsigned*)((const char*)(gbase) + (voff)[_i]), (LAS unsigned*)(lds + (bufoff) + ldsw + _i * 8192), 16, 0, 0); } while (0)
#define PG8_LDA(dst, b, h) do { _Pragma("unroll") for (int m = 0; m < 4; ++m) _Pragma("unroll") for (int k = 0; k < 2; ++k) dst[m][k] = *(const LAS bf16x8*)(lds + PG8_SA(b, h) + aoff + m * 2048 + k * 1024); } while (0)
#define PG8_LDB(dst, b, h) do { _Pragma("unroll") for (int n = 0; n < 2; ++n) _Pragma("unroll") for (int k = 0; k < 2; ++k) dst[n][k] = *(const LAS bf16x8*)(lds + PG8_SB(b, h) + boff + n * 2048 + k * 1024); } while (0)
#define PG8_MMA(ai, bj, At, Bt) do { __builtin_amdgcn_s_setprio(1); _Pragma("unroll") for (int m = 0; m < 4; ++m) _Pragma("unroll") for (int n = 0; n < 2; ++n) _Pragma("unroll") for (int k = 0; k < 2; ++k) \
        acc[ai][bj][m][n] = __builtin_amdgcn_mfma_f32_16x16x32_bf16(Bt[n][k], At[m][k], acc[ai][bj][m][n], 0, 0, 0); __builtin_amdgcn_s_setprio(0); } while (0)
#define PG8_WAIT_V(n) asm volatile("s_waitcnt vmcnt(" #n ")" ::: "memory")
#define PG8_WAIT_L(n) asm volatile("s_waitcnt lgkmcnt(" #n ")" ::: "memory")
#define PG8_BAR __builtin_amdgcn_s_barrier()
#define PG8_SCHED __builtin_amdgcn_sched_barrier(0)
#define PG8_APTR(u) ((const char*)g.A + (size_t)(u).pm * tstepA + (size_t)(u).pn * g.a_pn_step)
#define PG8_BPTR(u) ((const char*)g.Bt + (size_t)(u).pn * g.b_tstep + (g.tile_e ? (size_t)g.tile_e[(u).pm] * g.b_estep : (size_t)0))
    Unit cur, nxt; int ui = 0;
    if (!S.next(0, cur)) return;
    f32x4 acc[2][2][4][2];
#pragma unroll
    for (int a = 0; a < 2; ++a)
#pragma unroll
        for (int b = 0; b < 2; ++b)
#pragma unroll
            for (int m = 0; m < 4; ++m)
#pragma unroll
                for (int n = 0; n < 2; ++n) acc[a][b][m][n] = (f32x4){0.f, 0.f, 0.f, 0.f};
    bf16x8 At[4][2], B0[2][2], B1[2][2];
    const char* cA = PG8_APTR(cur); const char* cB = PG8_BPTR(cur);
    S.a_ready(cur);
    if constexpr (SP2) {
        PG8_STAGE(PG8_SB(0, 0), cB, voffB); PG8_STAGE(PG8_SB(0, 1), cB + hstepB, voffB); PG8_STAGE(PG8_SA(0, 0), cA, voffA); PG8_STAGE(PG8_SA(0, 1), cA + hstepA, voffA);
        if (wr == 1) PG8_BAR;
        PG8_WAIT_V(2); PG8_BAR;
        PG8_STAGE(PG8_SB(1, 0), cB + kstep, voffB); PG8_STAGE(PG8_SA(1, 0), cA + kstep, voffA); PG8_STAGE(PG8_SB(1, 1), cB + hstepB + kstep, voffB);
        PG8_WAIT_V(6); PG8_BAR;
    } else {
        PG8_STAGE(PG8_SB(0, 0), cB, voffB); PG8_STAGE(PG8_SA(0, 0), cA, voffA); PG8_STAGE(PG8_SB(0, 1), cB + hstepB, voffB); PG8_STAGE(PG8_SA(0, 1), cA + hstepA, voffA);
        if (wr == 1) PG8_BAR;
        PG8_WAIT_V(4); PG8_BAR;
        PG8_STAGE(PG8_SB(1, 0), cB + kstep, voffB); PG8_STAGE(PG8_SA(1, 0), cA + kstep, voffA); PG8_STAGE(PG8_SB(1, 1), cB + hstepB + kstep, voffB);
        PG8_WAIT_V(6); PG8_BAR;
    }
    for (;;) {
        const bool has_next = S.next(ui + 1, nxt);
        const char* nA = has_next ? PG8_APTR(nxt) : cA; const char* nB = has_next ? PG8_BPTR(nxt) : cB;
        for (int t = 0; t < nt; t += 2) {
            const bool last = (t == nt - 2);
            const char* a1 = cA + (size_t)(t + 1) * kstep;
            const char* a2 = last ? nA : cA + (size_t)(t + 2) * kstep; const char* b2 = last ? nB : cB + (size_t)(t + 2) * kstep;
            const char* a3 = a2 + kstep; const char* b3 = b2 + kstep;
            if (last && has_next) S.a_ready(nxt);
            if constexpr (SP2) {
            PG8_LDB(B0, 0, 0); PG8_LDB(B1, 0, 1); PG8_SCHED; PG8_LDA(At, 0, 0); PG8_STAGE(PG8_SA(1, 1), a1 + hstepA, voffA);
            PG8_WAIT_V(8); PG8_WAIT_L(0); PG8_BAR; PG8_MMA(0, 0, At, B0); PG8_MMA(0, 1, At, B1); PG8_BAR; PG8_SCHED;
            PG8_LDA(At, 0, 1); PG8_STAGE(PG8_SB(0, 0), b2, voffB); PG8_STAGE(PG8_SB(0, 1), b2 + hstepB, voffB); PG8_STAGE(PG8_SA(0, 0), a2, voffA);
            PG8_WAIT_V(8); PG8_WAIT_L(0); PG8_BAR; PG8_MMA(1, 0, At, B0); PG8_MMA(1, 1, At, B1); PG8_BAR; PG8_SCHED;
            PG8_LDB(B0, 1, 0); PG8_LDB(B1, 1, 1); PG8_SCHED; PG8_LDA(At, 1, 0); PG8_STAGE(PG8_SA(0, 1), a2 + hstepA, voffA);
            PG8_WAIT_V(8); PG8_WAIT_L(0); PG8_BAR; PG8_MMA(0, 0, At, B0); PG8_MMA(0, 1, At, B1); PG8_BAR; PG8_SCHED;
            PG8_LDA(At, 1, 1); PG8_STAGE(PG8_SB(1, 0), b3, voffB); PG8_STAGE(PG8_SB(1, 1), b3 + hstepB, voffB); PG8_STAGE(PG8_SA(1, 0), a3, voffA);
            PG8_WAIT_V(8); PG8_WAIT_L(0); PG8_BAR; PG8_MMA(1, 0, At, B0); PG8_MMA(1, 1, At, B1); PG8_BAR; PG8_SCHED;
            } else {
            PG8_LDB(B0, 0, 0); PG8_SCHED; PG8_LDA(At, 0, 0); PG8_STAGE(PG8_SA(1, 1), a1 + hstepA, voffA);
            PG8_WAIT_L(8); PG8_BAR; PG8_WAIT_L(0); PG8_MMA(0, 0, At, B0); PG8_BAR; PG8_SCHED;
            PG8_LDB(B1, 0, 1); PG8_STAGE(PG8_SB(0, 0), b2, voffB);
            PG8_BAR; PG8_WAIT_L(0); PG8_MMA(0, 1, At, B1); PG8_BAR;
            PG8_LDA(At, 0, 1); PG8_STAGE(PG8_SA(0, 0), a2, voffA);
            PG8_BAR; PG8_WAIT_L(0); PG8_MMA(1, 0, At, B0); PG8_BAR; PG8_SCHED;
            PG8_STAGE(PG8_SB(0, 1), b2 + hstepB, voffB);
            PG8_WAIT_V(6); PG8_BAR; PG8_MMA(1, 1, At, B1); PG8_BAR;
            PG8_LDB(B0, 1, 0); PG8_SCHED; PG8_LDA(At, 1, 0); PG8_STAGE(PG8_SA(0, 1), a2 + hstepA, voffA);
            PG8_WAIT_L(8); PG8_BAR; PG8_WAIT_L(0); PG8_MMA(0, 0, At, B0); PG8_BAR; PG8_SCHED;
            PG8_LDB(B1, 1, 1); PG8_STAGE(PG8_SB(1, 0), b3, voffB);
            PG8_BAR; PG8_WAIT_L(0); PG8_MMA(0, 1, At, B1); PG8_BAR;
            PG8_LDA(At, 1, 1); PG8_STAGE(PG8_SA(1, 0), a3, voffA);
            PG8_BAR; PG8_WAIT_L(0); PG8_MMA(1, 0, At, B0); PG8_BAR; PG8_SCHED;
            PG8_STAGE(PG8_SB(1, 1), b3 + hstepB, voffB);
            PG8_WAIT_V(6); PG8_BAR; PG8_MMA(1, 1, At, B1); PG8_BAR;
            }
        }
        if constexpr (ALIGN_EPI) { if (wr == 0) PG8_BAR; }
        if constexpr (!Epi::AFTER_DRAIN) { E(acc, cur, wr, wc, fr, fq); S.done(cur); }
        if (!has_next) break;
#pragma unroll
        for (int a = 0; a < 2; ++a)
#pragma unroll
            for (int b = 0; b < 2; ++b)
#pragma unroll
                for (int m = 0; m < 4; ++m)
#pragma unroll
                    for (int n = 0; n < 2; ++n) acc[a][b][m][n] = (f32x4){0.f, 0.f, 0.f, 0.f};
        cur = nxt; cA = nA; cB = nB; ++ui;
        if constexpr (ALIGN_EPI) { if (wr == 1) PG8_BAR; }
    }
    PG8_WAIT_V(0);
    if constexpr (!ALIGN_EPI) { if (wr == 0) PG8_BAR; }
    PG8_BAR;
    if constexpr (Epi::AFTER_DRAIN) { E.fused(acc, cur, wr, wc, fr, fq, lds, wid, lane); S.done(cur); }
#undef PG8_SA
#undef PG8_SB
#undef PG8_STAGE
#undef PG8_LDA
#undef PG8_LDB
#undef PG8_MMA
#undef PG8_WAIT_V
#undef PG8_WAIT_L
#undef PG8_BAR
#undef PG8_SCHED
#undef PG8_APTR
#undef PG8_BPTR
}
}

#define XB_TMO      128
#define XB_XCNT(j)  (256  + 64 * (j))
#define XB_XSUB(j)  (1280 + 64 * (j))
#define XB_XGEN(j)  (2304 + 64 * (j))
#define XB_TOP      3328
#define XB_TOPGEN   3392
#define XCD_BAR_WORDS 3456
#define XB_SPIN_CAP (1u << 28)
__device__ __forceinline__ unsigned xb_ld(unsigned* p)              { return __hip_atomic_load(p, __ATOMIC_RELAXED, __HIP_MEMORY_SCOPE_AGENT); }
__device__ __forceinline__ unsigned xb_add(unsigned* p, unsigned v) { return __hip_atomic_fetch_add(p, v, __ATOMIC_RELAXED, __HIP_MEMORY_SCOPE_AGENT); }
__device__ __forceinline__ unsigned xb_xcc_id() { return (unsigned)__builtin_amdgcn_s_getreg((3 << 11) | 20) & 0xFu; }
#define XB_SPIN(cond, bar) do { unsigned _sp = 0; while (cond) { __builtin_amdgcn_s_sleep(1); \
    if ((++_sp & 255u) == 0u) { if (xb_ld(&(bar)[XB_TMO])) break; if (_sp > XB_SPIN_CAP) { atomicAdd(&(bar)[XB_TMO], 1u); break; } } } } while (0)
struct XcdBarrier { unsigned* bar; unsigned x; volatile LAS unsigned* st; };
__device__ __forceinline__ XcdBarrier xcd_barrier_post(unsigned* bar, volatile LAS unsigned* st) {
    XcdBarrier b; b.bar = bar; b.x = xb_xcc_id(); b.st = st;
    if (threadIdx.x == 0) (void)xb_add(&bar[XB_XCNT(b.x)], 1u);
    return b;
}
__device__ __forceinline__ void xcd_barrier_complete(unsigned* bar, unsigned x, unsigned& nloc, unsigned& nx) {
    const unsigned G = gridDim.x * gridDim.y * gridDim.z;
    unsigned sum, cnt, mine, sp = 0u;
    for (;;) {
        sum = 0u; cnt = 0u; mine = 0u;
#pragma unroll
        for (unsigned j = 0; j < 16; ++j) { const unsigned c = xb_ld(&bar[XB_XCNT(j)]); sum += c; cnt += (c > 0u) ? 1u : 0u; mine = (j == x) ? c : mine; }
        if (sum == G) break;
        __builtin_amdgcn_s_sleep(1);
        if ((++sp & 255u) == 0u) { if (xb_ld(&bar[XB_TMO])) break; if (sp > XB_SPIN_CAP) { atomicAdd(&bar[XB_TMO], 1u); break; } }
    }
    nloc = mine > 0u ? mine : 1u; nx = cnt > 0u ? cnt : 1u;
}
__device__ __forceinline__ void xcd_barrier(const XcdBarrier& b) {
    asm volatile("s_waitcnt vmcnt(0)" ::: "memory");
    __syncthreads();
    if (threadIdx.x == 0) {
        unsigned* bar = b.bar;
        __builtin_amdgcn_s_waitcnt(0);
        unsigned nloc = b.st[0], nx = b.st[1];
        if (nloc == 0u) { xcd_barrier_complete(bar, b.x, nloc, nx); b.st[0] = nloc; b.st[1] = nx; }
        const unsigned old = xb_add(&bar[XB_XSUB(b.x)], 1u);
        const unsigned gen = old / nloc;
        if (old + 1u == (gen + 1u) * nloc) {
            __builtin_amdgcn_fence(__ATOMIC_RELEASE, "agent");
            asm volatile("s_waitcnt vmcnt(0)" ::: "memory");
            const unsigned og = xb_add(&bar[XB_TOP], 1u);
            const unsigned tg = og / nx;
            if (og + 1u == (tg + 1u) * nx) xb_add(&bar[XB_TOPGEN], 1u);
            else XB_SPIN(xb_ld(&bar[XB_TOPGEN]) == tg, bar);
            __builtin_amdgcn_fence(__ATOMIC_ACQUIRE, "agent");
            xb_add(&bar[XB_XGEN(b.x)], 1u);
            asm volatile("s_waitcnt vmcnt(0)" ::: "memory");
        } else {
            XB_SPIN(xb_ld(&bar[XB_XGEN(b.x)]) == gen, bar);
            __builtin_amdgcn_fence(__ATOMIC_ACQUIRE, "agent");
            asm volatile("s_waitcnt vmcnt(0)" ::: "memory");
        }
    }
    __syncthreads();
}

constexpr int NWAVES = 8;
constexpr int RING_BYTES = 131072, LDSCTL_OFF = RING_BYTES, MISC_OFF = LDSCTL_OFF + 320, LDS_BYTES = 147456;
constexpr int CW_BAR = 4096;
constexpr size_t W_GU0 = 209 * MiB, W_D0 = 220 * MiB, W_OUT0 = 225 * MiB + 512 * 1024, W_XQ0 = 227 * MiB + 512 * 1024, W_XO0 = 229 * MiB + 512 * 1024;
constexpr size_t W_IN0 = 265 * MiB, W_XK0 = 272 * MiB, W_XV0 = 274 * MiB;
constexpr size_t W_IN1 = 409 * MiB, W_OUT1 = 417 * MiB + 512 * 1024, W_XQ1 = 420 * MiB + 512 * 1024, W_XK1 = 422 * MiB + 512 * 1024, W_XV1 = 424 * MiB + 512 * 1024, W_XO1 = 426 * MiB + 512 * 1024;
constexpr size_t WS_MEMB = 428 * MiB + 512 * 1024, WS_KMEM0 = 429 * MiB, WS_VT0 = 429 * MiB + 512 * 1024, WS_KMEM1 = 430 * MiB, WS_VT1 = 430 * MiB + 512 * 1024;
constexpr size_t WS_HM = 65 * MiB, WS_XG = 159 * MiB, WS_YR = 227 * MiB, WS_RT = 291 * MiB, W_EGU = 292 * MiB, W_ED = 380 * MiB;
constexpr size_t EGU_STEP = 11 * MiB, ED_STEP = 5 * MiB + 512 * 1024;
constexpr size_t RT_TOPE = 0, RT_GATE = 128 * 1024, RT_ROWTOK = 256 * 1024, RT_SLOTROW = 512 * 1024, RT_TILEE = 640 * 1024, RT_META = 704 * 1024, RT_BC = 768 * 1024;

struct MArgs { const float* in[54]; float* out; unsigned char* ws; int ph_lo, ph_hi, li, pad; };
constexpr int PTAB_OFF = MISC_OFF + 128;
struct PTab { const LAS unsigned* t;
    __device__ __forceinline__ const float* operator[](int i) const { const unsigned lo = __builtin_amdgcn_readfirstlane(t[2 * i]), hi = __builtin_amdgcn_readfirstlane(t[2 * i + 1]);
        return (const float*)(((unsigned long long)hi << 32) | lo); } };
struct Ctx { PTab in; float* out; unsigned char* ws; };

struct CvtJob { const float* W0; const float* W1; bf16* dst; int ld, K, ndst, mode; };
__device__ __forceinline__ const float* cvt_src(const CvtJob& j, int n) {
    switch (j.mode) {
        case 0: return j.W0 + n;
        case 1: return n < 1552 ? j.W0 + n : (n < 1792 ? nullptr : j.W0 + (n - 240));
        case 2: return n < 2560 ? j.W0 + n : (n < 4096 ? j.W0 + (n + 16) : (n < 4112 ? j.W0 + (2560 + n - 4096) : nullptr));
        default: { const int pn = n >> 8, r = n & 255; return r < 128 ? j.W0 + (128 * pn + r) : j.W1 + (128 * pn + r - 128); }
    }
}
__device__ __forceinline__ unsigned pk2(float lo, float hi) { return (unsigned)f2bf(lo) | ((unsigned)f2bf(hi) << 16); }
__device__ __forceinline__ void cvt_item(const CvtJob& j, LAS float* scr, int item, int lane) {
    const int nblk = j.ndst / 32, kb = item / nblk, nb = item % nblk, k0 = 64 * kb, n0 = 32 * nb;
    const float* colp = cvt_src(j, n0 + (lane & 31));
#pragma unroll 8
    for (int i = 0; i < 32; ++i) { const int kk = 2 * i + (lane >> 5); scr[kk * 33 + (lane & 31)] = colp ? colp[(size_t)(k0 + kk) * j.ld] : 0.f; }
    asm volatile("s_waitcnt lgkmcnt(0)" ::: "memory");
    const int c = lane & 7;
#pragma unroll
    for (int jj = 0; jj < 4; ++jj) { const int n = (lane >> 3) + 8 * jj; const LAS float* sp = scr + (8 * c) * 33 + n;
        uint4 o; o.x = pk2(sp[0 * 33], sp[1 * 33]); o.y = pk2(sp[2 * 33], sp[3 * 33]); o.z = pk2(sp[4 * 33], sp[5 * 33]); o.w = pk2(sp[6 * 33], sp[7 * 33]);
        *(uint4*)(j.dst + (size_t)(n0 + n) * j.K + k0 + 8 * c) = o; }
    asm volatile("s_waitcnt lgkmcnt(0)" ::: "memory");
}
__device__ __forceinline__ CvtJob get_cvt_job(int idx, const Ctx& a) {
    unsigned char* ws = a.ws; CvtJob j; j.W1 = nullptr; j.mode = 0; j.ld = 1024; j.K = 1024; j.ndst = 1024;
    switch (idx) {
        case 0: j.W0 = a.in[2]; j.dst = (bf16*)(ws + W_IN0); j.ld = 3344; j.ndst = NP0; j.mode = 1; break;
        case 1: j.W0 = a.in[17]; j.dst = (bf16*)(ws + W_OUT0); break;
        case 2: j.W0 = a.in[20]; j.dst = (bf16*)(ws + W_XQ0); break;
        case 3: j.W0 = a.in[21]; j.dst = (bf16*)(ws + W_XK0); break;
        case 4: j.W0 = a.in[22]; j.dst = (bf16*)(ws + W_XV0); break;
        case 5: j.W0 = a.in[23]; j.dst = (bf16*)(ws + W_XO0); break;
        case 6: j.W0 = a.in[26]; j.W1 = a.in[27]; j.dst = (bf16*)(ws + W_GU0); j.ld = 2816; j.ndst = 5632; j.mode = 3; break;
        case 7: j.W0 = a.in[28]; j.dst = (bf16*)(ws + W_D0); j.K = 2816; break;
        case 8: j.W0 = a.in[31]; j.dst = (bf16*)(ws + W_IN1); j.ld = 4112; j.ndst = NP1; j.mode = 2; break;
        case 9: j.W0 = a.in[38]; j.dst = (bf16*)(ws + W_OUT1); j.K = 1536; break;
        case 10: j.W0 = a.in[41]; j.dst = (bf16*)(ws + W_XQ1); break;
        case 11: j.W0 = a.in[42]; j.dst = (bf16*)(ws + W_XK1); break;
        case 12: j.W0 = a.in[43]; j.dst = (bf16*)(ws + W_XV1); break;
        case 13: j.W0 = a.in[44]; j.dst = (bf16*)(ws + W_XO1); break;
        default: { const int e = (idx - 14) >> 1;
            if ((idx & 1) == 0) { j.W0 = a.in[49] + (size_t)e * 1024 * 2816; j.W1 = a.in[50] + (size_t)e * 1024 * 2816; j.dst = (bf16*)(ws + W_EGU + e * EGU_STEP); j.ld = 2816; j.ndst = 5632; j.mode = 3; }
            else { j.W0 = a.in[51] + (size_t)e * 2816 * 1024; j.dst = (bf16*)(ws + W_ED + e * ED_STEP); j.K = 2816; } } break;
    }
    return j;
}
__device__ __forceinline__ void cvt_jobs(int j_lo, int j_hi, const Ctx& args, LAS float* scr, int gw, int NGW, int ln) {
    int base = 0;
    for (int ji = j_lo; ji < j_hi; ++ji) {
        const CvtJob j = get_cvt_job(ji, args);
        const int nitems = (j.K / 64) * (j.ndst / 32);
        const int first = (gw - base % NGW + NGW) % NGW;
        for (int it = first; it < nitems; it += NGW) cvt_item(j, scr, it, ln);
        base += nitems;
    }
}
__device__ __forceinline__ void ln_row(const float* in, float* outf, bf16* outb, const float* g, const float* b, int lane, float4 (&o)[4]) {
    const float4* p = (const float4*)in + lane;
    float4 v[4]; float s = 0.f;
#pragma unroll
    for (int j = 0; j < 4; ++j) { v[j] = p[64 * j]; s += (v[j].x + v[j].y) + (v[j].z + v[j].w); }
    const float mean = wave_sum(s) * (1.f / D); float q = 0.f;
#pragma unroll
    for (int j = 0; j < 4; ++j) { v[j].x -= mean; v[j].y -= mean; v[j].z -= mean; v[j].w -= mean; q += (v[j].x * v[j].x + v[j].y * v[j].y) + (v[j].z * v[j].z + v[j].w * v[j].w); }
    const float rstd = 1.f / sqrtf(wave_sum(q) * (1.f / D) + 1e-5f);
#pragma unroll
    for (int j = 0; j < 4; ++j) {
        const int col = 4 * (lane + 64 * j);
        const float4 gg = *(const float4*)(g + col), bb = *(const float4*)(b + col);
        o[j].x = v[j].x * rstd * gg.x + bb.x; o[j].y = v[j].y * rstd * gg.y + bb.y; o[j].z = v[j].z * rstd * gg.z + bb.z; o[j].w = v[j].w * rstd * gg.w + bb.w;
        *(float4*)(outf + col) = o[j];
        if (outb) { uint2 w; w.x = pk2(o[j].x, o[j].y); w.y = pk2(o[j].z, o[j].w); *(uint2*)(outb + col) = w; }
    }
}
__device__ __forceinline__ int wave_sum_i(int v) {
#pragma unroll
    for (int o = 1; o < 64; o <<= 1) v += __shfl_xor(v, o);
    return v;
}

enum { K_PROLOGUE = 0, K_GEMM_BF, K_GEMM_RES, K_GEMM_SILU, K_GEMM_SOFTMAX, K_GEMM_YR, K_LN, K_L0_PREP, K_L0_SCAN, K_L0_FIN, K_L1_PREP, K_L1_SCAN, K_L1_FIN, K_MOE_ROUTE, K_MOE_ASSIGN, K_MOE_FINAL };
enum { F_KIND = 0, F_SYNC, F_MR, F_N, F_ROT, F_LDC, F_DYN, F_K, F_LDA, F_LDB, F_SCALE, F_PAD, F_A = 12, F_BT = 14, F_TILEE = 16, F_APN = 18, F_BTS = 20, F_BES = 22, F_O = 24, F_BASE = 26, F_OUTF = 28, F_LNG = 30, F_LNB = 32, STEP_DW = 40 };
constexpr int N_STEPS = 36;
constexpr int STAB_OFF = PTAB_OFF + 576;
static_assert(STAB_OFF + N_STEPS * STEP_DW * 4 <= LDS_BYTES, "LDS control area");
struct StepW { LAS unsigned* d;
    __device__ __forceinline__ void i(int f, int v) const { d[f] = (unsigned)v; }
    __device__ __forceinline__ void f(int fi, float v) const { d[fi] = __float_as_uint(v); }
    __device__ __forceinline__ void p(int f, const void* v) const { const unsigned long long q = (unsigned long long)v; d[f] = (unsigned)q; d[f + 1] = (unsigned)(q >> 32); }
    __device__ __forceinline__ void u(int f, size_t q) const { d[f] = (unsigned)q; d[f + 1] = (unsigned)(q >> 32); } };
struct StepR { const LAS unsigned* d;
    __device__ __forceinline__ int i(int f) const { return (int)__builtin_amdgcn_readfirstlane(d[f]); }
    __device__ __forceinline__ float f(int fi) const { return __uint_as_float(__builtin_amdgcn_readfirstlane(d[fi])); }
    __device__ __forceinline__ unsigned long long u(int f) const { const unsigned lo = __builtin_amdgcn_readfirstlane(d[f]), hi = __builtin_amdgcn_readfirstlane(d[f + 1]); return ((unsigned long long)hi << 32) | lo; }
    template <class T> __device__ __forceinline__ T* p(int f) const { return (T*)u(f); } };
__device__ __forceinline__ void build_step(int s, LAS unsigned* d, const float* const* in, float* out, unsigned char* ws) {
    float* XFA = (float*)(ws + WS_XFA); float* XFB = out; bf16* XB = (bf16*)(ws + WS_XB); bf16* P = (bf16*)(ws + WS_P); bf16* OMIX = (bf16*)(ws + WS_OMIX);
    bf16* Q = (bf16*)(ws + WS_P); bf16* PATT = (bf16*)(ws + WS_P + 32 * MiB); bf16* OX = (bf16*)(ws + WS_P + 64 * MiB); bf16* H = (bf16*)(ws + WS_P);
    bf16* MEMB = (bf16*)(ws + WS_MEMB);
    const StepW t{d};
    for (int k = 0; k < STEP_DW; ++k) d[k] = 0u;
    t.i(F_KIND, K_GEMM_BF); t.i(F_SYNC, 1); t.i(F_MR, M); t.i(F_N, 1024); t.i(F_LDC, 1024); t.f(F_SCALE, 1.f);
    t.p(F_A, XB); t.u(F_BTS, (size_t)256 * 1024 * 2); t.i(F_LDA, 1024); t.i(F_LDB, 1024); t.i(F_K, 1024);
    const int L = (s >= 20) ? 1 : 0;
    switch (s) {
        case 0: t.i(F_KIND, K_PROLOGUE); break;
        case 1: t.p(F_BT, ws + W_IN0); t.i(F_N, NP0); t.p(F_O, P); t.i(F_LDC, NP0); t.i(F_SYNC, 0); break;
        case 2: t.p(F_A, MEMB); t.p(F_BT, ws + W_XK0); t.i(F_MR, 256); t.p(F_O, ws + WS_KMEM0); t.i(F_SYNC, 0); t.i(F_ROT, 128); break;
        case 3: t.p(F_A, ws + W_XV0); t.p(F_BT, MEMB); t.i(F_MR, 1024); t.i(F_N, 256); t.p(F_O, ws + WS_VT0); t.i(F_LDC, 256); t.i(F_SYNC, 0); t.i(F_ROT, 132); break;
        case 4: t.p(F_A, MEMB); t.p(F_BT, ws + W_XK1); t.i(F_MR, 256); t.p(F_O, ws + WS_KMEM1); t.i(F_SYNC, 0); t.i(F_ROT, 136); break;
        case 5: t.p(F_A, ws + W_XV1); t.p(F_BT, MEMB); t.i(F_MR, 1024); t.i(F_N, 256); t.p(F_O, ws + WS_VT1); t.i(F_LDC, 256); t.i(F_ROT, 140); break;
        case 6: t.i(F_KIND, K_L0_PREP); break;
        case 7: t.i(F_KIND, K_L0_SCAN); break;
        case 8: t.i(F_KIND, K_L0_FIN); break;
        case 9: t.i(F_KIND, K_GEMM_RES); t.p(F_A, OMIX); t.p(F_BT, ws + W_OUT0); t.p(F_BASE, in[0]); t.p(F_OUTF, XFA); break;
        case 10: t.i(F_KIND, K_LN); t.p(F_OUTF, XFA); t.p(F_LNG, in[18]); t.p(F_LNB, in[19]); break;
        case 11: case 25: t.p(F_BT, ws + (L ? W_XQ1 : W_XQ0)); t.p(F_O, Q); t.f(F_SCALE, 0.0625f); break;
        case 12: case 26: t.i(F_KIND, K_GEMM_SOFTMAX); t.p(F_A, Q); t.u(F_APN, 512); t.p(F_BT, ws + (L ? WS_KMEM1 : WS_KMEM0)); t.u(F_BTS, 512); t.i(F_K, 256); t.p(F_O, PATT); break;
        case 13: case 27: t.p(F_A, PATT); t.u(F_APN, 512); t.p(F_BT, ws + (L ? WS_VT1 : WS_VT0)); t.i(F_LDB, 256); t.u(F_BTS, (size_t)256 * 256 * 2); t.i(F_K, 256); t.p(F_O, OX); break;
        case 14: t.i(F_KIND, K_GEMM_RES); t.p(F_A, OX); t.p(F_BT, ws + W_XO0); t.p(F_BASE, XFA); t.p(F_OUTF, XFB); break;
        case 15: t.i(F_KIND, K_LN); t.p(F_OUTF, XFB); t.p(F_LNG, in[24]); t.p(F_LNB, in[25]); break;
        case 16: t.i(F_KIND, K_GEMM_SILU); t.p(F_BT, ws + W_GU0); t.i(F_N, 5632); t.p(F_O, H); t.i(F_LDC, 2816); break;
        case 17: t.i(F_KIND, K_GEMM_RES); t.p(F_A, H); t.i(F_LDA, 2816); t.i(F_K, 2816); t.p(F_BT, ws + W_D0); t.i(F_LDB, 2816); t.u(F_BTS, (size_t)256 * 2816 * 2); t.p(F_BASE, XFB); t.p(F_OUTF, XFA); break;
        case 18: t.i(F_KIND, K_LN); t.p(F_OUTF, XFA); t.p(F_LNG, in[29]); t.p(F_LNB, in[30]); break;
        case 19: t.p(F_BT, ws + W_IN1); t.i(F_N, NP1); t.p(F_O, P); t.i(F_LDC, NP1); break;
        case 20: t.i(F_KIND, K_L1_PREP); break;
        case 21: t.i(F_KIND, K_L1_SCAN); break;
        case 22: t.i(F_KIND, K_L1_FIN); break;
        case 23: t.i(F_KIND, K_GEMM_RES); t.p(F_A, OMIX); t.i(F_LDA, 1536); t.i(F_K, 1536); t.p(F_BT, ws + W_OUT1); t.i(F_LDB, 1536); t.u(F_BTS, (size_t)256 * 1536 * 2); t.p(F_BASE, XFA); t.p(F_OUTF, XFB); break;
        case 24: t.i(F_KIND, K_LN); t.p(F_OUTF, XFB); t.p(F_LNG, in[39]); t.p(F_LNB, in[40]); break;
        case 28: t.i(F_KIND, K_GEMM_RES); t.p(F_A, OX); t.p(F_BT, ws + W_XO1); t.p(F_BASE, XFB); t.p(F_OUTF, XFA); break;
        case 29: t.i(F_KIND, K_MOE_ROUTE); t.p(F_OUTF, XFA); t.p(F_LNG, in[45]); t.p(F_LNB, in[46]); break;
        case 30: t.i(F_KIND, K_MOE_ASSIGN); break;
        case 31: case 33: t.i(F_KIND, K_GEMM_SILU); t.i(F_DYN, s == 31 ? 1 : 2); t.p(F_TILEE, ws + WS_RT + RT_TILEE); t.p(F_A, ws + WS_XG); t.p(F_BT, ws + W_EGU); t.u(F_BES, EGU_STEP); t.i(F_N, 5632); t.p(F_O, ws + WS_HM); t.i(F_LDC, 2816); break;
        case 32: case 34: t.i(F_KIND, K_GEMM_YR); t.i(F_DYN, s == 32 ? 1 : 2); t.p(F_TILEE, ws + WS_RT + RT_TILEE); t.p(F_A, ws + WS_HM); t.i(F_LDA, 2816); t.i(F_K, 2816); t.p(F_BT, ws + W_ED); t.i(F_LDB, 2816);
            t.u(F_BTS, (size_t)256 * 2816 * 2); t.u(F_BES, ED_STEP); t.p(F_O, ws + WS_YR); break;
        default: t.i(F_KIND, K_MOE_FINAL); break;
    }
}
struct GemmSetup { pg8::Gemm g; int Mr, N, rot, row_off; };
__device__ __forceinline__ GemmSetup load_gemm(const StepR& r, const unsigned char* ws) {
    GemmSetup q; q.g.A = r.p<const bf16>(F_A); q.g.Bt = r.p<const bf16>(F_BT); q.g.tile_e = r.p<const int>(F_TILEE); q.g.a_pn_step = r.u(F_APN); q.g.b_tstep = r.u(F_BTS); q.g.b_estep = r.u(F_BES);
    q.g.lda = r.i(F_LDA); q.g.ldb = r.i(F_LDB); q.g.K = r.i(F_K); q.g.pad = 0; q.Mr = r.i(F_MR); q.N = r.i(F_N); q.rot = r.i(F_ROT); q.row_off = 0;
    const int dyn = r.i(F_DYN);
    if (dyn) {
        const int ntl = __builtin_amdgcn_readfirstlane(((const int*)(ws + WS_RT + RT_META))[16]) >> 8, T0 = (ntl + 1) >> 1, toff = (dyn == 2) ? T0 : 0, nt = (dyn == 2) ? ntl - T0 : T0;
        q.Mr = nt * 256; q.row_off = toff * 256; q.g.tile_e += toff;
        if (q.g.lda == 1024) q.g.A += (size_t)toff * 256 * 1024;
    }
    return q;
}

__global__ void __launch_bounds__(NWAVES * 64, 2) mega(MArgs args) {
    extern __shared__ __attribute__((aligned(16))) unsigned char lds_raw[];
    LAS unsigned char* lds = (LAS unsigned char*)lds_raw;
    volatile LAS unsigned* MISC = (volatile LAS unsigned*)(lds + MISC_OFF);
    const int tid = threadIdx.x, lane = tid & 63, wave = __builtin_amdgcn_readfirstlane(tid >> 6);
    const int G = gridDim.x; const int bx = blockIdx.x;
    const int vcu = (G % 8 == 0) ? (bx % 8) * (G / 8) + bx / 8 : bx;
    for (int u = tid; u < (LDS_BYTES - LDSCTL_OFF) / 4; u += NWAVES * 64) ((LAS unsigned*)(lds + LDSCTL_OFF))[u] = 0u;
    __syncthreads();
    unsigned* ctl = (unsigned*)(args.ws + WS_CTL);
    XcdBarrier bar = xcd_barrier_post(ctl + CW_BAR + args.li * XCD_BAR_WORDS, MISC + 8);
    const int gw = vcu * NWAVES + wave, NGW = G * NWAVES;
    if (tid < 54) { const unsigned long long p = (unsigned long long)args.in[tid]; LAS unsigned* pt = (LAS unsigned*)(lds + PTAB_OFF); pt[2 * tid] = (unsigned)p; pt[2 * tid + 1] = (unsigned)(p >> 32); }
    if (tid == 64)
#pragma unroll 1
        for (int k = 0; k < N_STEPS; ++k) build_step(k, (LAS unsigned*)(lds + STAB_OFF) + k * STEP_DW, args.in, args.out, args.ws);
    __syncthreads();
    const int ph_hi = args.ph_hi;

    for (int s = args.ph_lo; s < ph_hi; ++s) {
        Ctx cx; cx.in.t = (const LAS unsigned*)(lds + PTAB_OFF); cx.out = args.out; cx.ws = args.ws;
        asm volatile("" : "+s"(cx.ws), "+s"(cx.out));
        unsigned char* const ws = cx.ws;
        const StepR st{(const LAS unsigned*)(lds + STAB_OFF) + s * STEP_DW};
        const int kind = st.i(F_KIND);
        int tl = tid; asm volatile("" : "+v"(tl));
        const int ln = tl & 63;
        const int gt = (vcu * NWAVES + wave) * 64 + ln, GT = NGW * 64;
        switch (kind) {
            case K_PROLOGUE: {
                cvt_jobs(0, 14, cx, (LAS float*)(lds + wave * 16384), gw, NGW, ln);
                const float4* x4 = (const float4*)cx.in[0]; uint2* o2 = (uint2*)(ws + WS_XB);
                for (size_t i = (size_t)gw * 64 + ln; i < (size_t)M * D / 4; i += (size_t)NGW * 64) { const float4 v = x4[i]; uint2 w; w.x = pk2(v.x, v.y); w.y = pk2(v.z, v.w); o2[i] = w; }
                const float4* m4 = (const float4*)cx.in[1]; uint2* mo = (uint2*)(ws + WS_MEMB);
                for (size_t i = (size_t)gw * 64 + ln; i < (size_t)256 * D / 4; i += (size_t)NGW * 64) { const float4 v = m4[i]; uint2 w; w.x = pk2(v.x, v.y); w.y = pk2(v.z, v.w); mo[i] = w; }
            } break;
            case K_GEMM_BF: { const GemmSetup q = load_gemm(st, ws); pg8::StaticOrder S; S.init(q.Mr, q.N, G, (bx + G - q.rot) % G); pg8::EpBf E{st.p<bf16>(F_O), st.i(F_LDC), st.f(F_SCALE)};
                pg8::gemm_phase<pg8::EpBf, pg8::StaticOrder, true, true>(lds, q.g, S, E, tl); } break;
            case K_GEMM_RES: { const GemmSetup q = load_gemm(st, ws); pg8::StaticOrder S; S.init(q.Mr, q.N, G, bx); pg8::EpRes E{st.p<const float>(F_BASE), st.p<float>(F_OUTF)};
                pg8::gemm_phase<pg8::EpRes, pg8::StaticOrder, true, true>(lds, q.g, S, E, tl); } break;
            case K_GEMM_SILU: { const GemmSetup q = load_gemm(st, ws); pg8::StaticOrder S; S.init(q.Mr, q.N, G, bx); pg8::EpSilu E{st.p<bf16>(F_O), st.i(F_LDC), 0};
                pg8::gemm_phase<pg8::EpSilu, pg8::StaticOrder, true, true>(lds, q.g, S, E, tl); } break;
            case K_GEMM_SOFTMAX: { const GemmSetup q = load_gemm(st, ws); pg8::StaticOrder S; S.init(q.Mr, q.N, G, bx); pg8::EpSoftmax E{st.p<bf16>(F_O), st.i(F_LDC), 0};
                pg8::gemm_phase<pg8::EpSoftmax, pg8::StaticOrder, false, true>(lds, q.g, S, E, tl); } break;
            case K_GEMM_YR: { const GemmSetup q = load_gemm(st, ws); pg8::StaticOrder S; S.init(q.Mr, q.N, G, bx);
                pg8::EpYR E{st.p<bf16>(F_O), (const int*)(ws + WS_RT + RT_ROWTOK) + q.row_off, q.g.tile_e, (const int*)(ws + WS_RT + RT_META), q.row_off, 0};
                pg8::gemm_phase<pg8::EpYR, pg8::StaticOrder, true, true>(lds, q.g, S, E, tl); } break;
            case K_LN: {
                bf16* XB = (bf16*)(ws + WS_XB); float4 o[4];
                float* xf = st.p<float>(F_OUTF); const float* lg = st.p<const float>(F_LNG); const float* lb = st.p<const float>(F_LNB);
                for (int r = gw; r < M; r += NGW) ln_row(xf + (size_t)r * D, xf + (size_t)r * D, XB + (size_t)r * D, lg, lb, ln, o);
            } break;
            case K_L0_PREP: {
                const bf16* P = (const bf16*)(ws + WS_P);
                float* EA = (float*)(ws + WS_XB);
                for (int idx = gt; idx < M * 256; idx += GT) gla_prep_item(idx, P, cx.in[3], cx.in[4], EA);
                float* VEC = (float*)(ws + WS_SCR); float* R = (float*)(ws + WS_XFA); bf16* Gt = (bf16*)(ws + WS_XB + 16 * MiB); float* BON = (float*)(ws + WS_CTL + 512 * 1024);
                for (int t = bx; t < M; t += G) rwkv_prep_token(t, wave * 64 + ln, (LAS float*)lds, P, cx.in[6], cx.in[7], cx.in[8], cx.in[9], cx.in[10], cx.in[11], cx.in[12], cx.in[13], cx.in[14], VEC, R, Gt, BON);
            } break;
            case K_L0_SCAN: {
                const bf16* P = (const bf16*)(ws + WS_P);
                if (wave == 0 && vcu < 8) gla_scan_item(vcu, ln, P, (const float*)(ws + WS_XB), (float*)cx.out);
                else if (wave == 0 && vcu < 16) rwkv_scan_item(vcu - 8, ln, P, cx.in[6], (const float*)(ws + WS_SCR), (const float*)(ws + WS_XFA), (float*)cx.out + (size_t)M * 512);
            } break;
            case K_L0_FIN: {
                const bf16* P = (const bf16*)(ws + WS_P); bf16* OMIX = (bf16*)(ws + WS_OMIX);
                for (int w = gw; w < M * 4; w += NGW) gla_fin_item(w, ln, P, (const float*)cx.out, cx.in[5], OMIX);
                for (int w = gw; w < M * 8; w += NGW) rwkv_fin_item(w, ln, P, cx.in[6], (const float*)cx.out + (size_t)M * 512, (const bf16*)(ws + WS_XB + 16 * MiB), (const float*)(ws + WS_CTL + 512 * 1024), cx.in[15], cx.in[16], OMIX);
            } break;
            case K_L1_PREP: {
                const bf16* P = (const bf16*)(ws + WS_P);
                float* XBC = (float*)(ws + WS_SCR); float* DT = (float*)(ws + WS_SCR + 96 * MiB); float* DA = (float*)(ws + WS_SCR + 97 * MiB); float* KM = (float*)(ws + WS_SCR + 98 * MiB);
                for (size_t idx = gt; idx < (size_t)M * 1536; idx += GT) ssd_prep_item(idx, P, cx.in[32], cx.in[33], XBC);
                for (int idx = gt; idx < M * 16; idx += GT) ssd_dt_item(idx, P, cx.in[34], cx.in[35], DT, DA);
                for (int idx = gt; idx < 8 * 64 * 64; idx += GT) moba_kmean_item(idx, P, KM);
            } break;
            case K_L1_SCAN: {
                const bf16* P = (const bf16*)(ws + WS_P);
                const float* XBC = (const float*)(ws + WS_SCR); const float* DT = (const float*)(ws + WS_SCR + 96 * MiB); const float* DA = (const float*)(ws + WS_SCR + 97 * MiB); const float* KM = (const float*)(ws + WS_SCR + 98 * MiB);
                if (wave == 0 && vcu < 16) ssd_scan_item(vcu, ln, XBC, DT, DA, cx.in[36], (float*)cx.out);
                for (int idx = gt; idx < M * 8; idx += GT) moba_item(idx, P, KM, (bf16*)(ws + WS_OMIX));
            } break;
            case K_L1_FIN: {
                const bf16* P = (const bf16*)(ws + WS_P);
                for (int w = gw; w < M * 2; w += NGW) ssd_fin_item(w, ln, P, (const float*)cx.out, cx.in[37], (bf16*)(ws + WS_OMIX));
            } break;
            case K_MOE_ROUTE: {
                volatile LAS int* cnt = (volatile LAS int*)(MISC + 16);
                if (tl < 8) cnt[tl] = 0;
                __syncthreads();
                bf16* XB = (bf16*)(ws + WS_XB); int* TOPE = (int*)(ws + WS_RT + RT_TOPE); float* GATE = (float*)(ws + WS_RT + RT_GATE);
                const float* wr = cx.in[47]; const float* br = cx.in[48]; float* xf = st.p<float>(F_OUTF); const float* lg = st.p<const float>(F_LNG); const float* lb = st.p<const float>(F_LNB);
                for (int k = 0; k < 8; ++k) {
                    const int r = vcu * 64 + wave * 8 + k; float4 o[4];
                    ln_row(xf + (size_t)r * D, xf + (size_t)r * D, XB + (size_t)r * D, lg, lb, ln, o);
                    float acc[8];
#pragma unroll
                    for (int e = 0; e < 8; ++e) acc[e] = 0.f;
#pragma unroll
                    for (int j = 0; j < 4; ++j) { const int col = 4 * (ln + 64 * j); const float xs[4] = {o[j].x, o[j].y, o[j].z, o[j].w};
#pragma unroll
                        for (int u = 0; u < 4; ++u) { const float4 w0 = *(const float4*)(wr + (size_t)(col + u) * 8), w1 = *(const float4*)(wr + (size_t)(col + u) * 8 + 4);
                            acc[0] += xs[u] * w0.x; acc[1] += xs[u] * w0.y; acc[2] += xs[u] * w0.z; acc[3] += xs[u] * w0.w; acc[4] += xs[u] * w1.x; acc[5] += xs[u] * w1.y; acc[6] += xs[u] * w1.z; acc[7] += xs[u] * w1.w; } }
#pragma unroll
                    for (int e = 0; e < 8; ++e) acc[e] = wave_sum(acc[e]) + br[e];
                    int e0 = 0; float l0 = acc[0];
#pragma unroll
                    for (int e = 1; e < 8; ++e) if (acc[e] > l0) { l0 = acc[e]; e0 = e; }
                    int e1 = -1; float l1 = -INFINITY;
#pragma unroll
                    for (int e = 0; e < 8; ++e) if (e != e0 && acc[e] > l1) { l1 = acc[e]; e1 = e; }
                    const float ex = expf(l1 - l0), g0 = 1.f / (1.f + ex);
                    if (ln == 0) { TOPE[2 * r] = e0; TOPE[2 * r + 1] = e1; GATE[2 * r] = g0; GATE[2 * r + 1] = ex * g0;
                        __hip_atomic_fetch_add((int*)(cnt + e0), 1, __ATOMIC_RELAXED, __HIP_MEMORY_SCOPE_WORKGROUP); __hip_atomic_fetch_add((int*)(cnt + e1), 1, __ATOMIC_RELAXED, __HIP_MEMORY_SCOPE_WORKGROUP); }
                }
                __syncthreads();
                if (tl < 8) ((int*)(ws + WS_RT + RT_BC))[vcu * 8 + tl] = cnt[tl];
                cvt_jobs(14, 30, cx, (LAS float*)(lds + wave * 16384), gw, NGW, ln);
            } break;
            case K_MOE_ASSIGN: {
                LAS int* sm = (LAS int*)lds;
                const int* BC = (const int*)(ws + WS_RT + RT_BC); const int* TOPE = (const int*)(ws + WS_RT + RT_TOPE);
                int* ROW_TOK = (int*)(ws + WS_RT + RT_ROWTOK); int* SLOT_ROW = (int*)(ws + WS_RT + RT_SLOTROW); int* TILE_E = (int*)(ws + WS_RT + RT_TILEE); int* META = (int*)(ws + WS_RT + RT_META);
                const bf16* XB = (const bf16*)(ws + WS_XB); bf16* XG = (bf16*)(ws + WS_XG);
                {   const int e = wave; int tot = 0, off = 0;
                    for (int b = ln; b < 256; b += 64) { const int c = BC[b * 8 + e]; tot += c; if (b < vcu) off += c; }
                    tot = wave_sum_i(tot); off = wave_sum_i(off);
                    if (ln == 0) { sm[e] = tot; sm[8 + e] = off; } }
                __syncthreads();
                if (tl == 0) { int p = 0, us = 0; for (int e = 0; e < 8; ++e) { sm[16 + e] = p; sm[32 + e] = us; p += (sm[e] + 255) / 256 * 256; us += sm[e]; } sm[24] = p; }
                __syncthreads();
                if (tl < 128) sm[64 + tl] = TOPE[vcu * 128 + tl];
                __syncthreads();
                if (tl < 128) { const int e = sm[64 + tl]; int rank = 0; for (int i = 0; i < tl; ++i) rank += (sm[64 + i] == e) ? 1 : 0;
                    const int pos = sm[16 + e] + sm[8 + e] + rank; SLOT_ROW[vcu * 128 + tl] = pos; ROW_TOK[pos] = vcu * 64 + (tl >> 1); sm[192 + tl] = pos; }
                __syncthreads();
                for (int i = wave; i < 128; i += 8) { const int pos = sm[192 + i], tok = vcu * 64 + (i >> 1);
                    const uint4* src = (const uint4*)(XB + (size_t)tok * D); uint4* dst = (uint4*)(XG + (size_t)pos * D); dst[ln] = src[ln]; dst[ln + 64] = src[ln + 64]; }
                for (int k = gw; k < 2048; k += NGW) { const int e = k >> 8, j = k & 255, row = sm[16 + e] + sm[e] + j;
                    if (row < sm[17 + e]) { if (ln == 0) ROW_TOK[row] = -1; uint4* dst = (uint4*)(XG + (size_t)row * D); const uint4 zz = {0u, 0u, 0u, 0u}; dst[ln] = zz; dst[ln + 64] = zz; } }
                if (bx == 0) {
                    if (tl < 8) { META[tl] = sm[16 + tl]; META[8 + tl] = sm[16 + tl] - sm[32 + tl]; }
                    if (tl == 8) META[16] = sm[24];
                    if (tl < RMAX / 256) { const int r = tl * 256; int e = 0; for (int x = 1; x < 8; ++x) if (r >= sm[16 + x]) e = x; TILE_E[tl] = e; }
                }
                __syncthreads();
            } break;
            default: {
                const float* XF = (const float*)(ws + WS_XFA); const bf16* YR = (const bf16*)(ws + WS_YR);
                const int* TOPE = (const int*)(ws + WS_RT + RT_TOPE); const float* GATE = (const float*)(ws + WS_RT + RT_GATE); const int* SLOT_ROW = (const int*)(ws + WS_RT + RT_SLOTROW); const int* META = (const int*)(ws + WS_RT + RT_META);
                const float* g = cx.in[52]; const float* b = cx.in[53];
                for (int t = gw; t < M; t += NGW) {
                    const int e0 = TOPE[2 * t], e1 = TOPE[2 * t + 1]; const float g0 = GATE[2 * t], g1 = GATE[2 * t + 1];
                    const bf16* y0 = YR + (size_t)(SLOT_ROW[2 * t] - META[8 + e0]) * D; const bf16* y1 = YR + (size_t)(SLOT_ROW[2 * t + 1] - META[8 + e1]) * D;
                    float4 v[4]; float sum = 0.f;
#pragma unroll
                    for (int j = 0; j < 4; ++j) { const int col = 4 * (ln + 64 * j); const float4 x = *(const float4*)(XF + (size_t)t * D + col);
                        const uint2 a0 = *(const uint2*)(y0 + col), a1 = *(const uint2*)(y1 + col);
                        v[j].x = ALPHA * x.x + g0 * __uint_as_float(a0.x << 16) + g1 * __uint_as_float(a1.x << 16);
                        v[j].y = ALPHA * x.y + g0 * __uint_as_float(a0.x & 0xffff0000u) + g1 * __uint_as_float(a1.x & 0xffff0000u);
                        v[j].z = ALPHA * x.z + g0 * __uint_as_float(a0.y << 16) + g1 * __uint_as_float(a1.y << 16);
                        v[j].w = ALPHA * x.w + g0 * __uint_as_float(a0.y & 0xffff0000u) + g1 * __uint_as_float(a1.y & 0xffff0000u);
                        sum += (v[j].x + v[j].y) + (v[j].z + v[j].w); }
                    const float mean = wave_sum(sum) * (1.f / D); float q = 0.f;
#pragma unroll
                    for (int j = 0; j < 4; ++j) { v[j].x -= mean; v[j].y -= mean; v[j].z -= mean; v[j].w -= mean; q += (v[j].x * v[j].x + v[j].y * v[j].y) + (v[j].z * v[j].z + v[j].w * v[j].w); }
                    const float rstd = 1.f / sqrtf(wave_sum(q) * (1.f / D) + 1e-5f);
#pragma unroll
                    for (int j = 0; j < 4; ++j) { const int col = 4 * (ln + 64 * j); const float4 gg = *(const float4*)(g + col), bb = *(const float4*)(b + col);
                        float4 o; o.x = v[j].x * rstd * gg.x + bb.x; o.y = v[j].y * rstd * gg.y + bb.y; o.z = v[j].z * rstd * gg.z + bb.z; o.w = v[j].w * rstd * gg.w + bb.w;
                        *(float4*)(cx.out + (size_t)t * D + col) = o; }
                }
            } break;
        }
        if (st.i(F_SYNC) && s + 1 < ph_hi) xcd_barrier(bar);
    }
}
}

extern "C" void kernel_launch(void* const* d_in, const int* in_sizes, int n_in, void* d_out, int out_size, void* d_ws, size_t ws_size, hipStream_t stream) {
    if (n_in != 54 || ws_size < WS_END) { fprintf(stderr, "kernel_launch: unexpected n_in %d / ws_size %zu (need %zu)\n", n_in, ws_size, (size_t)WS_END); return; }
    static int grid = 0;
    if (grid == 0) {
        int dev = 0, cus = 0;
        if (hipGetDevice(&dev) != hipSuccess || hipDeviceGetAttribute(&cus, hipDeviceAttributeMultiprocessorCount, dev) != hipSuccess) { fprintf(stderr, "kernel_launch: device query failed\n"); grid = -1; return; }
        if (hipFuncSetAttribute((const void*)mega, hipFuncAttributeMaxDynamicSharedMemorySize, LDS_BYTES) != hipSuccess) { fprintf(stderr, "kernel_launch: hipFuncSetAttribute failed\n"); grid = -1; return; }
        (void)hipGetLastError();
        grid = cus;
        if (grid != 256) fprintf(stderr, "kernel_launch: %d CUs (expected 256)\n", grid);
    }
    if (grid < 0) return;
    (void)hipMemsetAsync((unsigned char*)d_ws + WS_CTL, 0, 64 * 1024, stream);
    MArgs a{};
    for (int i = 0; i < 54; ++i) a.in[i] = (const float*)d_in[i];
    a.out = (float*)d_out; a.ws = (unsigned char*)d_ws;
    a.ph_lo = 0; a.ph_hi = N_STEPS; a.li = 0;
    hipLaunchKernelGGL(mega, dim3(grid), dim3(NWAVES * 64), LDS_BYTES, stream, a);
}
```

```cpp
#include <hip/hip_runtime.h>
#include <cstdio>
#include <cstdint>
#include <cstddef>

typedef unsigned short bf16;
#define LAS __attribute__((address_space(3)))

namespace {
constexpr int M = 16384, D = 1024;
constexpr int NP0 = 3584, NP1 = 4352;
constexpr float ALPHA = 1.4142135623730951f;
constexpr int RMAX = 34816;
constexpr size_t MiB = 1ull << 20;
constexpr size_t WS_CTL = 0, WS_XFA = 1 * MiB, WS_XB = 65 * MiB, WS_P = 97 * MiB, WS_OMIX = 233 * MiB, WS_SCR = 281 * MiB, WS_END = 433 * MiB;

__device__ __forceinline__ float bf2f(bf16 v) { return __uint_as_float(((unsigned)v) << 16); }
__device__ __forceinline__ bf16 f2bf(float f) { unsigned u = __float_as_uint(f); u += 0x7fffu + ((u >> 16) & 1u); return (bf16)(u >> 16); }
__device__ __forceinline__ float sigm(float x) { return 1.f / (1.f + expf(-x)); }
__device__ __forceinline__ float siluf(float x) { return x * sigm(x); }
__device__ __forceinline__ float wave_sum(float v) {
#pragma unroll
    for (int o = 1; o < 64; o <<= 1) v += __shfl_xor(v, o);
    return v;
}
__device__ __forceinline__ float wave_max(float v) {
#pragma unroll
    for (int o = 1; o < 64; o <<= 1) v = fmaxf(v, __shfl_xor(v, o));
    return v;
}

__device__ __forceinline__ void gla_prep_item(int idx, const bf16* P, const float* wa2, const float* ba, float* EA) {
    const int t = idx >> 8, c = idx & 255;
    float s = ba[c];
#pragma unroll
    for (int r = 0; r < 16; ++r) s += bf2f(P[(size_t)t * NP0 + 1536 + r]) * wa2[r * 256 + c];
    const float ls = fminf(s, 0.f) - log1pf(expf(-fabsf(s)));
    EA[idx] = expf(ls * (1.f / 16.f));
}
__device__ __forceinline__ void gla_scan_item(int item, int lane, const bf16* P, const float* EA, float* ORAW) {
    const int h = item >> 1, j = (item & 1) * 64 + lane;
    float S[64];
#pragma unroll
    for (int i = 0; i < 64; ++i) S[i] = 0.f;
    for (int t = 0; t < M; ++t) {
        const bf16* pr = P + (size_t)t * NP0;
        const float vj = bf2f(pr[512 + h * 128 + j]);
        const float* ea = EA + (size_t)t * 256 + h * 64;
        float o = 0.f;
#pragma unroll
        for (int i = 0; i < 64; ++i) {
            const float k = bf2f(pr[256 + h * 64 + i]), q = bf2f(pr[h * 64 + i]);
            S[i] = ea[i] * S[i] + k * vj; o += q * S[i];
        }
        ORAW[(size_t)t * 512 + h * 128 + j] = o * 0.125f;
    }
}
__device__ __forceinline__ void gla_fin_item(int w, int lane, const bf16* P, const float* ORAW, const float* norm_g, bf16* OMIX) {
    const int t = w >> 2, h = w & 3;
    const float o0 = ORAW[(size_t)t * 512 + h * 128 + lane], o1 = ORAW[(size_t)t * 512 + h * 128 + 64 + lane];
    const float r = 1.f / sqrtf(wave_sum(o0 * o0 + o1 * o1) * (1.f / 128.f) + 1e-5f);
#pragma unroll
    for (int u = 0; u < 2; ++u) {
        const int j = lane + 64 * u; const float o = u ? o1 : o0;
        const float g = bf2f(P[(size_t)t * NP0 + 1024 + h * 128 + j]);
        OMIX[(size_t)t * 1024 + h * 128 + j] = f2bf(o * r * norm_g[h * 128 + j] * siluf(g));
    }
}
__device__ __forceinline__ void rwkv_prep_token(int t, int c, LAS float* ps, const bf16* P, const float* mu, const float* w0, const float* w2, const float* a0, const float* a2, const float* g2,
                                                const float* kkw, const float* kaw, const float* rkw, float* VEC, float* R, bf16* G, float* BON) {
    for (int i = c; i < 1792; i += 512) {
        const float p = bf2f(P[(size_t)t * NP0 + 1792 + i]);
        const float pp = t > 0 ? bf2f(P[(size_t)(t - 1) * NP0 + 1792 + i]) : 0.f;
        ps[i] = p + mu[i] * (pp - p);
    }
    __syncthreads();
    if (c < 64) ps[1536 + c] = tanhf(ps[1536 + c]);
    else if (c >= 128 && c < 256) ps[1664 + c - 128] = sigm(ps[1664 + c - 128]);
    __syncthreads();
    float lw = w0[c];
#pragma unroll 4
    for (int i = 0; i < 64; ++i) lw += ps[1536 + i] * w2[i * 512 + c];
    float aa = a0[c];
#pragma unroll 4
    for (int i = 0; i < 64; ++i) aa += ps[1600 + i] * a2[i * 512 + c];
    aa = sigm(aa);
    float gg = 0.f;
#pragma unroll 4
    for (int i = 0; i < 128; ++i) gg += ps[1664 + i] * g2[i * 512 + c];
    const float w = expf(-0.6065306597126334f * sigm(lw));
    const float r = ps[c], k = ps[512 + c];
    const float kr = k * kkw[c];
    const float ss = wave_sum(kr * kr);
    const float kk = kr * (1.f / sqrtf(fmaxf(ss, 1e-24f)));
    const float k2 = k * (1.f + (aa - 1.f) * kaw[c]);
    const float b = kk * aa;
    const float bon = wave_sum(r * k2 * rkw[c]);
    const int h = c >> 6, l = c & 63;
    float* ve = VEC + ((size_t)t * 8 + h) * 256;
    ve[l] = k2; ve[64 + l] = w; ve[128 + l] = kk; ve[192 + l] = b;
    R[(size_t)t * 512 + c] = r;
    G[(size_t)t * 512 + c] = f2bf(gg);
    if (l == 0) BON[t * 8 + h] = bon;
    __syncthreads();
}
__device__ __forceinline__ void rwkv_scan_item(int h, int v, const bf16* P, const float* mu, const float* VEC, const float* R, float* ORAW) {
    float S[64];
#pragma unroll
    for (int i = 0; i < 64; ++i) S[i] = 0.f;
    const float muv = mu[1024 + h * 64 + v];
    float pp = 0.f;
    for (int t = 0; t < M; ++t) {
        const float* ve = VEC + ((size_t)t * 8 + h) * 256;
        const float* rr = R + (size_t)t * 512 + h * 64;
        const float p = bf2f(P[(size_t)t * NP0 + 1792 + 1024 + h * 64 + v]);
        const float vv = p + muv * (pp - p); pp = p;
        float sk = 0.f;
#pragma unroll
        for (int i = 0; i < 64; ++i) sk += S[i] * ve[128 + i];
        float o = 0.f;
#pragma unroll
        for (int i = 0; i < 64; ++i) { S[i] = S[i] * ve[64 + i] - sk * ve[192 + i] + vv * ve[i]; o += S[i] * rr[i]; }
        ORAW[(size_t)t * 512 + h * 64 + v] = o;
    }
}
__device__ __forceinline__ void rwkv_fin_item_naive(int w, int lane, const bf16* P, const float* mu, const float* ORAW, const bf16* G, const float* BON, const float* lnw, const float* lnb, bf16* OMIX) {
    const int t = w >> 3, h = w & 7, c = h * 64 + lane;
    const float o = ORAW[(size_t)t * 512 + c];
    const float mean = wave_sum(o) * (1.f / 64.f), d = o - mean;
    const float var = wave_sum(d * d) * (1.f / 64.f);
    const float on = d * (1.f / sqrtf(var + 64e-5f)) * lnw[c] + lnb[c];
    const float p = bf2f(P[(size_t)t * NP0 + 1792 + 1024 + c]);
    const float pp = t > 0 ? bf2f(P[(size_t)(t - 1) * NP0 + 1792 + 1024 + c]) : 0.f;
    const float vv = p + mu[1024 + c] * (pp - p);
    OMIX[(size_t)t * 1024 + 512 + c] = f2bf((on + BON[t * 8 + h] * vv) * bf2f(G[(size_t)t * 512 + c]));
}
__device__ __forceinline__ void ssd_prep_item(size_t idx, const bf16* P, const float* conv_w, const float* conv_b, float* XBC) {
    const int t = (int)(idx / 1536), c = (int)(idx % 1536);
    float y = conv_b[c];
#pragma unroll
    for (int i = 0; i < 4; ++i) { const int tt = t - 3 + i; if (tt >= 0) y += conv_w[i * 1536 + c] * bf2f(P[(size_t)tt * NP1 + 1024 + c]); }
    XBC[idx] = siluf(y);
}
__device__ __forceinline__ void ssd_dt_item(int idx, const bf16* P, const float* dt_bias, const float* a_log, float* DT, float* DA) {
    const int t = idx >> 4, h = idx & 15;
    const float x = bf2f(P[(size_t)t * NP1 + 4096 + h]) + dt_bias[h];
    const float dt = x > 20.f ? x : log1pf(expf(x));
    DT[idx] = dt; DA[idx] = expf(-dt * expf(a_log[h]));
}
__device__ __forceinline__ void ssd_scan_item(int h, int p, const float* XBC, const float* DT, const float* DA, const float* d_skip, float* Y) {
    const int g = h >> 3;
    float hs[128];
#pragma unroll
    for (int n = 0; n < 128; ++n) hs[n] = 0.f;
    const float dsk = d_skip[h];
    for (int t = 0; t < M; ++t) {
        const float* xr = XBC + (size_t)t * 1536;
        const float x = xr[h * 64 + p], dt = DT[t * 16 + h], dA = DA[t * 16 + h], xd = x * dt;
        const float* Bv = xr + 1024 + g * 128; const float* Cv = xr + 1280 + g * 128;
        float y = 0.f;
#pragma unroll
        for (int n = 0; n < 128; ++n) { hs[n] = dA * hs[n] + xd * Bv[n]; y += Cv[n] * hs[n]; }
        Y[(size_t)t * 1024 + h * 64 + p] = y + dsk * x;
    }
}
__device__ __forceinline__ void ssd_fin_item(int w, int lane, const bf16* P, const float* Y, const float* norm_g, bf16* OMIX) {
    const int t = w >> 1, g = w & 1;
    float val[8]; float ss = 0.f;
#pragma unroll
    for (int u = 0; u < 8; ++u) { const int i = g * 512 + lane + 64 * u; val[u] = Y[(size_t)t * 1024 + i] * siluf(bf2f(P[(size_t)t * NP1 + i])); ss += val[u] * val[u]; }
    const float r = 1.f / sqrtf(wave_sum(ss) * (1.f / 512.f) + 1e-5f);
#pragma unroll
    for (int u = 0; u < 8; ++u) { const int i = g * 512 + lane + 64 * u; OMIX[(size_t)t * 1536 + i] = f2bf(val[u] * r * norm_g[i]); }
}
__device__ __forceinline__ void moba_kmean_item(int idx, const bf16* P, float* KM) {
    const int d = idx & 63, j = (idx >> 6) & 63, h = idx >> 12;
    float s = 0.f;
    for (int i = 0; i < 256; ++i) s += bf2f(P[(size_t)(j * 256 + i) * NP1 + 3072 + h * 64 + d]);
    KM[idx] = s * (1.f / 256.f);
}
__device__ __forceinline__ void moba_item(int idx, const bf16* P, const float* KM, bf16* OMIX) {
    const int h = idx & 7, t = idx >> 3;
    float q[64];
#pragma unroll
    for (int d = 0; d < 64; ++d) q[d] = bf2f(P[(size_t)t * NP1 + 2560 + h * 64 + d]) * 0.125f;
    const int own = t >> 8;
    float b0 = -INFINITY, b1 = -INFINITY, b2 = -INFINITY; int i0 = 0, i1 = 0, i2 = 0;
    for (int j = 0; j < own; ++j) {
        const float* km = KM + (size_t)(h * 64 + j) * 64; float g = 0.f;
#pragma unroll
        for (int d = 0; d < 64; ++d) g += q[d] * km[d];
        if (g > b0) { b2 = b1; i2 = i1; b1 = b0; i1 = i0; b0 = g; i0 = j; }
        else if (g > b1) { b2 = b1; i2 = i1; b1 = g; i1 = j; }
        else if (g > b2) { b2 = g; i2 = j; }
    }
    const int nsel = own < 3 ? own : 3;
    const float slope = exp2f(-(float)(h + 1));
    float mx = -INFINITY, l = 0.f, o[64];
#pragma unroll
    for (int d = 0; d < 64; ++d) o[d] = 0.f;
    for (int u = 0; u <= nsel; ++u) {
        int s0, s1;
        if (u == 0) { s0 = own * 256; s1 = t; } else { const int j = (u == 1) ? i0 : (u == 2 ? i1 : i2); s0 = j * 256; s1 = s0 + 255; }
        for (int s = s0; s <= s1; ++s) {
            const bf16* kr = P + (size_t)s * NP1 + 3072 + h * 64; const bf16* vr = kr + 512;
            float sc = 0.f;
#pragma unroll
            for (int d = 0; d < 64; ++d) sc += q[d] * bf2f(kr[d]);
            sc -= slope * (float)(t - s);
            const float mn = fmaxf(mx, sc), corr = expf(mx - mn), pe = expf(sc - mn);
            l = l * corr + pe; mx = mn;
#pragma unroll
            for (int d = 0; d < 64; ++d) o[d] = o[d] * corr + pe * bf2f(vr[d]);
        }
    }
    const float inv = 1.f / l;
#pragma unroll
    for (int d = 0; d < 64; ++d) OMIX[(size_t)t * 1536 + 1024 + h * 64 + d] = f2bf(o[d] * inv);
}

constexpr int RW_J = 128, RW_SEG = 128;
typedef short bf16x8_t __attribute__((ext_vector_type(8)));
typedef float f32x4_t __attribute__((ext_vector_type(4)));
typedef unsigned u32x4_t __attribute__((ext_vector_type(4)));
typedef unsigned u32x2_t __attribute__((ext_vector_type(2)));
__device__ __forceinline__ void rwkv_prep_group(int t0, int tl, LAS float* ps, const bf16* P, const float* mu, const float* w0, const float* w2, const float* a0, const float* a2, const float* g2,
                                                const float* kkw, const float* kaw, const float* rkw, float* VEC, bf16* G, float* BON) {
#pragma unroll 1
    for (int t = 0; t < 16; ++t) {
        const int tt = t0 + t;
        for (int c = tl; c < 1792; c += 512) {
            const float p = bf2f(P[(size_t)tt * NP0 + 1792 + c]);
            const float pp = tt > 0 ? bf2f(P[(size_t)(tt - 1) * NP0 + 1792 + c]) : 0.f;
            float v = p + mu[c] * (pp - p);
            if (c >= 1536 && c < 1600) v = tanhf(v); else if (c >= 1664) v = sigm(v);
            ps[t * 1792 + c] = v;
        }
    }
    __syncthreads();
    const int c = tl;
    float aw[16], aa[16], ag[16];
    { const float w0c = w0[c], a0c = a0[c];
#pragma unroll
      for (int t = 0; t < 16; ++t) { aw[t] = w0c; aa[t] = a0c; ag[t] = 0.f; } }
#pragma unroll 1
    for (int i = 0; i < 64; i += 4) {
        const float u0 = w2[(i + 0) * 512 + c], u1 = w2[(i + 1) * 512 + c], u2 = w2[(i + 2) * 512 + c], u3 = w2[(i + 3) * 512 + c];
        const float v0 = a2[(i + 0) * 512 + c], v1 = a2[(i + 1) * 512 + c], v2 = a2[(i + 2) * 512 + c], v3 = a2[(i + 3) * 512 + c];
#pragma unroll
        for (int t = 0; t < 16; ++t) {
            const f32x4_t x = *(const LAS f32x4_t*)(ps + t * 1792 + 1536 + i), y = *(const LAS f32x4_t*)(ps + t * 1792 + 1600 + i);
            aw[t] += x[0] * u0 + x[1] * u1 + x[2] * u2 + x[3] * u3; aa[t] += y[0] * v0 + y[1] * v1 + y[2] * v2 + y[3] * v3;
        }
    }
#pragma unroll 1
    for (int i = 0; i < 128; i += 4) {
        const float u0 = g2[(i + 0) * 512 + c], u1 = g2[(i + 1) * 512 + c], u2 = g2[(i + 2) * 512 + c], u3 = g2[(i + 3) * 512 + c];
#pragma unroll
        for (int t = 0; t < 16; ++t) { const f32x4_t x = *(const LAS f32x4_t*)(ps + t * 1792 + 1664 + i); ag[t] += x[0] * u0 + x[1] * u1 + x[2] * u2 + x[3] * u3; }
    }
    const float kkc = kkw[c], kac = kaw[c], rkc = rkw[c];
    const int h = c >> 6, l = c & 63;
#pragma unroll
    for (int t = 0; t < 16; ++t) {
        const int tt = t0 + t;
        const float a = sigm(aa[t]);
        const float w = expf(-0.6065306597126334f * sigm(aw[t]));
        const float r = ps[t * 1792 + c], k = ps[t * 1792 + 512 + c];
        const float kr = k * kkc;
        const float ss = wave_sum(kr * kr);
        const float kk = kr * (1.f / sqrtf(fmaxf(ss, 1e-24f)));
        const float k2 = k * (1.f + (a - 1.f) * kac);
        const float bon = wave_sum(r * k2 * rkc);
        float* ve = VEC + ((size_t)tt * 8 + h) * 256;
        ve[l] = k2; ve[64 + l] = w; ve[128 + l] = kk; ve[192 + l] = kk * a;
        G[(size_t)tt * 512 + c] = f2bf(ag[t]);
        if (l == 0) BON[tt * 8 + h] = bon;
    }
    __syncthreads();
}
__device__ __forceinline__ void rwkv_scan_seg(int item, int ln, LAS float* stg, const bf16* P, const float* mu, const float* VEC, float* ORAW, float* CB, float* SLOC, float* MEND) {
    const int h = item & 7, j = item >> 3, t0 = j * RW_SEG;
    float S[64], Mx[64];
#pragma unroll
    for (int k = 0; k < 64; ++k) { S[k] = 0.f; Mx[k] = (k == ln) ? 1.f : 0.f; }
    const float mur = mu[h * 64 + ln], muv = mu[1024 + h * 64 + ln];
    const bf16* Pr = P + 1792 + h * 64 + ln;
    float rp = t0 > 0 ? bf2f(Pr[(size_t)(t0 - 1) * NP0]) : 0.f, vp = t0 > 0 ? bf2f(Pr[(size_t)(t0 - 1) * NP0 + 1024]) : 0.f;
#pragma unroll 1
    for (int g = 0; g < RW_SEG / 8; ++g) {
        f32x4_t vv[8]; float rr[8], vl[8];
#pragma unroll
        for (int u = 0; u < 8; ++u) { const int t = t0 + g * 8 + u;
            vv[u] = *(const f32x4_t*)(VEC + ((size_t)t * 8 + h) * 256 + 4 * ln);
            const float pr = bf2f(Pr[(size_t)t * NP0]), pv = bf2f(Pr[(size_t)t * NP0 + 1024]);
            rr[u] = pr + mur * (rp - pr); rp = pr; vl[u] = pv + muv * (vp - pv); vp = pv; }
#pragma unroll
        for (int u = 0; u < 8; ++u) { *(LAS f32x4_t*)(stg + u * 384 + 4 * ln) = vv[u]; stg[u * 384 + 256 + ln] = rr[u]; stg[u * 384 + 320 + ln] = vl[u]; }
        asm volatile("s_waitcnt lgkmcnt(0)" ::: "memory");
#pragma unroll 1
        for (int u = 0; u < 8; ++u) {
            const LAS f32x4_t* s4 = (const LAS f32x4_t*)(stg + u * 384);
            const float vcur = stg[u * 384 + 320 + ln];
            float sa0 = 0.f, sa1 = 0.f, ma0 = 0.f, ma1 = 0.f;
#pragma unroll
            for (int q = 0; q < 16; ++q) { const f32x4_t kk4 = s4[32 + q];
                sa0 += S[4 * q] * kk4[0]; sa1 += S[4 * q + 1] * kk4[1]; sa0 += S[4 * q + 2] * kk4[2]; sa1 += S[4 * q + 3] * kk4[3];
                ma0 += Mx[4 * q] * kk4[0]; ma1 += Mx[4 * q + 1] * kk4[1]; ma0 += Mx[4 * q + 2] * kk4[2]; ma1 += Mx[4 * q + 3] * kk4[3]; }
            const float nS = -(sa0 + sa1), nM = -(ma0 + ma1);
            float o0 = 0.f, o1 = 0.f, c0 = 0.f, c1 = 0.f;
#pragma unroll
            for (int q = 0; q < 16; ++q) { const f32x4_t k24 = s4[q], w4 = s4[16 + q], b4 = s4[48 + q], r4 = s4[64 + q];
#pragma unroll
                for (int e = 0; e < 4; ++e) { const int k = 4 * q + e;
                    S[k] = fmaf(S[k], w4[e], fmaf(nS, b4[e], vcur * k24[e])); Mx[k] = fmaf(Mx[k], w4[e], nM * b4[e]);
                    if (e & 1) { o1 += S[k] * r4[e]; c1 += Mx[k] * r4[e]; } else { o0 += S[k] * r4[e]; c0 += Mx[k] * r4[e]; } } }
            const size_t oi = (size_t)(t0 + g * 8 + u) * 512 + h * 64 + ln;
            ORAW[oi] = o0 + o1; CB[oi] = c0 + c1;
        }
    }
    float* sl = SLOC + ((size_t)(j * 8 + h) * 64 + ln) * 64; float* me = MEND + ((size_t)(j * 8 + h) * 64 + ln) * 64;
#pragma unroll
    for (int q = 0; q < 16; ++q) { *(f32x4_t*)(sl + 4 * q) = (f32x4_t){S[4 * q], S[4 * q + 1], S[4 * q + 2], S[4 * q + 3]}; *(f32x4_t*)(me + 4 * q) = (f32x4_t){Mx[4 * q], Mx[4 * q + 1], Mx[4 * q + 2], Mx[4 * q + 3]}; }
}
__device__ __forceinline__ void rwkv_combine_row(int row, int ln, float* SLOC, const float* MEND) {
    const int h = row >> 6, v = row & 63;
    float s = 0.f;
    float m[64];
#pragma unroll
    for (int i = 0; i < 64; ++i) m[i] = MEND[((size_t)(0 * 8 + h) * 64 + i) * 64 + ln];
#pragma unroll 1
    for (int j = 0; j < RW_J; ++j) {
        float* slot = SLOC + ((size_t)(j * 8 + h) * 64 + v) * 64 + ln;
        const float l = *slot;
        float mn[64];
        const int jn = (j + 1 < RW_J) ? j + 1 : j;
#pragma unroll
        for (int i = 0; i < 64; ++i) mn[i] = MEND[((size_t)(jn * 8 + h) * 64 + i) * 64 + ln];
        *slot = s;
        float a0 = l, a1 = 0.f;
#pragma unroll
        for (int i = 0; i < 64; i += 2) { a0 += __uint_as_float(__builtin_amdgcn_readlane(__float_as_uint(s), i)) * m[i]; a1 += __uint_as_float(__builtin_amdgcn_readlane(__float_as_uint(s), i + 1)) * m[i + 1]; }
        s = a0 + a1;
#pragma unroll
        for (int i = 0; i < 64; ++i) m[i] = mn[i];
    }
}
__device__ __forceinline__ void rwkv_fin_item(int item, int ln, const bf16* P, const float* mu, const float* ORAW, const float* CB, const float* SINIT, const bf16* G, const float* BON,
                                              const float* lnw, const float* lnb, bf16* OMIX) {
    const int tg = item & 7, h = (item >> 3) & 7, j = item >> 6;
    const int tb = j * RW_SEG + tg * 16, lr = ln & 15, lq = ln >> 4;
    bf16x8_t af[2], bfr[4][2];
#pragma unroll
    for (int kb = 0; kb < 2; ++kb) {
        const float* cp = CB + (size_t)(tb + lr) * 512 + h * 64 + kb * 32 + 8 * lq;
        const f32x4_t x0 = *(const f32x4_t*)cp, x1 = *(const f32x4_t*)(cp + 4);
        af[kb] = (bf16x8_t){(short)f2bf(x0[0]), (short)f2bf(x0[1]), (short)f2bf(x0[2]), (short)f2bf(x0[3]), (short)f2bf(x1[0]), (short)f2bf(x1[1]), (short)f2bf(x1[2]), (short)f2bf(x1[3])};
#pragma unroll
        for (int nt = 0; nt < 4; ++nt) {
            const float* sp = SINIT + ((size_t)(j * 8 + h) * 64 + nt * 16 + lr) * 64 + kb * 32 + 8 * lq;
            const f32x4_t y0 = *(const f32x4_t*)sp, y1 = *(const f32x4_t*)(sp + 4);
            bfr[nt][kb] = (bf16x8_t){(short)f2bf(y0[0]), (short)f2bf(y0[1]), (short)f2bf(y0[2]), (short)f2bf(y0[3]), (short)f2bf(y1[0]), (short)f2bf(y1[1]), (short)f2bf(y1[2]), (short)f2bf(y1[3])};
        }
    }
    f32x4_t acc[4];
#pragma unroll
    for (int nt = 0; nt < 4; ++nt) { acc[nt] = (f32x4_t){0.f, 0.f, 0.f, 0.f};
#pragma unroll
        for (int kb = 0; kb < 2; ++kb) acc[nt] = __builtin_amdgcn_mfma_f32_16x16x32_bf16(af[kb], bfr[nt][kb], acc[nt], 0, 0, 0); }
#pragma unroll
    for (int r = 0; r < 4; ++r) {
        const int t = tb + 4 * lq + r;
        float o[4]; float sum = 0.f;
#pragma unroll
        for (int nt = 0; nt < 4; ++nt) { o[nt] = acc[nt][r] + ORAW[(size_t)t * 512 + h * 64 + nt * 16 + lr]; sum += o[nt]; }
        sum += __shfl_xor(sum, 1); sum += __shfl_xor(sum, 2); sum += __shfl_xor(sum, 4); sum += __shfl_xor(sum, 8);
        const float mean = sum * (1.f / 64.f); float q = 0.f;
#pragma unroll
        for (int nt = 0; nt < 4; ++nt) { o[nt] -= mean; q += o[nt] * o[nt]; }
        q += __shfl_xor(q, 1); q += __shfl_xor(q, 2); q += __shfl_xor(q, 4); q += __shfl_xor(q, 8);
        const float rstd = 1.f / sqrtf(q * (1.f / 64.f) + 64e-5f);
        const float bon = BON[t * 8 + h];
#pragma unroll
        for (int nt = 0; nt < 4; ++nt) { const int c = h * 64 + nt * 16 + lr;
            const float p = bf2f(P[(size_t)t * NP0 + 1792 + 1024 + c]);
            const float pp = t > 0 ? bf2f(P[(size_t)(t - 1) * NP0 + 1792 + 1024 + c]) : 0.f;
            const float vv = p + mu[1024 + c] * (pp - p);
            OMIX[(size_t)t * 1024 + 512 + c] = f2bf((o[nt] * rstd * lnw[c] + lnb[c] + bon * vv) * bf2f(G[(size_t)t * 512 + c])); }
    }
}

constexpr int GL_LD = 72;
constexpr int GL_BC = 0, GL_WA = 16384, GL_QD = 20480, GL_KD = 29696, GL_KT = 38912, GL_VT = 48128, GL_PM = 66560, GL_SP = 75776, GL_RED = 94208;
__device__ __forceinline__ void unpack8(const uint4 u, float (&f)[8]) {
    f[0] = __uint_as_float(u.x << 16); f[1] = __uint_as_float(u.x & 0xffff0000u); f[2] = __uint_as_float(u.y << 16); f[3] = __uint_as_float(u.y & 0xffff0000u);
    f[4] = __uint_as_float(u.z << 16); f[5] = __uint_as_float(u.z & 0xffff0000u); f[6] = __uint_as_float(u.w << 16); f[7] = __uint_as_float(u.w & 0xffff0000u);
}
__device__ __forceinline__ void gla_decay_cumsum(int n, int h, int tl, LAS unsigned char* lds, const bf16* P, const float* wa2, const float* ba) {
    LAS float* bc = (LAS float*)(lds + GL_BC); LAS float* wa = (LAS float*)(lds + GL_WA);
    for (int i = tl; i < 1024; i += 512) wa[i] = wa2[(i >> 6) * 256 + h * 64 + (i & 63)];
    __syncthreads();
    const int t = tl >> 3, oq = tl & 7; const size_t row = (size_t)n * 64 + t;
    float a[16];
    { const uint4* ap = (const uint4*)(P + row * NP0 + 1536); float f[8]; unpack8(ap[0], f);
#pragma unroll
      for (int e = 0; e < 8; ++e) a[e] = f[e];
      unpack8(ap[1], f);
#pragma unroll
      for (int e = 0; e < 8; ++e) a[8 + e] = f[e]; }
#pragma unroll
    for (int e = 0; e < 8; ++e) { const int d = oq * 8 + e; float s = ba[h * 64 + d];
#pragma unroll
        for (int r = 0; r < 16; ++r) s += a[r] * wa[r * 64 + d];
        bc[t * 64 + d] = (fminf(s, 0.f) - log1pf(expf(-fabsf(s)))) * (1.f / 16.f); }
    __syncthreads();
    if (tl < 64) { float acc = 0.f;
#pragma unroll 8
        for (int tt = 0; tt < 64; ++tt) { acc += bc[tt * 64 + tl]; bc[tt * 64 + tl] = acc; } }
    __syncthreads();
}
__device__ __forceinline__ void gla_stage_vt(int n, int h, int tl, LAS unsigned char* lds, const bf16* P) {
    LAS bf16* vt = (LAS bf16*)(lds + GL_VT);
    const int t = tl >> 3, oq = tl & 7; const size_t row = (size_t)n * 64 + t;
#pragma unroll
    for (int half = 0; half < 2; ++half) { const int oct = oq + 8 * half; const uint4 u = *(const uint4*)(P + row * NP0 + 512 + h * 128 + oct * 8);
        const unsigned w[4] = {u.x, u.y, u.z, u.w};
#pragma unroll
        for (int e = 0; e < 8; ++e) vt[(oct * 8 + e) * GL_LD + t] = (bf16)((e & 1) ? (w[e >> 1] >> 16) : (w[e >> 1] & 0xffffu)); }
}
__device__ __forceinline__ bf16x8_t lds_frag(const LAS bf16* base, int row, int k0) { return *(const LAS bf16x8_t*)(base + row * GL_LD + k0); }
__device__ __forceinline__ void gla_state_item(int item, int tl, LAS unsigned char* lds, const bf16* P, const float* wa2, const float* ba, float* KVS, float* DEC) {
    const int n = item >> 2, h = item & 3, wv = tl >> 6, ln = tl & 63, lr = ln & 15, lq = ln >> 4;
    gla_decay_cumsum(n, h, tl, lds, P, wa2, ba);
    LAS float* bc = (LAS float*)(lds + GL_BC); LAS bf16* kt = (LAS bf16*)(lds + GL_KT); LAS bf16* vt = (LAS bf16*)(lds + GL_VT);
    { const int t = tl >> 3, oq = tl & 7; const size_t row = (size_t)n * 64 + t; float k[8]; unpack8(*(const uint4*)(P + row * NP0 + 256 + h * 64 + oq * 8), k);
#pragma unroll
      for (int e = 0; e < 8; ++e) { const int d = oq * 8 + e; kt[d * GL_LD + t] = f2bf(k[e] * __expf(bc[63 * 64 + d] - bc[t * 64 + d])); } }
    gla_stage_vt(n, h, tl, lds, P);
    __syncthreads();
    f32x4_t acc[4];
#pragma unroll
    for (int nt = 0; nt < 4; ++nt) acc[nt] = (f32x4_t){0.f, 0.f, 0.f, 0.f};
#pragma unroll
    for (int kb = 0; kb < 2; ++kb) { const bf16x8_t a = lds_frag(vt, 16 * wv + lr, kb * 32 + 8 * lq);
#pragma unroll
        for (int nt = 0; nt < 4; ++nt) acc[nt] = __builtin_amdgcn_mfma_f32_16x16x32_bf16(a, lds_frag(kt, 16 * nt + lr, kb * 32 + 8 * lq), acc[nt], 0, 0, 0); }
    float* kv = KVS + (size_t)(n * 4 + h) * 128 * 64;
#pragma unroll
    for (int nt = 0; nt < 4; ++nt)
#pragma unroll
        for (int r = 0; r < 4; ++r) kv[(16 * wv + 4 * lq + r) * 64 + 16 * nt + lr] = acc[nt][r];
    if (tl < 64) DEC[(n * 4 + h) * 64 + tl] = __expf(bc[63 * 64 + tl]);
    __syncthreads();
}
__device__ __forceinline__ void gla_out_item(int item, int tl, LAS unsigned char* lds, const bf16* P, const float* wa2, const float* ba, const float* KVS, const float* norm_g, bf16* OMIX) {
    const int n = item >> 2, h = item & 3, wv = tl >> 6, ln = tl & 63, lr = ln & 15, lq = ln >> 4;
    gla_decay_cumsum(n, h, tl, lds, P, wa2, ba);
    LAS float* bc = (LAS float*)(lds + GL_BC); LAS bf16* qd = (LAS bf16*)(lds + GL_QD); LAS bf16* kd = (LAS bf16*)(lds + GL_KD); LAS bf16* vt = (LAS bf16*)(lds + GL_VT);
    LAS bf16* pm = (LAS bf16*)(lds + GL_PM); LAS bf16* sp = (LAS bf16*)(lds + GL_SP); LAS float* red = (LAS float*)(lds + GL_RED);
    { const int t = tl >> 3, oq = tl & 7; const size_t row = (size_t)n * 64 + t; float q[8], k[8];
      unpack8(*(const uint4*)(P + row * NP0 + h * 64 + oq * 8), q); unpack8(*(const uint4*)(P + row * NP0 + 256 + h * 64 + oq * 8), k);
      unsigned qw[4], kw[4];
#pragma unroll
      for (int e = 0; e < 8; e += 2) { const float b0 = bc[t * 64 + oq * 8 + e], b1 = bc[t * 64 + oq * 8 + e + 1];
          qw[e >> 1] = (unsigned)f2bf(q[e] * 0.125f * __expf(b0)) | ((unsigned)f2bf(q[e + 1] * 0.125f * __expf(b1)) << 16);
          kw[e >> 1] = (unsigned)f2bf(k[e] * __expf(-b0)) | ((unsigned)f2bf(k[e + 1] * __expf(-b1)) << 16); }
      *(LAS u32x4_t*)(qd + t * GL_LD + oq * 8) = (u32x4_t){qw[0], qw[1], qw[2], qw[3]}; *(LAS u32x4_t*)(kd + t * GL_LD + oq * 8) = (u32x4_t){kw[0], kw[1], kw[2], kw[3]}; }
    gla_stage_vt(n, h, tl, lds, P);
    { const float* kv = KVS + (size_t)(n * 4 + h) * 128 * 64;
#pragma unroll
      for (int i = 0; i < 4; ++i) { const int idx = tl + 512 * i, v = idx >> 4, d4 = idx & 15; const f32x4_t x = *(const f32x4_t*)(kv + v * 64 + d4 * 4);
          *(LAS u32x2_t*)(sp + v * GL_LD + d4 * 4) = (u32x2_t){(unsigned)f2bf(x[0]) | ((unsigned)f2bf(x[1]) << 16), (unsigned)f2bf(x[2]) | ((unsigned)f2bf(x[3]) << 16)}; } }
    __syncthreads();
    const int mt = wv & 3;
    {
        const int nt0 = (wv >> 2) * 2; f32x4_t acc[2] = {(f32x4_t){0.f, 0.f, 0.f, 0.f}, (f32x4_t){0.f, 0.f, 0.f, 0.f}};
#pragma unroll
        for (int kb = 0; kb < 2; ++kb) { const bf16x8_t a = lds_frag(qd, 16 * mt + lr, kb * 32 + 8 * lq);
#pragma unroll
            for (int nn = 0; nn < 2; ++nn) acc[nn] = __builtin_amdgcn_mfma_f32_16x16x32_bf16(a, lds_frag(kd, 16 * (nt0 + nn) + lr, kb * 32 + 8 * lq), acc[nn], 0, 0, 0); }
#pragma unroll
        for (int nn = 0; nn < 2; ++nn)
#pragma unroll
            for (int r = 0; r < 4; ++r) { const int i = 16 * mt + 4 * lq + r, j = 16 * (nt0 + nn) + lr; pm[i * GL_LD + j] = f2bf(j <= i ? acc[nn][r] : 0.f); }
    }
    __syncthreads();
    const int ntb = (wv >> 2) * 4; f32x4_t acc[4];
#pragma unroll
    for (int nn = 0; nn < 4; ++nn) acc[nn] = (f32x4_t){0.f, 0.f, 0.f, 0.f};
#pragma unroll
    for (int kb = 0; kb < 2; ++kb) { const bf16x8_t a1 = lds_frag(pm, 16 * mt + lr, kb * 32 + 8 * lq), a2 = lds_frag(qd, 16 * mt + lr, kb * 32 + 8 * lq);
#pragma unroll
        for (int nn = 0; nn < 4; ++nn) { acc[nn] = __builtin_amdgcn_mfma_f32_16x16x32_bf16(a1, lds_frag(vt, 16 * (ntb + nn) + lr, kb * 32 + 8 * lq), acc[nn], 0, 0, 0);
            acc[nn] = __builtin_amdgcn_mfma_f32_16x16x32_bf16(a2, lds_frag(sp, 16 * (ntb + nn) + lr, kb * 32 + 8 * lq), acc[nn], 0, 0, 0); } }
#pragma unroll
    for (int r = 0; r < 4; ++r) { float ss = 0.f;
#pragma unroll
        for (int nn = 0; nn < 4; ++nn) ss += acc[nn][r] * acc[nn][r];
        ss += __shfl_xor(ss, 1); ss += __shfl_xor(ss, 2); ss += __shfl_xor(ss, 4); ss += __shfl_xor(ss, 8);
        if (lr == 0) red[(16 * mt + 4 * lq + r) * 2 + (wv >> 2)] = ss; }
    __syncthreads();
#pragma unroll
    for (int r = 0; r < 4; ++r) { const int i = 16 * mt + 4 * lq + r; const float rstd = 1.f / sqrtf((red[i * 2] + red[i * 2 + 1]) * (1.f / 128.f) + 1e-5f);
        const size_t row = (size_t)n * 64 + i;
#pragma unroll
        for (int nn = 0; nn < 4; ++nn) { const int v = 16 * (ntb + nn) + lr; const float g = bf2f(P[row * NP0 + 1024 + h * 128 + v]);
            OMIX[row * 1024 + h * 128 + v] = f2bf(acc[nn][r] * rstd * norm_g[h * 128 + v] * (g / (1.f + __expf(-g)))); } }
    __syncthreads();
}
__device__ __forceinline__ void gla_state_scan(int e, float* KVS, const float* DEC) {
    const int h = e >> 13, vd = e & 8191, d = e & 63; float s = 0.f;
#pragma unroll 4
    for (int n = 0; n < 256; ++n) { float* p = KVS + (size_t)(n * 4 + h) * 8192 + vd; const float kv = *p, dec = DEC[(n * 4 + h) * 64 + d]; *p = s; s = dec * s + kv; }
}

constexpr int SD_LD = 136;
constexpr int SD_ACS = 0, SD_T0 = 4096, SD_T1 = SD_T0 + 128 * SD_LD * 2, SD_X = SD_T1 + 128 * SD_LD * 2, SD_PV = SD_X + 64 * SD_LD * 2;
static_assert(SD_PV + 64 * SD_LD * 2 <= 131072, "SSD LDS");
__device__ __forceinline__ void ssd_prep_oct(int idx, const bf16* P, const float* conv_w, const float* conv_b, bf16* XBC) {
    const int t = idx / 192, c0 = (idx % 192) * 8;
    float y[8];
#pragma unroll
    for (int e = 0; e < 8; ++e) y[e] = conv_b[c0 + e];
#pragma unroll
    for (int i = 0; i < 4; ++i) { const int tt = t - 3 + i; if (tt >= 0) { float x[8]; unpack8(*(const uint4*)(P + (size_t)tt * NP1 + 1024 + c0), x);
#pragma unroll
        for (int e = 0; e < 8; ++e) y[e] += conv_w[i * 1536 + c0 + e] * x[e]; } }
    unsigned w[4];
#pragma unroll
    for (int e = 0; e < 8; e += 2) { const float a = y[e] / (1.f + __expf(-y[e])), b = y[e + 1] / (1.f + __expf(-y[e + 1])); w[e >> 1] = (unsigned)f2bf(a) | ((unsigned)f2bf(b) << 16); }
    *(uint4*)(XBC + (size_t)t * 1536 + c0) = make_uint4(w[0], w[1], w[2], w[3]);
}
__device__ __forceinline__ void ssd_dt_item2(int idx, const bf16* P, const float* dt_bias, const float* a_log, float* DT, float* AA) {
    const int t = idx >> 4, h = idx & 15;
    const float x = bf2f(P[(size_t)t * NP1 + 4096 + h]) + dt_bias[h];
    const float dt = x > 20.f ? x : log1pf(expf(x));
    DT[idx] = dt; AA[idx] = -dt * expf(a_log[h]);
}
__device__ __forceinline__ void ssd_acs(int c, int g, int wv, int ln, LAS float* acs, const float* AA) {
    const int h = g * 8 + wv, t0 = c * 128;
    const float a0 = AA[(size_t)(t0 + 2 * ln) * 16 + h], a1 = AA[(size_t)(t0 + 2 * ln + 1) * 16 + h];
    float s = a0 + a1;
#pragma unroll
    for (int o = 1; o < 64; o <<= 1) { const float u = __shfl_up(s, o); if (ln >= o) s += u; }
    acs[wv * 128 + 2 * ln] = s - a1; acs[wv * 128 + 2 * ln + 1] = s;
}
__device__ __forceinline__ bf16x8_t sd_frag(const LAS bf16* base, int row, int k0) { return *(const LAS bf16x8_t*)(base + row * SD_LD + k0); }
__device__ __forceinline__ void ssd_state_item(int item, int tl, LAS unsigned char* lds, const bf16* XBC, const float* DT, const float* AA, float* ST, float* CDEC) {
    const int c = item >> 1, g = item & 1, wv = tl >> 6, ln = tl & 63, lr = ln & 15, lq = ln >> 4, t0 = c * 128;
    LAS float* acs = (LAS float*)(lds + SD_ACS); LAS bf16* bt = (LAS bf16*)(lds + SD_T0); LAS bf16* xdt = (LAS bf16*)(lds + SD_X);
    ssd_acs(c, g, wv, ln, acs, AA);
#pragma unroll
    for (int i = 0; i < 4; ++i) { const int task = tl + 512 * i, sidx = task >> 4, noct = task & 15; const uint4 u = *(const uint4*)(XBC + (size_t)(t0 + sidx) * 1536 + 1024 + g * 128 + noct * 8);
        const unsigned w[4] = {u.x, u.y, u.z, u.w};
#pragma unroll
        for (int e = 0; e < 8; ++e) bt[(noct * 8 + e) * SD_LD + sidx] = (bf16)((e & 1) ? (w[e >> 1] >> 16) : (w[e >> 1] & 0xffffu)); }
    __syncthreads();
#pragma unroll 1
    for (int hh = 0; hh < 8; ++hh) {
        const int h = g * 8 + hh; const float alast = acs[hh * 128 + 127];
#pragma unroll
        for (int i = 0; i < 2; ++i) { const int task = tl + 512 * i, sidx = task >> 3, poct = task & 7; float x[8]; unpack8(*(const uint4*)(XBC + (size_t)(t0 + sidx) * 1536 + h * 64 + poct * 8), x);
            const float f = DT[(size_t)(t0 + sidx) * 16 + h] * __expf(alast - acs[hh * 128 + sidx]);
#pragma unroll
            for (int e = 0; e < 8; ++e) xdt[(poct * 8 + e) * SD_LD + sidx] = f2bf(x[e] * f); }
        __syncthreads();
        const int mt = wv & 3, ntb = (wv >> 2) * 4; f32x4_t acc[4];
#pragma unroll
        for (int nn = 0; nn < 4; ++nn) acc[nn] = (f32x4_t){0.f, 0.f, 0.f, 0.f};
#pragma unroll
        for (int kb = 0; kb < 4; ++kb) { const bf16x8_t a = sd_frag(xdt, 16 * mt + lr, kb * 32 + 8 * lq);
#pragma unroll
            for (int nn = 0; nn < 4; ++nn) acc[nn] = __builtin_amdgcn_mfma_f32_16x16x32_bf16(a, sd_frag(bt, 16 * (ntb + nn) + lr, kb * 32 + 8 * lq), acc[nn], 0, 0, 0); }
        float* st = ST + (size_t)(c * 16 + h) * 8192;
#pragma unroll
        for (int nn = 0; nn < 4; ++nn)
#pragma unroll
            for (int r = 0; r < 4; ++r) st[(16 * mt + 4 * lq + r) * 128 + 16 * (ntb + nn) + lr] = acc[nn][r];
        if (tl == 0) CDEC[c * 16 + h] = __expf(alast);
        __syncthreads();
    }
}
__device__ __forceinline__ void ssd_state_scan(int e, float* ST, const float* CDEC) {
    const int h = e >> 13; float s = 0.f;
#pragma unroll 4
    for (int c = 0; c < 128; ++c) { float* p = ST + (size_t)c * 131072 + e; const float st = *p, dec = CDEC[c * 16 + h]; *p = s; s = dec * s + st; }
}
__device__ __forceinline__ void ssd_out_item(int item, int tl, LAS unsigned char* lds, const bf16* P, const bf16* XBC, const float* DT, const float* AA, const float* ST, const float* d_skip, const float* norm_g, bf16* OMIX) {
    const int c = item >> 1, g = item & 1, wv = tl >> 6, ln = tl & 63, lr = ln & 15, lq = ln >> 4, t0 = c * 128;
    LAS float* acs = (LAS float*)(lds + SD_ACS); LAS bf16* cc = (LAS bf16*)(lds + SD_T0); LAS bf16* bb = (LAS bf16*)(lds + SD_T1); LAS bf16* pw = bb;
    LAS bf16* xdt = (LAS bf16*)(lds + SD_X); LAS bf16* pv = (LAS bf16*)(lds + SD_PV);
    ssd_acs(c, g, wv, ln, acs, AA);
#pragma unroll
    for (int i = 0; i < 4; ++i) { const int task = tl + 512 * i, sidx = task >> 4, noct = task & 15; const bf16* src = XBC + (size_t)(t0 + sidx) * 1536 + 1024 + g * 128 + noct * 8;
        const uint4 ub = *(const uint4*)src, uc = *(const uint4*)(src + 256);
        *(LAS u32x4_t*)(bb + sidx * SD_LD + noct * 8) = (u32x4_t){ub.x, ub.y, ub.z, ub.w}; *(LAS u32x4_t*)(cc + sidx * SD_LD + noct * 8) = (u32x4_t){uc.x, uc.y, uc.z, uc.w}; }
    __syncthreads();
    bf16x8_t cf[4]; f32x4_t cb[8];
#pragma unroll
    for (int kb = 0; kb < 4; ++kb) cf[kb] = sd_frag(cc, 16 * wv + lr, kb * 32 + 8 * lq);
#pragma unroll
    for (int nt = 0; nt < 8; ++nt) { cb[nt] = (f32x4_t){0.f, 0.f, 0.f, 0.f};
#pragma unroll
        for (int kb = 0; kb < 4; ++kb) cb[nt] = __builtin_amdgcn_mfma_f32_16x16x32_bf16(cf[kb], sd_frag(bb, 16 * nt + lr, kb * 32 + 8 * lq), cb[nt], 0, 0, 0); }
    __syncthreads();
    float ss[4] = {0.f, 0.f, 0.f, 0.f};
#pragma unroll 1
    for (int hh = 0; hh < 8; ++hh) {
        const int h = g * 8 + hh;
#pragma unroll
        for (int i = 0; i < 2; ++i) { const int task = tl + 512 * i, sidx = task >> 3, poct = task & 7; float x[8]; unpack8(*(const uint4*)(XBC + (size_t)(t0 + sidx) * 1536 + h * 64 + poct * 8), x);
            const float f = DT[(size_t)(t0 + sidx) * 16 + h];
#pragma unroll
            for (int e = 0; e < 8; ++e) xdt[(poct * 8 + e) * SD_LD + sidx] = f2bf(x[e] * f); }
        { const float* st = ST + (size_t)(c * 16 + h) * 8192;
#pragma unroll
          for (int i = 0; i < 4; ++i) { const int idx = tl + 512 * i, p = idx >> 5, n4 = idx & 31; const f32x4_t x = *(const f32x4_t*)(st + p * 128 + n4 * 4);
              *(LAS u32x2_t*)(pv + p * SD_LD + n4 * 4) = (u32x2_t){(unsigned)f2bf(x[0]) | ((unsigned)f2bf(x[1]) << 16), (unsigned)f2bf(x[2]) | ((unsigned)f2bf(x[3]) << 16)}; } }
        float al[4];
#pragma unroll
        for (int r = 0; r < 4; ++r) al[r] = acs[hh * 128 + 16 * wv + 4 * lq + r];
#pragma unroll
        for (int nt = 0; nt < 8; ++nt) { const int sidx = 16 * nt + lr; const float as = acs[hh * 128 + sidx];
#pragma unroll
            for (int r = 0; r < 4; ++r) { const int l = 16 * wv + 4 * lq + r; pw[l * SD_LD + sidx] = f2bf(sidx <= l ? cb[nt][r] * __expf(al[r] - as) : 0.f); } }
        __syncthreads();
        f32x4_t yd[4], yo[4];
#pragma unroll
        for (int nn = 0; nn < 4; ++nn) { yd[nn] = (f32x4_t){0.f, 0.f, 0.f, 0.f}; yo[nn] = (f32x4_t){0.f, 0.f, 0.f, 0.f}; }
#pragma unroll
        for (int kb = 0; kb < 4; ++kb) { const bf16x8_t a = sd_frag(pw, 16 * wv + lr, kb * 32 + 8 * lq);
#pragma unroll
            for (int nn = 0; nn < 4; ++nn) { yd[nn] = __builtin_amdgcn_mfma_f32_16x16x32_bf16(a, sd_frag(xdt, 16 * nn + lr, kb * 32 + 8 * lq), yd[nn], 0, 0, 0);
                yo[nn] = __builtin_amdgcn_mfma_f32_16x16x32_bf16(cf[kb], sd_frag(pv, 16 * nn + lr, kb * 32 + 8 * lq), yo[nn], 0, 0, 0); } }
        const float dsk = d_skip[h];
#pragma unroll
        for (int r = 0; r < 4; ++r) { const size_t row = (size_t)t0 + 16 * wv + 4 * lq + r; const float ea = __expf(al[r]);
#pragma unroll
            for (int nn = 0; nn < 4; ++nn) { const int ch = h * 64 + 16 * nn + lr;
                const float x = bf2f(XBC[row * 1536 + ch]), z = bf2f(P[row * NP1 + ch]);
                const float val = (yd[nn][r] + ea * yo[nn][r] + dsk * x) * (z / (1.f + __expf(-z)));
                ss[r] += val * val; OMIX[row * 1536 + ch] = f2bf(val); } }
        __syncthreads();
    }
#pragma unroll
    for (int r = 0; r < 4; ++r) { float q = ss[r]; q += __shfl_xor(q, 1); q += __shfl_xor(q, 2); q += __shfl_xor(q, 4); q += __shfl_xor(q, 8); ss[r] = 1.f / sqrtf(q * (1.f / 512.f) + 1e-5f); }
#pragma unroll 1
    for (int hh = 0; hh < 8; ++hh)
#pragma unroll
        for (int r = 0; r < 4; ++r) { const size_t row = (size_t)t0 + 16 * wv + 4 * lq + r;
#pragma unroll
            for (int nn = 0; nn < 4; ++nn) { const int ch = (g * 8 + hh) * 64 + 16 * nn + lr; bf16* o = OMIX + row * 1536 + ch; *o = f2bf(bf2f(*o) * ss[r] * norm_g[ch]); } }
    __syncthreads();
}

namespace pg8 {
typedef short bf16x8 __attribute__((ext_vector_type(8)));
typedef float f32x4 __attribute__((ext_vector_type(4)));
typedef unsigned u32x4 __attribute__((ext_vector_type(4)));
constexpr int BM = 256, BK = 64, HALF = 128, HTB = HALF * BK * 2, STAGE_BYTES = 8 * HTB, NXCD = 8, WGM = 8;
__host__ __device__ __forceinline__ int lds_byte(int r, int c) { const int st = (r >> 4) * 2 + (c >> 5), rr = r & 15, cc = c & 31, ob = rr * 64 + cc * 2; return st * 1024 + (ob ^ (((ob >> 9) & 1) << 5)); }
__host__ __device__ __forceinline__ void stage_rc(int b, int& R, int& C) { const int st = b / 1024, sb = b % 1024, swz = sb ^ (((sb >> 9) & 1) << 5); R = (st >> 1) * 16 + swz / 64; C = (st & 1) * 32 + (swz % 64) / 2; }
__host__ __device__ __forceinline__ int perm32(int rho) { const int n = rho >> 4, i = rho & 15; return 8 * (i >> 2) + 4 * n + (i & 3); }
struct Unit { int pm, pn; };
struct Gemm { const bf16* A; const bf16* Bt; const int* tile_e; size_t a_pn_step, b_tstep, b_estep; int lda, ldb, K, pad; };
struct StaticOrder {
    int nM, nN, nwg, G, c;
    __device__ void init(int Mr, int N, int G_, int c_) { nM = Mr / BM; nN = N / BM; nwg = nM * nN; G = G_; c = c_; }
    __device__ bool next(int i, Unit& u) const {
        const long L = (long)i * G + c; if (L >= nwg) return false;
        int wgid = (int)L; { const int q = nwg / NXCD, r = nwg % NXCD, xcd = wgid % NXCD, off = wgid / NXCD; wgid = (xcd < r ? xcd * (q + 1) : r * (q + 1) + (xcd - r) * q) + off; }
        const int nig = WGM * nN, gid = wgid / nig, fm = gid * WGM, gsz = (nM - fm) < WGM ? (nM - fm) : WGM;
        u.pm = fm + ((wgid % nig) % gsz); u.pn = (wgid % nig) / gsz; return true;
    }
    __device__ __forceinline__ void a_ready(const Unit&) const {}
    __device__ __forceinline__ void done(const Unit&) const {}
};
__device__ __forceinline__ unsigned cvt_pk_bf16(float lo, float hi) { unsigned r; asm volatile("v_cvt_pk_bf16_f32 %0, %1, %2" : "=v"(r) : "v"(lo), "v"(hi)); return r; }
__device__ __forceinline__ u32x4 pack8(const f32x4 v0, const f32x4 v1) { u32x4 w; w.x = cvt_pk_bf16(v0[0], v0[1]); w.y = cvt_pk_bf16(v0[2], v0[3]); w.z = cvt_pk_bf16(v1[0], v1[1]); w.w = cvt_pk_bf16(v1[2], v1[3]); return w; }
struct EpBf {
    static constexpr bool PERM = true, AFTER_DRAIN = false;
    bf16* O; int ldc; float scale;
    __device__ __forceinline__ void operator()(const f32x4 (&acc)[2][2][4][2], const Unit& u, int wr, int wc, int fr, int fq) const {
        const int row0 = u.pm * BM + wr * 64 + fr, col0 = u.pn * BM + wc * 32 + 8 * fq;
#pragma unroll
        for (int ai = 0; ai < 2; ++ai)
#pragma unroll
            for (int m = 0; m < 4; ++m) { bf16* rowp = O + (size_t)(row0 + ai * HALF + m * 16) * ldc + col0;
#pragma unroll
                for (int bj = 0; bj < 2; ++bj) *(u32x4*)(rowp + bj * HALF) = pack8(acc[ai][bj][m][0] * scale, acc[ai][bj][m][1] * scale); }
    }
};
struct EpRes {
    static constexpr bool PERM = false, AFTER_DRAIN = false;
    const float* base; float* out;
    __device__ __forceinline__ void operator()(const f32x4 (&acc)[2][2][4][2], const Unit& u, int wr, int wc, int fr, int fq) const {
        const int row0 = u.pm * BM + wr * 64 + fr, col0 = u.pn * BM + wc * 32 + 4 * fq;
#pragma unroll
        for (int ai = 0; ai < 2; ++ai)
#pragma unroll
            for (int m = 0; m < 4; ++m) { const size_t off = (size_t)(row0 + ai * HALF + m * 16) * D + col0;
#pragma unroll
                for (int bj = 0; bj < 2; ++bj)
#pragma unroll
                    for (int n = 0; n < 2; ++n) { const f32x4 bs = *(const f32x4*)(base + off + bj * HALF + n * 16); *(f32x4*)(out + off + bj * HALF + n * 16) = bs * ALPHA + acc[ai][bj][m][n]; } }
    }
};
struct EpSilu {
    static constexpr bool PERM = true, AFTER_DRAIN = false;
    bf16* O; int ldc; int pad;
    __device__ __forceinline__ void operator()(const f32x4 (&acc)[2][2][4][2], const Unit& u, int wr, int wc, int fr, int fq) const {
        const int row0 = u.pm * BM + wr * 64 + fr, col0 = u.pn * HALF + wc * 32 + 8 * fq;
#pragma unroll
        for (int ai = 0; ai < 2; ++ai)
#pragma unroll
            for (int m = 0; m < 4; ++m) { f32x4 h[2];
#pragma unroll
                for (int n = 0; n < 2; ++n)
#pragma unroll
                    for (int j = 0; j < 4; ++j) { const float g = acc[ai][0][m][n][j]; h[n][j] = g / (1.f + __expf(-g)) * acc[ai][1][m][n][j]; }
                *(u32x4*)(O + (size_t)(row0 + ai * HALF + m * 16) * ldc + col0) = pack8(h[0], h[1]); }
    }
};
struct EpYR {
    static constexpr bool PERM = true, AFTER_DRAIN = false;
    bf16* YR; const int* row_tok; const int* tile_e; const int* meta; int row_off; int pad;
    __device__ __forceinline__ void operator()(const f32x4 (&acc)[2][2][4][2], const Unit& u, int wr, int wc, int fr, int fq) const {
        const int row0 = u.pm * BM + wr * 64 + fr, col0 = u.pn * BM + wc * 32 + 8 * fq;
        const int shift = row_off - meta[8 + tile_e[u.pm]];
#pragma unroll
        for (int ai = 0; ai < 2; ++ai)
#pragma unroll
            for (int m = 0; m < 4; ++m) { const int r = row0 + ai * HALF + m * 16;
                if (row_tok[r] >= 0) { bf16* rowp = YR + (size_t)(r + shift) * D + col0;
#pragma unroll
                    for (int bj = 0; bj < 2; ++bj) *(u32x4*)(rowp + bj * HALF) = pack8(acc[ai][bj][m][0], acc[ai][bj][m][1]); } }
    }
};
struct EpSoftmax {
    static constexpr bool PERM = true, AFTER_DRAIN = true;
    bf16* O; int ldc; int pad;
    __device__ __forceinline__ void fused(f32x4 (&acc)[2][2][4][2], const Unit& u, int wr, int wc, int fr, int fq, LAS unsigned char* lds, int wid, int lane) const {
        LAS float* T1 = (LAS float*)lds; LAS float* T2 = T1 + 1024;
#pragma unroll
        for (int ai = 0; ai < 2; ++ai)
#pragma unroll
            for (int m = 0; m < 4; ++m) { float v = -INFINITY;
#pragma unroll
                for (int bj = 0; bj < 2; ++bj)
#pragma unroll
                    for (int n = 0; n < 2; ++n) { const f32x4 x = acc[ai][bj][m][n]; v = fmaxf(v, fmaxf(fmaxf(x[0], x[1]), fmaxf(x[2], x[3]))); }
                v = fmaxf(v, __shfl_xor(v, 16)); v = fmaxf(v, __shfl_xor(v, 32));
                if (fq == 0) T1[(ai * HALF + wr * 64 + m * 16 + fr) * 4 + wc] = v; }
        asm volatile("s_waitcnt lgkmcnt(0)" ::: "memory"); __builtin_amdgcn_s_barrier(); asm volatile("" ::: "memory");
#pragma unroll
        for (int ai = 0; ai < 2; ++ai)
#pragma unroll
            for (int m = 0; m < 4; ++m) { const int r = ai * HALF + wr * 64 + m * 16 + fr; const f32x4 t = *(const LAS f32x4*)(T1 + r * 4);
                const float mx = fmaxf(fmaxf(t[0], t[1]), fmaxf(t[2], t[3])); float s = 0.f;
#pragma unroll
                for (int bj = 0; bj < 2; ++bj)
#pragma unroll
                    for (int n = 0; n < 2; ++n)
#pragma unroll
                        for (int j = 0; j < 4; ++j) { const float e = __expf(acc[ai][bj][m][n][j] - mx); acc[ai][bj][m][n][j] = e; s += e; }
                s += __shfl_xor(s, 16); s += __shfl_xor(s, 32);
                if (fq == 0) T2[r * 4 + wc] = s; }
        asm volatile("s_waitcnt lgkmcnt(0)" ::: "memory"); __builtin_amdgcn_s_barrier(); asm volatile("" ::: "memory");
        const int row0 = u.pm * BM + wr * 64 + fr, col0 = u.pn * BM + wc * 32 + 8 * fq;
#pragma unroll
        for (int ai = 0; ai < 2; ++ai)
#pragma unroll
            for (int m = 0; m < 4; ++m) { const int r = ai * HALF + wr * 64 + m * 16 + fr; const f32x4 t = *(const LAS f32x4*)(T2 + r * 4);
                const float inv = 1.f / ((t[0] + t[1]) + (t[2] + t[3]));
                bf16* rowp = O + (size_t)(row0 + ai * HALF + m * 16) * ldc + col0;
#pragma unroll
                for (int bj = 0; bj < 2; ++bj) *(u32x4*)(rowp + bj * HALF) = pack8(acc[ai][bj][m][0] * inv, acc[ai][bj][m][1] * inv); }
        asm volatile("s_waitcnt lgkmcnt(0)" ::: "memory"); __builtin_amdgcn_s_barrier(); asm volatile("" ::: "memory");
    }
};

template <class Epi, class Sched, bool ALIGN_EPI, bool SP2>
__device__ __forceinline__ void gemm_phase(LAS unsigned char* lds, const Gemm g, const Sched& S, const Epi& E, const int tid) {
    const int wid = __builtin_amdgcn_readfirstlane(tid >> 6), lane = tid & 63, wr = wid >> 2, wc = wid & 3, fr = lane & 15, fq = lane >> 4;
    const int K = g.K, nt = K / BK;
    unsigned voffA[2], voffB[2];
#pragma unroll
    for (int i = 0; i < 2; ++i) { int R, C; stage_rc(tid * 16 + i * 8192, R, C); const int Rb = Epi::PERM ? ((R & ~31) + perm32(R & 31)) : R;
        voffA[i] = (unsigned)(R * g.lda + C) * 2u; voffB[i] = (unsigned)(Rb * g.ldb + C) * 2u; }
    const size_t kstep = (size_t)(BK * 2);
    const size_t hstepA = (size_t)HALF * g.lda * 2, hstepB = (size_t)HALF * g.ldb * 2;
    const size_t tstepA = 2 * hstepA;
    const unsigned ldsw = (unsigned)wid * 1024u;
    const int aoff = lds_byte(wr * 64 + fr, fq * 8), boff = lds_byte(wc * 32 + fr, fq * 8);
#define PG8_SA(b, h) (((b) * 2 + (h)) * HTB)
#define PG8_SB(b, h) ((4 + (b) * 2 + (h)) * HTB)
#define PG8_STAGE(bufoff, gbase, voff) do { _Pragma("unroll") for (int _i = 0; _i < 2; ++_i) \
        __builtin_amdgcn_global_load_lds((const unsigned*)((const char*)(gbase) + (voff)[_i]), (LAS unsigned*)(lds + (bufoff) + ldsw + _i * 8192), 16, 0, 0); } while (0)
#define PG8_LDA(dst, b, h) do { _Pragma("unroll") for (int m = 0; m < 4; ++m) _Pragma("unroll") for (int k = 0; k < 2; ++k) dst[m][k] = *(const LAS bf16x8*)(lds + PG8_SA(b, h) + aoff + m * 2048 + k * 1024); } while (0)
#define PG8_LDB(dst, b, h) do { _Pragma("unroll") for (int n = 0; n < 2; ++n) _Pragma("unroll") for (int k = 0; k < 2; ++k) dst[n][k] = *(const LAS bf16x8*)(lds + PG8_SB(b, h) + boff + n * 2048 + k * 1024); } while (0)
#define PG8_MMA(ai, bj, At, Bt) do { __builtin_amdgcn_s_setprio(1); _Pragma("unroll") for (int m = 0; m < 4; ++m) _Pragma("unroll") for (int n = 0; n < 2; ++n) _Pragma("unroll") for (int k = 0; k < 2; ++k) \
        acc[ai][bj][m][n] = __builtin_amdgcn_mfma_f32_16x16x32_bf16(Bt[n][k], At[m][k], acc[ai][bj][m][n], 0, 0, 0); __builtin_amdgcn_s_setprio(0); } while (0)
#define PG8_WAIT_V(n) asm volatile("s_waitcnt vmcnt(" #n ")" ::: "memory")
#define PG8_WAIT_L(n) asm volatile("s_waitcnt lgkmcnt(" #n ")" ::: "memory")
#define PG8_BAR __builtin_amdgcn_s_barrier()
#define PG8_SCHED __builtin_amdgcn_sched_barrier(0)
#define PG8_APTR(u) ((const char*)g.A + (size_t)(u).pm * tstepA + (size_t)(u).pn * g.a_pn_step)
#define PG8_BPTR(u) ((const char*)g.Bt + (size_t)(u).pn * g.b_tstep + (g.tile_e ? (size_t)g.tile_e[(u).pm] * g.b_estep : (size_t)0))
    Unit cur, nxt; int ui = 0;
    if (!S.next(0, cur)) return;
    f32x4 acc[2][2][4][2];
#pragma unroll
    for (int a = 0; a < 2; ++a)
#pragma unroll
        for (int b = 0; b < 2; ++b)
#pragma unroll
            for (int m = 0; m < 4; ++m)
#pragma unroll
                for (int n = 0; n < 2; ++n) acc[a][b][m][n] = (f32x4){0.f, 0.f, 0.f, 0.f};
    bf16x8 At[4][2], B0[2][2], B1[2][2];
    const char* cA = PG8_APTR(cur); const char* cB = PG8_BPTR(cur);
    S.a_ready(cur);
    if constexpr (SP2) {
        PG8_STAGE(PG8_SB(0, 0), cB, voffB); PG8_STAGE(PG8_SB(0, 1), cB + hstepB, voffB); PG8_STAGE(PG8_SA(0, 0), cA, voffA); PG8_STAGE(PG8_SA(0, 1), cA + hstepA, voffA);
        if (wr == 1) PG8_BAR;
        PG8_WAIT_V(2); PG8_BAR;
        PG8_STAGE(PG8_SB(1, 0), cB + kstep, voffB); PG8_STAGE(PG8_SA(1, 0), cA + kstep, voffA); PG8_STAGE(PG8_SB(1, 1), cB + hstepB + kstep, voffB);
        PG8_WAIT_V(6); PG8_BAR;
    } else {
        PG8_STAGE(PG8_SB(0, 0), cB, voffB); PG8_STAGE(PG8_SA(0, 0), cA, voffA); PG8_STAGE(PG8_SB(0, 1), cB + hstepB, voffB); PG8_STAGE(PG8_SA(0, 1), cA + hstepA, voffA);
        if (wr == 1) PG8_BAR;
        PG8_WAIT_V(4); PG8_BAR;
        PG8_STAGE(PG8_SB(1, 0), cB + kstep, voffB); PG8_STAGE(PG8_SA(1, 0), cA + kstep, voffA); PG8_STAGE(PG8_SB(1, 1), cB + hstepB + kstep, voffB);
        PG8_WAIT_V(6); PG8_BAR;
    }
    for (;;) {
        const bool has_next = S.next(ui + 1, nxt);
        const char* nA = has_next ? PG8_APTR(nxt) : cA; const char* nB = has_next ? PG8_BPTR(nxt) : cB;
        for (int t = 0; t < nt; t += 2) {
            const bool last = (t == nt - 2);
            const char* a1 = cA + (size_t)(t + 1) * kstep;
            const char* a2 = last ? nA : cA + (size_t)(t + 2) * kstep; const char* b2 = last ? nB : cB + (size_t)(t + 2) * kstep;
            const char* a3 = a2 + kstep; const char* b3 = b2 + kstep;
            if (last && has_next) S.a_ready(nxt);
            if constexpr (SP2) {
            PG8_LDB(B0, 0, 0); PG8_LDB(B1, 0, 1); PG8_SCHED; PG8_LDA(At, 0, 0); PG8_STAGE(PG8_SA(1, 1), a1 + hstepA, voffA);
            PG8_WAIT_V(8); PG8_WAIT_L(0); PG8_BAR; PG8_MMA(0, 0, At, B0); PG8_MMA(0, 1, At, B1); PG8_BAR; PG8_SCHED;
            PG8_LDA(At, 0, 1); PG8_STAGE(PG8_SB(0, 0), b2, voffB); PG8_STAGE(PG8_SB(0, 1), b2 + hstepB, voffB); PG8_STAGE(PG8_SA(0, 0), a2, voffA);
            PG8_WAIT_V(8); PG8_WAIT_L(0); PG8_BAR; PG8_MMA(1, 0, At, B0); PG8_MMA(1, 1, At, B1); PG8_BAR; PG8_SCHED;
            PG8_LDB(B0, 1, 0); PG8_LDB(B1, 1, 1); PG8_SCHED; PG8_LDA(At, 1, 0); PG8_STAGE(PG8_SA(0, 1), a2 + hstepA, voffA);
            PG8_WAIT_V(8); PG8_WAIT_L(0); PG8_BAR; PG8_MMA(0, 0, At, B0); PG8_MMA(0, 1, At, B1); PG8_BAR; PG8_SCHED;
            PG8_LDA(At, 1, 1); PG8_STAGE(PG8_SB(1, 0), b3, voffB); PG8_STAGE(PG8_SB(1, 1), b3 + hstepB, voffB); PG8_STAGE(PG8_SA(1, 0), a3, voffA);
            PG8_WAIT_V(8); PG8_WAIT_L(0); PG8_BAR; PG8_MMA(1, 0, At, B0); PG8_MMA(1, 1, At, B1); PG8_BAR; PG8_SCHED;
            } else {
            PG8_LDB(B0, 0, 0); PG8_SCHED; PG8_LDA(At, 0, 0); PG8_STAGE(PG8_SA(1, 1), a1 + hstepA, voffA);
            PG8_WAIT_L(8); PG8_BAR; PG8_WAIT_L(0); PG8_MMA(0, 0, At, B0); PG8_BAR; PG8_SCHED;
            PG8_LDB(B1, 0, 1); PG8_STAGE(PG8_SB(0, 0), b2, voffB);
            PG8_BAR; PG8_WAIT_L(0); PG8_MMA(0, 1, At, B1); PG8_BAR;
            PG8_LDA(At, 0, 1); PG8_STAGE(PG8_SA(0, 0), a2, voffA);
            PG8_BAR; PG8_WAIT_L(0); PG8_MMA(1, 0, At, B0); PG8_BAR; PG8_SCHED;
            PG8_STAGE(PG8_SB(0, 1), b2 + hstepB, voffB);
            PG8_WAIT_V(6); PG8_BAR; PG8_MMA(1, 1, At, B1); PG8_BAR;
            PG8_LDB(B0, 1, 0); PG8_SCHED; PG8_LDA(At, 1, 0); PG8_STAGE(PG8_SA(0, 1), a2 + hstepA, voffA);
            PG8_WAIT_L(8); PG8_BAR; PG8_WAIT_L(0); PG8_MMA(0, 0, At, B0); PG8_BAR; PG8_SCHED;
            PG8_LDB(B1, 1, 1); PG8_STAGE(PG8_SB(1, 0), b3, voffB);
            PG8_BAR; PG8_WAIT_L(0); PG8_MMA(0, 1, At, B1); PG8_BAR;
            PG8_LDA(At, 1, 1); PG8_STAGE(PG8_SA(1, 0), a3, voffA);
            PG8_BAR; PG8_WAIT_L(0); PG8_MMA(1, 0, At, B0); PG8_BAR; PG8_SCHED;
            PG8_STAGE(PG8_SB(1, 1), b3 + hstepB, voffB);
            PG8_WAIT_V(6); PG8_BAR; PG8_MMA(1, 1, At, B1); PG8_BAR;
            }
        }
        if constexpr (ALIGN_EPI) { if (wr == 0) PG8_BAR; }
        if constexpr (!Epi::AFTER_DRAIN) { E(acc, cur, wr, wc, fr, fq); S.done(cur); }
        if (!has_next) break;
#pragma unroll
        for (int a = 0; a < 2; ++a)
#pragma unroll
            for (int b = 0; b < 2; ++b)
#pragma unroll
                for (int m = 0; m < 4; ++m)
#pragma unroll
                    for (int n = 0; n < 2; ++n) acc[a][b][m][n] = (f32x4){0.f, 0.f, 0.f, 0.f};
        cur = nxt; cA = nA; cB = nB; ++ui;
        if constexpr (ALIGN_EPI) { if (wr == 1) PG8_BAR; }
    }
    PG8_WAIT_V(0);
    if constexpr (!ALIGN_EPI) { if (wr == 0) PG8_BAR; }
    PG8_BAR;
    if constexpr (Epi::AFTER_DRAIN) { E.fused(acc, cur, wr, wc, fr, fq, lds, wid, lane); S.done(cur); }
#undef PG8_SA
#undef PG8_SB
#undef PG8_STAGE
#undef PG8_LDA
#undef PG8_LDB
#undef PG8_MMA
#undef PG8_WAIT_V
#undef PG8_WAIT_L
#undef PG8_BAR
#undef PG8_SCHED
#undef PG8_APTR
#undef PG8_BPTR
}
}

#define XB_TMO      128
#define XB_XCNT(j)  (256  + 64 * (j))
#define XB_XSUB(j)  (1280 + 64 * (j))
#define XB_XGEN(j)  (2304 + 64 * (j))
#define XB_TOP      3328
#define XB_TOPGEN   3392
#define XCD_BAR_WORDS 3456
#define XB_SPIN_CAP (1u << 28)
__device__ __forceinline__ unsigned xb_ld(unsigned* p)              { return __hip_atomic_load(p, __ATOMIC_RELAXED, __HIP_MEMORY_SCOPE_AGENT); }
__device__ __forceinline__ unsigned xb_add(unsigned* p, unsigned v) { return __hip_atomic_fetch_add(p, v, __ATOMIC_RELAXED, __HIP_MEMORY_SCOPE_AGENT); }
__device__ __forceinline__ unsigned xb_xcc_id() { return (unsigned)__builtin_amdgcn_s_getreg((3 << 11) | 20) & 0xFu; }
#define XB_SPIN(cond, bar) do { unsigned _sp = 0; while (cond) { __builtin_amdgcn_s_sleep(1); \
    if ((++_sp & 255u) == 0u) { if (xb_ld(&(bar)[XB_TMO])) break; if (_sp > XB_SPIN_CAP) { atomicAdd(&(bar)[XB_TMO], 1u); break; } } } } while (0)
struct XcdBarrier { unsigned* bar; unsigned x; volatile LAS unsigned* st; };
__device__ __forceinline__ XcdBarrier xcd_barrier_post(unsigned* bar, volatile LAS unsigned* st) {
    XcdBarrier b; b.bar = bar; b.x = xb_xcc_id(); b.st = st;
    if (threadIdx.x == 0) (void)xb_add(&bar[XB_XCNT(b.x)], 1u);
    return b;
}
__device__ __forceinline__ void xcd_barrier_complete(unsigned* bar, unsigned x, unsigned& nloc, unsigned& nx) {
    const unsigned G = gridDim.x * gridDim.y * gridDim.z;
    unsigned sum, cnt, mine, sp = 0u;
    for (;;) {
        sum = 0u; cnt = 0u; mine = 0u;
#pragma unroll
        for (unsigned j = 0; j < 16; ++j) { const unsigned c = xb_ld(&bar[XB_XCNT(j)]); sum += c; cnt += (c > 0u) ? 1u : 0u; mine = (j == x) ? c : mine; }
        if (sum == G) break;
        __builtin_amdgcn_s_sleep(1);
        if ((++sp & 255u) == 0u) { if (xb_ld(&bar[XB_TMO])) break; if (sp > XB_SPIN_CAP) { atomicAdd(&bar[XB_TMO], 1u); break; } }
    }
    nloc = mine > 0u ? mine : 1u; nx = cnt > 0u ? cnt : 1u;
}
__device__ __forceinline__ void xcd_barrier(const XcdBarrier& b) {
    asm volatile("s_waitcnt vmcnt(0)" ::: "memory");
    __syncthreads();
    if (threadIdx.x == 0) {
        unsigned* bar = b.bar;
        __builtin_amdgcn_s_waitcnt(0);
        unsigned nloc = b.st[0], nx = b.st[1];
        if (nloc == 0u) { xcd_barrier_complete(bar, b.x, nloc, nx); b.st[0] = nloc; b.st[1] = nx; }
        const unsigned old = xb_add(&bar[XB_XSUB(b.x)], 1u);
        const unsigned gen = old / nloc;
        if (old + 1u == (gen + 1u) * nloc) {
            __builtin_amdgcn_fence(__ATOMIC_RELEASE, "agent");
            asm volatile("s_waitcnt vmcnt(0)" ::: "memory");
            const unsigned og = xb_add(&bar[XB_TOP], 1u);
            const unsigned tg = og / nx;
            if (og + 1u == (tg + 1u) * nx) xb_add(&bar[XB_TOPGEN], 1u);
            else XB_SPIN(xb_ld(&bar[XB_TOPGEN]) == tg, bar);
            __builtin_amdgcn_fence(__ATOMIC_ACQUIRE, "agent");
            xb_add(&bar[XB_XGEN(b.x)], 1u);
            asm volatile("s_waitcnt vmcnt(0)" ::: "memory");
        } else {
            XB_SPIN(xb_ld(&bar[XB_XGEN(b.x)]) == gen, bar);
            __builtin_amdgcn_fence(__ATOMIC_ACQUIRE, "agent");
            asm volatile("s_waitcnt vmcnt(0)" ::: "memory");
        }
    }
    __syncthreads();
}

constexpr int NWAVES = 8;
constexpr int RING_BYTES = 131072, LDSCTL_OFF = RING_BYTES, MISC_OFF = LDSCTL_OFF + 320, LDS_BYTES = 147456;
constexpr int CW_BAR = 4096;
constexpr size_t W_GU0 = 209 * MiB, W_D0 = 220 * MiB, W_OUT0 = 225 * MiB + 512 * 1024, W_XQ0 = 227 * MiB + 512 * 1024, W_XO0 = 229 * MiB + 512 * 1024;
constexpr size_t W_IN0 = 265 * MiB, W_XK0 = 272 * MiB, W_XV0 = 274 * MiB;
constexpr size_t W_IN1 = 409 * MiB, W_OUT1 = 417 * MiB + 512 * 1024, W_XQ1 = 420 * MiB + 512 * 1024, W_XK1 = 422 * MiB + 512 * 1024, W_XV1 = 424 * MiB + 512 * 1024, W_XO1 = 426 * MiB + 512 * 1024;
constexpr size_t WS_MEMB = 428 * MiB + 512 * 1024, WS_KMEM0 = 429 * MiB, WS_VT0 = 429 * MiB + 512 * 1024, WS_KMEM1 = 430 * MiB, WS_VT1 = 430 * MiB + 512 * 1024;
constexpr size_t WS_HM = 65 * MiB, WS_XG = 159 * MiB, WS_YR = 227 * MiB, WS_RT = 291 * MiB, W_EGU = 292 * MiB, W_ED = 380 * MiB;
constexpr size_t EGU_STEP = 11 * MiB, ED_STEP = 5 * MiB + 512 * 1024;
constexpr size_t RT_TOPE = 0, RT_GATE = 128 * 1024, RT_ROWTOK = 256 * 1024, RT_SLOTROW = 512 * 1024, RT_TILEE = 640 * 1024, RT_META = 704 * 1024, RT_BC = 768 * 1024;

struct MArgs { const float* in[54]; float* out; unsigned char* ws; int ph_lo, ph_hi, li, pad; };
constexpr int PTAB_OFF = MISC_OFF + 128;
struct PTab { const LAS unsigned* t;
    __device__ __forceinline__ const float* operator[](int i) const { const unsigned lo = __builtin_amdgcn_readfirstlane(t[2 * i]), hi = __builtin_amdgcn_readfirstlane(t[2 * i + 1]);
        return (const float*)(((unsigned long long)hi << 32) | lo); } };
struct Ctx { PTab in; float* out; unsigned char* ws; };

struct CvtJob { const float* W0; const float* W1; bf16* dst; int ld, K, ndst, mode; };
__device__ __forceinline__ const float* cvt_src(const CvtJob& j, int n) {
    switch (j.mode) {
        case 0: return j.W0 + n;
        case 1: return n < 1552 ? j.W0 + n : (n < 1792 ? nullptr : j.W0 + (n - 240));
        case 2: return n < 2560 ? j.W0 + n : (n < 4096 ? j.W0 + (n + 16) : (n < 4112 ? j.W0 + (2560 + n - 4096) : nullptr));
        default: { const int pn = n >> 8, r = n & 255; return r < 128 ? j.W0 + (128 * pn + r) : j.W1 + (128 * pn + r - 128); }
    }
}
__device__ __forceinline__ unsigned pk2(float lo, float hi) { return (unsigned)f2bf(lo) | ((unsigned)f2bf(hi) << 16); }
__device__ __forceinline__ void cvt_item(const CvtJob& j, LAS float* scr, int item, int lane) {
    const int nblk = j.ndst / 32, kb = item / nblk, nb = item % nblk, k0 = 64 * kb, n0 = 32 * nb;
    const float* colp = cvt_src(j, n0 + (lane & 31));
#pragma unroll 8
    for (int i = 0; i < 32; ++i) { const int kk = 2 * i + (lane >> 5); scr[kk * 33 + (lane & 31)] = colp ? colp[(size_t)(k0 + kk) * j.ld] : 0.f; }
    asm volatile("s_waitcnt lgkmcnt(0)" ::: "memory");
    const int c = lane & 7;
#pragma unroll
    for (int jj = 0; jj < 4; ++jj) { const int n = (lane >> 3) + 8 * jj; const LAS float* sp = scr + (8 * c) * 33 + n;
        uint4 o; o.x = pk2(sp[0 * 33], sp[1 * 33]); o.y = pk2(sp[2 * 33], sp[3 * 33]); o.z = pk2(sp[4 * 33], sp[5 * 33]); o.w = pk2(sp[6 * 33], sp[7 * 33]);
        *(uint4*)(j.dst + (size_t)(n0 + n) * j.K + k0 + 8 * c) = o; }
    asm volatile("s_waitcnt lgkmcnt(0)" ::: "memory");
}
__device__ __forceinline__ CvtJob get_cvt_job(int idx, const Ctx& a) {
    unsigned char* ws = a.ws; CvtJob j; j.W1 = nullptr; j.mode = 0; j.ld = 1024; j.K = 1024; j.ndst = 1024;
    switch (idx) {
        case 0: j.W0 = a.in[2]; j.dst = (bf16*)(ws + W_IN0); j.ld = 3344; j.ndst = NP0; j.mode = 1; break;
        case 1: j.W0 = a.in[17]; j.dst = (bf16*)(ws + W_OUT0); break;
        case 2: j.W0 = a.in[20]; j.dst = (bf16*)(ws + W_XQ0); break;
        case 3: j.W0 = a.in[21]; j.dst = (bf16*)(ws + W_XK0); break;
        case 4: j.W0 = a.in[22]; j.dst = (bf16*)(ws + W_XV0); break;
        case 5: j.W0 = a.in[23]; j.dst = (bf16*)(ws + W_XO0); break;
        case 6: j.W0 = a.in[26]; j.W1 = a.in[27]; j.dst = (bf16*)(ws + W_GU0); j.ld = 2816; j.ndst = 5632; j.mode = 3; break;
        case 7: j.W0 = a.in[28]; j.dst = (bf16*)(ws + W_D0); j.K = 2816; break;
        case 8: j.W0 = a.in[31]; j.dst = (bf16*)(ws + W_IN1); j.ld = 4112; j.ndst = NP1; j.mode = 2; break;
        case 9: j.W0 = a.in[38]; j.dst = (bf16*)(ws + W_OUT1); j.K = 1536; break;
        case 10: j.W0 = a.in[41]; j.dst = (bf16*)(ws + W_XQ1); break;
        case 11: j.W0 = a.in[42]; j.dst = (bf16*)(ws + W_XK1); break;
        case 12: j.W0 = a.in[43]; j.dst = (bf16*)(ws + W_XV1); break;
        case 13: j.W0 = a.in[44]; j.dst = (bf16*)(ws + W_XO1); break;
        default: { const int e = (idx - 14) >> 1;
            if ((idx & 1) == 0) { j.W0 = a.in[49] + (size_t)e * 1024 * 2816; j.W1 = a.in[50] + (size_t)e * 1024 * 2816; j.dst = (bf16*)(ws + W_EGU + e * EGU_STEP); j.ld = 2816; j.ndst = 5632; j.mode = 3; }
            else { j.W0 = a.in[51] + (size_t)e * 2816 * 1024; j.dst = (bf16*)(ws + W_ED + e * ED_STEP); j.K = 2816; } } break;
    }
    return j;
}
__device__ __forceinline__ void cvt_jobs(int j_lo, int j_hi, const Ctx& args, LAS float* scr, int gw, int NGW, int ln) {
    int base = 0;
    for (int ji = j_lo; ji < j_hi; ++ji) {
        const CvtJob j = get_cvt_job(ji, args);
        const int nitems = (j.K / 64) * (j.ndst / 32);
        const int first = (gw - base % NGW + NGW) % NGW;
        for (int it = first; it < nitems; it += NGW) cvt_item(j, scr, it, ln);
        base += nitems;
    }
}
__device__ __forceinline__ void ln_row(const float* in, float* outf, bf16* outb, const float* g, const float* b, int lane, float4 (&o)[4]) {
    const float4* p = (const float4*)in + lane;
    float4 v[4]; float s = 0.f;
#pragma unroll
    for (int j = 0; j < 4; ++j) { v[j] = p[64 * j]; s += (v[j].x + v[j].y) + (v[j].z + v[j].w); }
    const float mean = wave_sum(s) * (1.f / D); float q = 0.f;
#pragma unroll
    for (int j = 0; j < 4; ++j) { v[j].x -= mean; v[j].y -= mean; v[j].z -= mean; v[j].w -= mean; q += (v[j].x * v[j].x + v[j].y * v[j].y) + (v[j].z * v[j].z + v[j].w * v[j].w); }
    const float rstd = 1.f / sqrtf(wave_sum(q) * (1.f / D) + 1e-5f);
#pragma unroll
    for (int j = 0; j < 4; ++j) {
        const int col = 4 * (lane + 64 * j);
        const float4 gg = *(const float4*)(g + col), bb = *(const float4*)(b + col);
        o[j].x = v[j].x * rstd * gg.x + bb.x; o[j].y = v[j].y * rstd * gg.y + bb.y; o[j].z = v[j].z * rstd * gg.z + bb.z; o[j].w = v[j].w * rstd * gg.w + bb.w;
        *(float4*)(outf + col) = o[j];
        if (outb) { uint2 w; w.x = pk2(o[j].x, o[j].y); w.y = pk2(o[j].z, o[j].w); *(uint2*)(outb + col) = w; }
    }
}
__device__ __forceinline__ int wave_sum_i(int v) {
#pragma unroll
    for (int o = 1; o < 64; o <<= 1) v += __shfl_xor(v, o);
    return v;
}

enum { K_PROLOGUE = 0, K_GEMM_BF, K_GEMM_RES, K_GEMM_SILU, K_GEMM_SOFTMAX, K_GEMM_YR, K_LN, K_L0_PREP, K_L0_SCAN, K_L0_COMB, K_L0_FIN, K_L1_PREP, K_L1_STATE, K_L1_SCAN, K_L1_FIN, K_MOE_ROUTE, K_MOE_ASSIGN, K_MOE_FINAL };
enum { F_KIND = 0, F_SYNC, F_MR, F_N, F_ROT, F_LDC, F_DYN, F_K, F_LDA, F_LDB, F_SCALE, F_PAD, F_A = 12, F_BT = 14, F_TILEE = 16, F_APN = 18, F_BTS = 20, F_BES = 22, F_O = 24, F_BASE = 26, F_OUTF = 28, F_LNG = 30, F_LNB = 32, STEP_DW = 40 };
enum StepId { S_PROLOGUE = 0, S_P0, S_KM0, S_VT0, S_KM1, S_VT1, S_L0_PREP, S_L0_SCAN, S_L0_COMB, S_L0_FIN, S_WOUT0, S_LN1_0, S_Q0, S_SM0, S_OX0, S_XO0, S_LN2_0, S_UP0, S_DOWN0, S_LN3_0,
              S_P1, S_L1_PREP, S_L1_STATE, S_L1_SCAN, S_L1_FIN, S_WOUT1, S_LN1_1, S_Q1, S_SM1, S_OX1, S_XO1, S_ROUTE, S_ASSIGN, S_UP_C0, S_DOWN_C0, S_UP_C1, S_DOWN_C1, S_FINAL, N_STEPS };
constexpr int STAB_OFF = PTAB_OFF + 576;
static_assert(STAB_OFF + N_STEPS * STEP_DW * 4 <= LDS_BYTES, "LDS control area");
struct StepW { LAS unsigned* d;
    __device__ __forceinline__ void i(int f, int v) const { d[f] = (unsigned)v; }
    __device__ __forceinline__ void f(int fi, float v) const { d[fi] = __float_as_uint(v); }
    __device__ __forceinline__ void p(int f, const void* v) const { const unsigned long long q = (unsigned long long)v; d[f] = (unsigned)q; d[f + 1] = (unsigned)(q >> 32); }
    __device__ __forceinline__ void u(int f, size_t q) const { d[f] = (unsigned)q; d[f + 1] = (unsigned)(q >> 32); } };
struct StepR { const LAS unsigned* d;
    __device__ __forceinline__ int i(int f) const { return (int)__builtin_amdgcn_readfirstlane(d[f]); }
    __device__ __forceinline__ float f(int fi) const { return __uint_as_float(__builtin_amdgcn_readfirstlane(d[fi])); }
    __device__ __forceinline__ unsigned long long u(int f) const { const unsigned lo = __builtin_amdgcn_readfirstlane(d[f]), hi = __builtin_amdgcn_readfirstlane(d[f + 1]); return ((unsigned long long)hi << 32) | lo; }
    template <class T> __device__ __forceinline__ T* p(int f) const { return (T*)u(f); } };
__device__ __forceinline__ void build_step(int s, LAS unsigned* d, const float* const* in, float* out, unsigned char* ws) {
    float* XFA = (float*)(ws + WS_XFA); float* XFB = out; bf16* XB = (bf16*)(ws + WS_XB); bf16* P = (bf16*)(ws + WS_P); bf16* OMIX = (bf16*)(ws + WS_OMIX);
    bf16* Q = (bf16*)(ws + WS_P); bf16* PATT = (bf16*)(ws + WS_P + 32 * MiB); bf16* OX = (bf16*)(ws + WS_P + 64 * MiB); bf16* H = (bf16*)(ws + WS_P);
    bf16* MEMB = (bf16*)(ws + WS_MEMB);
    const StepW t{d};
    for (int k = 0; k < STEP_DW; ++k) d[k] = 0u;
    t.i(F_KIND, K_GEMM_BF); t.i(F_SYNC, 1); t.i(F_MR, M); t.i(F_N, 1024); t.i(F_LDC, 1024); t.f(F_SCALE, 1.f);
    t.p(F_A, XB); t.u(F_BTS, (size_t)256 * 1024 * 2); t.i(F_LDA, 1024); t.i(F_LDB, 1024); t.i(F_K, 1024);
    const int L = (s >= S_P1) ? 1 : 0;
    switch (s) {
        case S_PROLOGUE: t.i(F_KIND, K_PROLOGUE); break;
        case S_P0: t.p(F_BT, ws + W_IN0); t.i(F_N, NP0); t.p(F_O, P); t.i(F_LDC, NP0); t.i(F_SYNC, 0); break;
        case S_KM0: t.p(F_A, MEMB); t.p(F_BT, ws + W_XK0); t.i(F_MR, 256); t.p(F_O, ws + WS_KMEM0); t.i(F_SYNC, 0); t.i(F_ROT, 128); break;
        case S_VT0: t.p(F_A, ws + W_XV0); t.p(F_BT, MEMB); t.i(F_MR, 1024); t.i(F_N, 256); t.p(F_O, ws + WS_VT0); t.i(F_LDC, 256); t.i(F_SYNC, 0); t.i(F_ROT, 132); break;
        case S_KM1: t.p(F_A, MEMB); t.p(F_BT, ws + W_XK1); t.i(F_MR, 256); t.p(F_O, ws + WS_KMEM1); t.i(F_SYNC, 0); t.i(F_ROT, 136); break;
        case S_VT1: t.p(F_A, ws + W_XV1); t.p(F_BT, MEMB); t.i(F_MR, 1024); t.i(F_N, 256); t.p(F_O, ws + WS_VT1); t.i(F_LDC, 256); t.i(F_ROT, 140); break;
        case S_L0_PREP: t.i(F_KIND, K_L0_PREP); break;
        case S_L0_SCAN: t.i(F_KIND, K_L0_SCAN); break;
        case S_L0_COMB: t.i(F_KIND, K_L0_COMB); break;
        case S_L0_FIN: t.i(F_KIND, K_L0_FIN); break;
        case S_WOUT0: t.i(F_KIND, K_GEMM_RES); t.p(F_A, OMIX); t.p(F_BT, ws + W_OUT0); t.p(F_BASE, in[0]); t.p(F_OUTF, XFA); break;
        case S_LN1_0: t.i(F_KIND, K_LN); t.p(F_OUTF, XFA); t.p(F_LNG, in[18]); t.p(F_LNB, in[19]); break;
        case S_Q0: case S_Q1: t.p(F_BT, ws + (L ? W_XQ1 : W_XQ0)); t.p(F_O, Q); t.f(F_SCALE, 0.0625f); break;
        case S_SM0: case S_SM1: t.i(F_KIND, K_GEMM_SOFTMAX); t.p(F_A, Q); t.u(F_APN, 512); t.p(F_BT, ws + (L ? WS_KMEM1 : WS_KMEM0)); t.u(F_BTS, 512); t.i(F_K, 256); t.p(F_O, PATT); break;
        case S_OX0: case S_OX1: t.p(F_A, PATT); t.u(F_APN, 512); t.p(F_BT, ws + (L ? WS_VT1 : WS_VT0)); t.i(F_LDB, 256); t.u(F_BTS, (size_t)256 * 256 * 2); t.i(F_K, 256); t.p(F_O, OX); break;
        case S_XO0: t.i(F_KIND, K_GEMM_RES); t.p(F_A, OX); t.p(F_BT, ws + W_XO0); t.p(F_BASE, XFA); t.p(F_OUTF, XFB); break;
        case S_LN2_0: t.i(F_KIND, K_LN); t.p(F_OUTF, XFB); t.p(F_LNG, in[24]); t.p(F_LNB, in[25]); break;
        case S_UP0: t.i(F_KIND, K_GEMM_SILU); t.p(F_BT, ws + W_GU0); t.i(F_N, 5632); t.p(F_O, H); t.i(F_LDC, 2816); break;
        case S_DOWN0: t.i(F_KIND, K_GEMM_RES); t.p(F_A, H); t.i(F_LDA, 2816); t.i(F_K, 2816); t.p(F_BT, ws + W_D0); t.i(F_LDB, 2816); t.u(F_BTS, (size_t)256 * 2816 * 2); t.p(F_BASE, XFB); t.p(F_OUTF, XFA); break;
        case S_LN3_0: t.i(F_KIND, K_LN); t.p(F_OUTF, XFA); t.p(F_LNG, in[29]); t.p(F_LNB, in[30]); break;
        case S_P1: t.p(F_BT, ws + W_IN1); t.i(F_N, NP1); t.p(F_O, P); t.i(F_LDC, NP1); break;
        case S_L1_PREP: t.i(F_KIND, K_L1_PREP); break;
        case S_L1_STATE: t.i(F_KIND, K_L1_STATE); break;
        case S_L1_SCAN: t.i(F_KIND, K_L1_SCAN); break;
        case S_L1_FIN: t.i(F_KIND, K_L1_FIN); break;
        case S_WOUT1: t.i(F_KIND, K_GEMM_RES); t.p(F_A, OMIX); t.i(F_LDA, 1536); t.i(F_K, 1536); t.p(F_BT, ws + W_OUT1); t.i(F_LDB, 1536); t.u(F_BTS, (size_t)256 * 1536 * 2); t.p(F_BASE, XFA); t.p(F_OUTF, XFB); break;
        case S_LN1_1: t.i(F_KIND, K_LN); t.p(F_OUTF, XFB); t.p(F_LNG, in[39]); t.p(F_LNB, in[40]); break;
        case S_XO1: t.i(F_KIND, K_GEMM_RES); t.p(F_A, OX); t.p(F_BT, ws + W_XO1); t.p(F_BASE, XFB); t.p(F_OUTF, XFA); break;
        case S_ROUTE: t.i(F_KIND, K_MOE_ROUTE); t.p(F_OUTF, XFA); t.p(F_LNG, in[45]); t.p(F_LNB, in[46]); break;
        case S_ASSIGN: t.i(F_KIND, K_MOE_ASSIGN); break;
        case S_UP_C0: case S_UP_C1: t.i(F_KIND, K_GEMM_SILU); t.i(F_DYN, s == S_UP_C0 ? 1 : 2); t.p(F_TILEE, ws + WS_RT + RT_TILEE); t.p(F_A, ws + WS_XG); t.p(F_BT, ws + W_EGU); t.u(F_BES, EGU_STEP); t.i(F_N, 5632); t.p(F_O, ws + WS_HM); t.i(F_LDC, 2816); break;
        case S_DOWN_C0: case S_DOWN_C1: t.i(F_KIND, K_GEMM_YR); t.i(F_DYN, s == S_DOWN_C0 ? 1 : 2); t.p(F_TILEE, ws + WS_RT + RT_TILEE); t.p(F_A, ws + WS_HM); t.i(F_LDA, 2816); t.i(F_K, 2816); t.p(F_BT, ws + W_ED); t.i(F_LDB, 2816);
            t.u(F_BTS, (size_t)256 * 2816 * 2); t.u(F_BES, ED_STEP); t.p(F_O, ws + WS_YR); break;
        default: t.i(F_KIND, K_MOE_FINAL); break;
    }
}
struct GemmSetup { pg8::Gemm g; int Mr, N, rot, row_off; };
__device__ __forceinline__ GemmSetup load_gemm(const StepR& r, const unsigned char* ws) {
    GemmSetup q; q.g.A = r.p<const bf16>(F_A); q.g.Bt = r.p<const bf16>(F_BT); q.g.tile_e = r.p<const int>(F_TILEE); q.g.a_pn_step = r.u(F_APN); q.g.b_tstep = r.u(F_BTS); q.g.b_estep = r.u(F_BES);
    q.g.lda = r.i(F_LDA); q.g.ldb = r.i(F_LDB); q.g.K = r.i(F_K); q.g.pad = 0; q.Mr = r.i(F_MR); q.N = r.i(F_N); q.rot = r.i(F_ROT); q.row_off = 0;
    const int dyn = r.i(F_DYN);
    if (dyn) {
        const int ntl = __builtin_amdgcn_readfirstlane(((const int*)(ws + WS_RT + RT_META))[16]) >> 8, T0 = (ntl + 1) >> 1, toff = (dyn == 2) ? T0 : 0, nt = (dyn == 2) ? ntl - T0 : T0;
        q.Mr = nt * 256; q.row_off = toff * 256; q.g.tile_e += toff;
        if (q.g.lda == 1024) q.g.A += (size_t)toff * 256 * 1024;
    }
    return q;
}

__global__ void __launch_bounds__(NWAVES * 64, 2) mega(MArgs args) {
    extern __shared__ __attribute__((aligned(16))) unsigned char lds_raw[];
    LAS unsigned char* lds = (LAS unsigned char*)lds_raw;
    volatile LAS unsigned* MISC = (volatile LAS unsigned*)(lds + MISC_OFF);
    const int tid = threadIdx.x, lane = tid & 63, wave = __builtin_amdgcn_readfirstlane(tid >> 6);
    const int G = gridDim.x; const int bx = blockIdx.x;
    const int vcu = (G % 8 == 0) ? (bx % 8) * (G / 8) + bx / 8 : bx;
    for (int u = tid; u < (LDS_BYTES - LDSCTL_OFF) / 4; u += NWAVES * 64) ((LAS unsigned*)(lds + LDSCTL_OFF))[u] = 0u;
    __syncthreads();
    unsigned* ctl = (unsigned*)(args.ws + WS_CTL);
    XcdBarrier bar = xcd_barrier_post(ctl + CW_BAR + args.li * XCD_BAR_WORDS, MISC + 8);
    const int gw = vcu * NWAVES + wave, NGW = G * NWAVES;
    if (tid < 54) { const unsigned long long p = (unsigned long long)args.in[tid]; LAS unsigned* pt = (LAS unsigned*)(lds + PTAB_OFF); pt[2 * tid] = (unsigned)p; pt[2 * tid + 1] = (unsigned)(p >> 32); }
    if (tid == 64)
#pragma unroll 1
        for (int k = 0; k < N_STEPS; ++k) build_step(k, (LAS unsigned*)(lds + STAB_OFF) + k * STEP_DW, args.in, args.out, args.ws);
    __syncthreads();
    const int ph_hi = args.ph_hi;

    for (int s = args.ph_lo; s < ph_hi; ++s) {
        Ctx cx; cx.in.t = (const LAS unsigned*)(lds + PTAB_OFF); cx.out = args.out; cx.ws = args.ws;
        asm volatile("" : "+s"(cx.ws), "+s"(cx.out));
        unsigned char* const ws = cx.ws;
        const StepR st{(const LAS unsigned*)(lds + STAB_OFF) + s * STEP_DW};
        const int kind = st.i(F_KIND);
        int tl = tid; asm volatile("" : "+v"(tl));
        const int ln = tl & 63;
        const int gt = (vcu * NWAVES + wave) * 64 + ln, GT = NGW * 64;
        switch (kind) {
            case K_PROLOGUE: {
                cvt_jobs(0, 14, cx, (LAS float*)(lds + wave * 16384), gw, NGW, ln);
                const float4* x4 = (const float4*)cx.in[0]; uint2* o2 = (uint2*)(ws + WS_XB);
                for (size_t i = (size_t)gw * 64 + ln; i < (size_t)M * D / 4; i += (size_t)NGW * 64) { const float4 v = x4[i]; uint2 w; w.x = pk2(v.x, v.y); w.y = pk2(v.z, v.w); o2[i] = w; }
                const float4* m4 = (const float4*)cx.in[1]; uint2* mo = (uint2*)(ws + WS_MEMB);
                for (size_t i = (size_t)gw * 64 + ln; i < (size_t)256 * D / 4; i += (size_t)NGW * 64) { const float4 v = m4[i]; uint2 w; w.x = pk2(v.x, v.y); w.y = pk2(v.z, v.w); mo[i] = w; }
            } break;
            case K_GEMM_BF: { const GemmSetup q = load_gemm(st, ws); pg8::StaticOrder S; S.init(q.Mr, q.N, G, (bx + G - q.rot) % G); pg8::EpBf E{st.p<bf16>(F_O), st.i(F_LDC), st.f(F_SCALE)};
                pg8::gemm_phase<pg8::EpBf, pg8::StaticOrder, true, true>(lds, q.g, S, E, tl); } break;
            case K_GEMM_RES: { const GemmSetup q = load_gemm(st, ws); pg8::StaticOrder S; S.init(q.Mr, q.N, G, bx); pg8::EpRes E{st.p<const float>(F_BASE), st.p<float>(F_OUTF)};
                pg8::gemm_phase<pg8::EpRes, pg8::StaticOrder, true, true>(lds, q.g, S, E, tl); } break;
            case K_GEMM_SILU: { const GemmSetup q = load_gemm(st, ws); pg8::StaticOrder S; S.init(q.Mr, q.N, G, bx); pg8::EpSilu E{st.p<bf16>(F_O), st.i(F_LDC), 0};
                pg8::gemm_phase<pg8::EpSilu, pg8::StaticOrder, true, true>(lds, q.g, S, E, tl); } break;
            case K_GEMM_SOFTMAX: { const GemmSetup q = load_gemm(st, ws); pg8::StaticOrder S; S.init(q.Mr, q.N, G, bx); pg8::EpSoftmax E{st.p<bf16>(F_O), st.i(F_LDC), 0};
                pg8::gemm_phase<pg8::EpSoftmax, pg8::StaticOrder, false, true>(lds, q.g, S, E, tl); } break;
            case K_GEMM_YR: { const GemmSetup q = load_gemm(st, ws); pg8::StaticOrder S; S.init(q.Mr, q.N, G, bx);
                pg8::EpYR E{st.p<bf16>(F_O), (const int*)(ws + WS_RT + RT_ROWTOK) + q.row_off, q.g.tile_e, (const int*)(ws + WS_RT + RT_META), q.row_off, 0};
                pg8::gemm_phase<pg8::EpYR, pg8::StaticOrder, true, true>(lds, q.g, S, E, tl); } break;
            case K_LN: {
                bf16* XB = (bf16*)(ws + WS_XB); float4 o[4];
                float* xf = st.p<float>(F_OUTF); const float* lg = st.p<const float>(F_LNG); const float* lb = st.p<const float>(F_LNB);
                for (int r = gw; r < M; r += NGW) ln_row(xf + (size_t)r * D, xf + (size_t)r * D, XB + (size_t)r * D, lg, lb, ln, o);
            } break;
            case K_L0_PREP: {
                const bf16* P = (const bf16*)(ws + WS_P);
                for (int it = bx; it < 1024; it += G) gla_state_item(it, tl, lds, P, cx.in[3], cx.in[4], (float*)cx.out, (float*)(ws + WS_CTL + 128 * 1024));
                float* VEC = (float*)(ws + WS_SCR); bf16* Gt = (bf16*)(ws + WS_XB + 16 * MiB); float* BON = (float*)(ws + WS_CTL + 512 * 1024);
                for (int grp = bx; grp < M / 16; grp += G) rwkv_prep_group(grp * 16, tl, (LAS float*)lds, P, cx.in[6], cx.in[7], cx.in[8], cx.in[9], cx.in[10], cx.in[11], cx.in[12], cx.in[13], cx.in[14], VEC, Gt, BON);
            } break;
            case K_L0_SCAN: {
                const bf16* P = (const bf16*)(ws + WS_P);
                if (wave < 4) rwkv_scan_seg(vcu * 4 + wave, ln, (LAS float*)(lds + wave * 12288), P, cx.in[6], (const float*)(ws + WS_SCR), (float*)(ws + WS_XFA), (float*)(ws + WS_XFA + 32 * MiB),
                                            (float*)cx.out + (size_t)8 * 1024 * 1024, (float*)cx.out + (size_t)12 * 1024 * 1024);
                else if (vcu < 128) gla_state_scan((vcu * 4 + (wave - 4)) * 64 + ln, (float*)cx.out, (const float*)(ws + WS_CTL + 128 * 1024));
            } break;
            case K_L0_COMB: {
                if (vcu < 64) rwkv_combine_row(vcu * 8 + wave, ln, (float*)cx.out + (size_t)8 * 1024 * 1024, (const float*)cx.out + (size_t)12 * 1024 * 1024);
                else for (int it = vcu - 64; it < 1024; it += G - 64) gla_out_item(it, tl, lds, (const bf16*)(ws + WS_P), cx.in[3], cx.in[4], (const float*)cx.out, cx.in[5], (bf16*)(ws + WS_OMIX));
            } break;
            case K_L0_FIN: {
                const bf16* P = (const bf16*)(ws + WS_P); bf16* OMIX = (bf16*)(ws + WS_OMIX);
                for (int it = gw; it < RW_J * 64; it += NGW) rwkv_fin_item(it, ln, P, cx.in[6], (const float*)(ws + WS_XFA), (const float*)(ws + WS_XFA + 32 * MiB), (const float*)cx.out + (size_t)8 * 1024 * 1024,
                                                                              (const bf16*)(ws + WS_XB + 16 * MiB), (const float*)(ws + WS_CTL + 512 * 1024), cx.in[15], cx.in[16], OMIX);
            } break;
            case K_L1_PREP: {
                const bf16* P = (const bf16*)(ws + WS_P);
                bf16* XBC = (bf16*)(ws + WS_SCR); float* DT = (float*)(ws + WS_SCR + 48 * MiB); float* AA = (float*)(ws + WS_SCR + 49 * MiB); float* KM = (float*)(ws + WS_SCR + 50 * MiB);
                for (int idx = gt; idx < M * 192; idx += GT) ssd_prep_oct(idx, P, cx.in[32], cx.in[33], XBC);
                for (int idx = gt; idx < M * 16; idx += GT) ssd_dt_item2(idx, P, cx.in[34], cx.in[35], DT, AA);
                for (int idx = gt; idx < 8 * 64 * 64; idx += GT) moba_kmean_item(idx, P, KM);
            } break;
            case K_L1_STATE: {
                if (bx < 256) ssd_state_item(bx, tl, lds, (const bf16*)(ws + WS_SCR), (const float*)(ws + WS_SCR + 48 * MiB), (const float*)(ws + WS_SCR + 49 * MiB), (float*)cx.out, (float*)(ws + WS_SCR + 51 * MiB));
            } break;
            case K_L1_SCAN: {
                const bf16* P = (const bf16*)(ws + WS_P);
                ssd_state_scan(gt, (float*)cx.out, (const float*)(ws + WS_SCR + 51 * MiB));
                for (int idx = gt; idx < M * 8; idx += GT) moba_item(idx, P, (const float*)(ws + WS_SCR + 50 * MiB), (bf16*)(ws + WS_OMIX));
            } break;
            case K_L1_FIN: {
                if (bx < 256) ssd_out_item(bx, tl, lds, (const bf16*)(ws + WS_P), (const bf16*)(ws + WS_SCR), (const float*)(ws + WS_SCR + 48 * MiB), (const float*)(ws + WS_SCR + 49 * MiB), (const float*)cx.out,
                                           cx.in[36], cx.in[37], (bf16*)(ws + WS_OMIX));
            } break;
            case K_MOE_ROUTE: {
                volatile LAS int* cnt = (volatile LAS int*)(MISC + 16);
                if (tl < 8) cnt[tl] = 0;
                __syncthreads();
                bf16* XB = (bf16*)(ws + WS_XB); int* TOPE = (int*)(ws + WS_RT + RT_TOPE); float* GATE = (float*)(ws + WS_RT + RT_GATE);
                const float* wr = cx.in[47]; const float* br = cx.in[48]; float* xf = st.p<float>(F_OUTF); const float* lg = st.p<const float>(F_LNG); const float* lb = st.p<const float>(F_LNB);
                for (int k = 0; k < 8; ++k) {
                    const int r = vcu * 64 + wave * 8 + k; float4 o[4];
                    ln_row(xf + (size_t)r * D, xf + (size_t)r * D, XB + (size_t)r * D, lg, lb, ln, o);
                    float acc[8];
#pragma unroll
                    for (int e = 0; e < 8; ++e) acc[e] = 0.f;
#pragma unroll
                    for (int j = 0; j < 4; ++j) { const int col = 4 * (ln + 64 * j); const float xs[4] = {o[j].x, o[j].y, o[j].z, o[j].w};
#pragma unroll
                        for (int u = 0; u < 4; ++u) { const float4 w0 = *(const float4*)(wr + (size_t)(col + u) * 8), w1 = *(const float4*)(wr + (size_t)(col + u) * 8 + 4);
                            acc[0] += xs[u] * w0.x; acc[1] += xs[u] * w0.y; acc[2] += xs[u] * w0.z; acc[3] += xs[u] * w0.w; acc[4] += xs[u] * w1.x; acc[5] += xs[u] * w1.y; acc[6] += xs[u] * w1.z; acc[7] += xs[u] * w1.w; } }
#pragma unroll
                    for (int e = 0; e < 8; ++e) acc[e] = wave_sum(acc[e]) + br[e];
                    int e0 = 0; float l0 = acc[0];
#pragma unroll
                    for (int e = 1; e < 8; ++e) if (acc[e] > l0) { l0 = acc[e]; e0 = e; }
                    int e1 = -1; float l1 = -INFINITY;
#pragma unroll
                    for (int e = 0; e < 8; ++e) if (e != e0 && acc[e] > l1) { l1 = acc[e]; e1 = e; }
                    const float ex = expf(l1 - l0), g0 = 1.f / (1.f + ex);
                    if (ln == 0) { TOPE[2 * r] = e0; TOPE[2 * r + 1] = e1; GATE[2 * r] = g0; GATE[2 * r + 1] = ex * g0;
                        __hip_atomic_fetch_add((int*)(cnt + e0), 1, __ATOMIC_RELAXED, __HIP_MEMORY_SCOPE_WORKGROUP); __hip_atomic_fetch_add((int*)(cnt + e1), 1, __ATOMIC_RELAXED, __HIP_MEMORY_SCOPE_WORKGROUP); }
                }
                __syncthreads();
                if (tl < 8) ((int*)(ws + WS_RT + RT_BC))[vcu * 8 + tl] = cnt[tl];
                cvt_jobs(14, 30, cx, (LAS float*)(lds + wave * 16384), gw, NGW, ln);
            } break;
            case K_MOE_ASSIGN: {
                LAS int* sm = (LAS int*)lds;
                const int* BC = (const int*)(ws + WS_RT + RT_BC); const int* TOPE = (const int*)(ws + WS_RT + RT_TOPE);
                int* ROW_TOK = (int*)(ws + WS_RT + RT_ROWTOK); int* SLOT_ROW = (int*)(ws + WS_RT + RT_SLOTROW); int* TILE_E = (int*)(ws + WS_RT + RT_TILEE); int* META = (int*)(ws + WS_RT + RT_META);
                const bf16* XB = (const bf16*)(ws + WS_XB); bf16* XG = (bf16*)(ws + WS_XG);
                {   const int e = wave; int tot = 0, off = 0;
                    for (int b = ln; b < 256; b += 64) { const int c = BC[b * 8 + e]; tot += c; if (b < vcu) off += c; }
                    tot = wave_sum_i(tot); off = wave_sum_i(off);
                    if (ln == 0) { sm[e] = tot; sm[8 + e] = off; } }
                __syncthreads();
                if (tl == 0) { int p = 0, us = 0; for (int e = 0; e < 8; ++e) { sm[16 + e] = p; sm[32 + e] = us; p += (sm[e] + 255) / 256 * 256; us += sm[e]; } sm[24] = p; }
                __syncthreads();
                if (tl < 128) sm[64 + tl] = TOPE[vcu * 128 + tl];
                __syncthreads();
                if (tl < 128) { const int e = sm[64 + tl]; int rank = 0; for (int i = 0; i < tl; ++i) rank += (sm[64 + i] == e) ? 1 : 0;
                    const int pos = sm[16 + e] + sm[8 + e] + rank; SLOT_ROW[vcu * 128 + tl] = pos; ROW_TOK[pos] = vcu * 64 + (tl >> 1); sm[192 + tl] = pos; }
                __syncthreads();
                for (int i = wave; i < 128; i += 8) { const int pos = sm[192 + i], tok = vcu * 64 + (i >> 1);
                    const uint4* src = (const uint4*)(XB + (size_t)tok * D); uint4* dst = (uint4*)(XG + (size_t)pos * D); dst[ln] = src[ln]; dst[ln + 64] = src[ln + 64]; }
                for (int k = gw; k < 2048; k += NGW) { const int e = k >> 8, j = k & 255, row = sm[16 + e] + sm[e] + j;
                    if (row < sm[17 + e]) { if (ln == 0) ROW_TOK[row] = -1; uint4* dst = (uint4*)(XG + (size_t)row * D); const uint4 zz = {0u, 0u, 0u, 0u}; dst[ln] = zz; dst[ln + 64] = zz; } }
                if (bx == 0) {
                    if (tl < 8) { META[tl] = sm[16 + tl]; META[8 + tl] = sm[16 + tl] - sm[32 + tl]; }
                    if (tl == 8) META[16] = sm[24];
                    if (tl < RMAX / 256) { const int r = tl * 256; int e = 0; for (int x = 1; x < 8; ++x) if (r >= sm[16 + x]) e = x; TILE_E[tl] = e; }
                }
                __syncthreads();
            } break;
            default: {
                const float* XF = (const float*)(ws + WS_XFA); const bf16* YR = (const bf16*)(ws + WS_YR);
                const int* TOPE = (const int*)(ws + WS_RT + RT_TOPE); const float* GATE = (const float*)(ws + WS_RT + RT_GATE); const int* SLOT_ROW = (const int*)(ws + WS_RT + RT_SLOTROW); const int* META = (const int*)(ws + WS_RT + RT_META);
                const float* g = cx.in[52]; const float* b = cx.in[53];
                for (int t = gw; t < M; t += NGW) {
                    const int e0 = TOPE[2 * t], e1 = TOPE[2 * t + 1]; const float g0 = GATE[2 * t], g1 = GATE[2 * t + 1];
                    const bf16* y0 = YR + (size_t)(SLOT_ROW[2 * t] - META[8 + e0]) * D; const bf16* y1 = YR + (size_t)(SLOT_ROW[2 * t + 1] - META[8 + e1]) * D;
                    float4 v[4]; float sum = 0.f;
#pragma unroll
                    for (int j = 0; j < 4; ++j) { const int col = 4 * (ln + 64 * j); const float4 x = *(const float4*)(XF + (size_t)t * D + col);
                        const uint2 a0 = *(const uint2*)(y0 + col), a1 = *(const uint2*)(y1 + col);
                        v[j].x = ALPHA * x.x + g0 * __uint_as_float(a0.x << 16) + g1 * __uint_as_float(a1.x << 16);
                        v[j].y = ALPHA * x.y + g0 * __uint_as_float(a0.x & 0xffff0000u) + g1 * __uint_as_float(a1.x & 0xffff0000u);
                        v[j].z = ALPHA * x.z + g0 * __uint_as_float(a0.y << 16) + g1 * __uint_as_float(a1.y << 16);
                        v[j].w = ALPHA * x.w + g0 * __uint_as_float(a0.y & 0xffff0000u) + g1 * __uint_as_float(a1.y & 0xffff0000u);
                        sum += (v[j].x + v[j].y) + (v[j].z + v[j].w); }
                    const float mean = wave_sum(sum) * (1.f / D); float q = 0.f;
#pragma unroll
                    for (int j = 0; j < 4; ++j) { v[j].x -= mean; v[j].y -= mean; v[j].z -= mean; v[j].w -= mean; q += (v[j].x * v[j].x + v[j].y * v[j].y) + (v[j].z * v[j].z + v[j].w * v[j].w); }
                    const float rstd = 1.f / sqrtf(wave_sum(q) * (1.f / D) + 1e-5f);
#pragma unroll
                    for (int j = 0; j < 4; ++j) { const int col = 4 * (ln + 64 * j); const float4 gg = *(const float4*)(g + col), bb = *(const float4*)(b + col);
                        float4 o; o.x = v[j].x * rstd * gg.x + bb.x; o.y = v[j].y * rstd * gg.y + bb.y; o.z = v[j].z * rstd * gg.z + bb.z; o.w = v[j].w * rstd * gg.w + bb.w;
                        *(float4*)(cx.out + (size_t)t * D + col) = o; }
                }
            } break;
        }
        if (st.i(F_SYNC) && s + 1 < ph_hi) xcd_barrier(bar);
    }
}
}

extern "C" void kernel_launch(void* const* d_in, const int* in_sizes, int n_in, void* d_out, int out_size, void* d_ws, size_t ws_size, hipStream_t stream) {
    if (n_in != 54 || ws_size < WS_END) { fprintf(stderr, "kernel_launch: unexpected n_in %d / ws_size %zu (need %zu)\n", n_in, ws_size, (size_t)WS_END); return; }
    static int grid = 0;
    if (grid == 0) {
        int dev = 0, cus = 0;
        if (hipGetDevice(&dev) != hipSuccess || hipDeviceGetAttribute(&cus, hipDeviceAttributeMultiprocessorCount, dev) != hipSuccess) { fprintf(stderr, "kernel_launch: device query failed\n"); grid = -1; return; }
        if (hipFuncSetAttribute((const void*)mega, hipFuncAttributeMaxDynamicSharedMemorySize, LDS_BYTES) != hipSuccess) { fprintf(stderr, "kernel_launch: hipFuncSetAttribute failed\n"); grid = -1; return; }
        (void)hipGetLastError();
        grid = cus;
        if (grid != 256) fprintf(stderr, "kernel_launch: %d CUs (expected 256)\n", grid);
    }
    if (grid < 0) return;
    (void)hipMemsetAsync((unsigned char*)d_ws + WS_CTL, 0, 64 * 1024, stream);
    MArgs a{};
    for (int i = 0; i < 54; ++i) a.in[i] = (const float*)d_in[i];
    a.out = (float*)d_out; a.ws = (unsigned char*)d_ws;
    a.ph_lo = 0; a.ph_hi = N_STEPS; a.li = 0;
    hipLaunchKernelGGL(mega, dim3(grid), dim3(NWAVES * 64), LDS_BYTES, stream, a);
}
```

```cpp
#include <hip/hip_runtime.h>
#include <cstdio>
#include <cstdint>
#include <cstddef>

typedef unsigned short bf16;
#define LAS __attribute__((address_space(3)))

namespace {
constexpr int M = 16384, D = 1024;
constexpr int NP0 = 3584, NP1 = 4352;
constexpr float ALPHA = 1.4142135623730951f;
constexpr int RMAX = 34816;
constexpr size_t MiB = 1ull << 20;
constexpr size_t WS_CTL = 0, WS_XFA = 1 * MiB, WS_XB = 65 * MiB, WS_P = 97 * MiB, WS_OMIX = 233 * MiB, WS_SCR = 281 * MiB, WS_END = 433 * MiB;

__device__ __forceinline__ float bf2f(bf16 v) { return __uint_as_float(((unsigned)v) << 16); }
__device__ __forceinline__ bf16 f2bf(float f) { unsigned u = __float_as_uint(f); u += 0x7fffu + ((u >> 16) & 1u); return (bf16)(u >> 16); }
__device__ __forceinline__ float sigm(float x) { return 1.f / (1.f + __expf(-x)); }
__device__ __forceinline__ float tanh_fast(float x) { return 1.f - 2.f / (__expf(2.f * x) + 1.f); }
__device__ __forceinline__ float siluf(float x) { return x * sigm(x); }
__device__ __forceinline__ float wave_sum(float v) {
#pragma unroll
    for (int o = 1; o < 64; o <<= 1) v += __shfl_xor(v, o);
    return v;
}
__device__ __forceinline__ float wave_max(float v) {
#pragma unroll
    for (int o = 1; o < 64; o <<= 1) v = fmaxf(v, __shfl_xor(v, o));
    return v;
}

__device__ __forceinline__ void moba_kmean_item(int idx, const bf16* P, float* KM) {
    const int d = idx & 63, j = (idx >> 6) & 63, h = idx >> 12;
    float s = 0.f;
    for (int i = 0; i < 256; ++i) s += bf2f(P[(size_t)(j * 256 + i) * NP1 + 3072 + h * 64 + d]);
    KM[idx] = s * (1.f / 256.f);
}

constexpr int RW_J = 128, RW_SEG = 128;
typedef short bf16x8_t __attribute__((ext_vector_type(8)));
typedef float f32x4_t __attribute__((ext_vector_type(4)));
typedef unsigned u32x4_t __attribute__((ext_vector_type(4)));
typedef unsigned u32x2_t __attribute__((ext_vector_type(2)));
__device__ __forceinline__ void rwkv_prep_group(int t0, int tl, LAS float* ps, const bf16* P, const float* mu, const float* w0, const float* w2, const float* a0, const float* a2, const float* g2,
                                                const float* kkw, const float* kaw, const float* rkw, float* VEC, bf16* G, float* BON) {
#pragma unroll 1
    for (int t = 0; t < 16; ++t) {
        const int tt = t0 + t;
        for (int c = tl; c < 1792; c += 512) {
            const float p = bf2f(P[(size_t)tt * NP0 + 1792 + c]);
            const float pp = tt > 0 ? bf2f(P[(size_t)(tt - 1) * NP0 + 1792 + c]) : 0.f;
            float v = p + mu[c] * (pp - p);
            if (c >= 1536 && c < 1600) v = tanh_fast(v); else if (c >= 1664) v = sigm(v);
            ps[t * 1792 + c] = v;
        }
    }
    __syncthreads();
    const int c = tl;
    float aw[16], aa[16], ag[16];
    { const float w0c = w0[c], a0c = a0[c];
#pragma unroll
      for (int t = 0; t < 16; ++t) { aw[t] = w0c; aa[t] = a0c; ag[t] = 0.f; } }
#pragma unroll 1
    for (int i = 0; i < 64; i += 4) {
        const float u0 = w2[(i + 0) * 512 + c], u1 = w2[(i + 1) * 512 + c], u2 = w2[(i + 2) * 512 + c], u3 = w2[(i + 3) * 512 + c];
        const float v0 = a2[(i + 0) * 512 + c], v1 = a2[(i + 1) * 512 + c], v2 = a2[(i + 2) * 512 + c], v3 = a2[(i + 3) * 512 + c];
#pragma unroll
        for (int t = 0; t < 16; ++t) {
            const f32x4_t x = *(const LAS f32x4_t*)(ps + t * 1792 + 1536 + i), y = *(const LAS f32x4_t*)(ps + t * 1792 + 1600 + i);
            aw[t] += x[0] * u0 + x[1] * u1 + x[2] * u2 + x[3] * u3; aa[t] += y[0] * v0 + y[1] * v1 + y[2] * v2 + y[3] * v3;
        }
    }
#pragma unroll 1
    for (int i = 0; i < 128; i += 4) {
        const float u0 = g2[(i + 0) * 512 + c], u1 = g2[(i + 1) * 512 + c], u2 = g2[(i + 2) * 512 + c], u3 = g2[(i + 3) * 512 + c];
#pragma unroll
        for (int t = 0; t < 16; ++t) { const f32x4_t x = *(const LAS f32x4_t*)(ps + t * 1792 + 1664 + i); ag[t] += x[0] * u0 + x[1] * u1 + x[2] * u2 + x[3] * u3; }
    }
    const float kkc = kkw[c], kac = kaw[c], rkc = rkw[c];
    const int h = c >> 6, l = c & 63;
#pragma unroll
    for (int t = 0; t < 16; ++t) {
        const int tt = t0 + t;
        const float a = sigm(aa[t]);
        const float w = __expf(-0.6065306597126334f * sigm(aw[t]));
        const float r = ps[t * 1792 + c], k = ps[t * 1792 + 512 + c];
        const float kr = k * kkc;
        const float ss = wave_sum(kr * kr);
        const float kk = kr * (1.f / sqrtf(fmaxf(ss, 1e-24f)));
        const float k2 = k * (1.f + (a - 1.f) * kac);
        const float bon = wave_sum(r * k2 * rkc);
        float* ve = VEC + ((size_t)tt * 8 + h) * 256;
        ve[l] = k2; ve[64 + l] = w; ve[128 + l] = kk; ve[192 + l] = kk * a;
        G[(size_t)tt * 512 + c] = f2bf(ag[t]);
        if (l == 0) BON[tt * 8 + h] = bon;
    }
    __syncthreads();
}
__device__ __forceinline__ void rwkv_scan_seg(int item, int ln, LAS float* stg, const bf16* P, const float* mu, const float* VEC, float* ORAW, float* CB, float* SLOC, float* MEND) {
    const int h = item & 7, j = item >> 3, t0 = j * RW_SEG;
    float S[64], Mx[64];
#pragma unroll
    for (int k = 0; k < 64; ++k) { S[k] = 0.f; Mx[k] = (k == ln) ? 1.f : 0.f; }
    const float mur = mu[h * 64 + ln], muv = mu[1024 + h * 64 + ln];
    const bf16* Pr = P + 1792 + h * 64 + ln;
    float rp = t0 > 0 ? bf2f(Pr[(size_t)(t0 - 1) * NP0]) : 0.f, vp = t0 > 0 ? bf2f(Pr[(size_t)(t0 - 1) * NP0 + 1024]) : 0.f;
#pragma unroll 1
    for (int g = 0; g < RW_SEG / 8; ++g) {
        f32x4_t vv[8]; float rr[8], vl[8];
#pragma unroll
        for (int u = 0; u < 8; ++u) { const int t = t0 + g * 8 + u;
            vv[u] = *(const f32x4_t*)(VEC + ((size_t)t * 8 + h) * 256 + 4 * ln);
            const float pr = bf2f(Pr[(size_t)t * NP0]), pv = bf2f(Pr[(size_t)t * NP0 + 1024]);
            rr[u] = pr + mur * (rp - pr); rp = pr; vl[u] = pv + muv * (vp - pv); vp = pv; }
#pragma unroll
        for (int u = 0; u < 8; ++u) { *(LAS f32x4_t*)(stg + u * 384 + 4 * ln) = vv[u]; stg[u * 384 + 256 + ln] = rr[u]; stg[u * 384 + 320 + ln] = vl[u]; }
        asm volatile("s_waitcnt lgkmcnt(0)" ::: "memory");
#pragma unroll 1
        for (int u = 0; u < 8; ++u) {
            const LAS f32x4_t* s4 = (const LAS f32x4_t*)(stg + u * 384);
            const float vcur = stg[u * 384 + 320 + ln];
            float sa0 = 0.f, sa1 = 0.f, ma0 = 0.f, ma1 = 0.f;
#pragma unroll
            for (int q = 0; q < 16; ++q) { const f32x4_t kk4 = s4[32 + q];
                sa0 += S[4 * q] * kk4[0]; sa1 += S[4 * q + 1] * kk4[1]; sa0 += S[4 * q + 2] * kk4[2]; sa1 += S[4 * q + 3] * kk4[3];
                ma0 += Mx[4 * q] * kk4[0]; ma1 += Mx[4 * q + 1] * kk4[1]; ma0 += Mx[4 * q + 2] * kk4[2]; ma1 += Mx[4 * q + 3] * kk4[3]; }
            const float nS = -(sa0 + sa1), nM = -(ma0 + ma1);
            float o0 = 0.f, o1 = 0.f, c0 = 0.f, c1 = 0.f;
#pragma unroll
            for (int q = 0; q < 16; ++q) { const f32x4_t k24 = s4[q], w4 = s4[16 + q], b4 = s4[48 + q], r4 = s4[64 + q];
#pragma unroll
                for (int e = 0; e < 4; ++e) { const int k = 4 * q + e;
                    S[k] = fmaf(S[k], w4[e], fmaf(nS, b4[e], vcur * k24[e])); Mx[k] = fmaf(Mx[k], w4[e], nM * b4[e]);
                    if (e & 1) { o1 += S[k] * r4[e]; c1 += Mx[k] * r4[e]; } else { o0 += S[k] * r4[e]; c0 += Mx[k] * r4[e]; } } }
            const size_t oi = (size_t)(t0 + g * 8 + u) * 512 + h * 64 + ln;
            ORAW[oi] = o0 + o1; CB[oi] = c0 + c1;
        }
    }
    float* sl = SLOC + ((size_t)(j * 8 + h) * 64 + ln) * 64; float* me = MEND + ((size_t)(j * 8 + h) * 64 + ln) * 64;
#pragma unroll
    for (int q = 0; q < 16; ++q) { *(f32x4_t*)(sl + 4 * q) = (f32x4_t){S[4 * q], S[4 * q + 1], S[4 * q + 2], S[4 * q + 3]}; *(f32x4_t*)(me + 4 * q) = (f32x4_t){Mx[4 * q], Mx[4 * q + 1], Mx[4 * q + 2], Mx[4 * q + 3]}; }
}
__device__ __forceinline__ void rwkv_combine_row(int row, int ln, float* SLOC, const float* MEND) {
    const int h = row >> 6, v = row & 63;
    float s = 0.f;
    float m[64];
#pragma unroll
    for (int i = 0; i < 64; ++i) m[i] = MEND[((size_t)(0 * 8 + h) * 64 + i) * 64 + ln];
#pragma unroll 1
    for (int j = 0; j < RW_J; ++j) {
        float* slot = SLOC + ((size_t)(j * 8 + h) * 64 + v) * 64 + ln;
        const float l = *slot;
        float mn[64];
        const int jn = (j + 1 < RW_J) ? j + 1 : j;
#pragma unroll
        for (int i = 0; i < 64; ++i) mn[i] = MEND[((size_t)(jn * 8 + h) * 64 + i) * 64 + ln];
        *slot = s;
        float a0 = l, a1 = 0.f;
#pragma unroll
        for (int i = 0; i < 64; i += 2) { a0 += __uint_as_float(__builtin_amdgcn_readlane(__float_as_uint(s), i)) * m[i]; a1 += __uint_as_float(__builtin_amdgcn_readlane(__float_as_uint(s), i + 1)) * m[i + 1]; }
        s = a0 + a1;
#pragma unroll
        for (int i = 0; i < 64; ++i) m[i] = mn[i];
    }
}
__device__ __forceinline__ void rwkv_fin_item(int item, int ln, const bf16* P, const float* mu, const float* ORAW, const float* CB, const float* SINIT, const bf16* G, const float* BON,
                                              const float* lnw, const float* lnb, bf16* OMIX) {
    const int tg = item & 7, h = (item >> 3) & 7, j = item >> 6;
    const int tb = j * RW_SEG + tg * 16, lr = ln & 15, lq = ln >> 4;
    bf16x8_t af[2], bfr[4][2];
#pragma unroll
    for (int kb = 0; kb < 2; ++kb) {
        const float* cp = CB + (size_t)(tb + lr) * 512 + h * 64 + kb * 32 + 8 * lq;
        const f32x4_t x0 = *(const f32x4_t*)cp, x1 = *(const f32x4_t*)(cp + 4);
        af[kb] = (bf16x8_t){(short)f2bf(x0[0]), (short)f2bf(x0[1]), (short)f2bf(x0[2]), (short)f2bf(x0[3]), (short)f2bf(x1[0]), (short)f2bf(x1[1]), (short)f2bf(x1[2]), (short)f2bf(x1[3])};
#pragma unroll
        for (int nt = 0; nt < 4; ++nt) {
            const float* sp = SINIT + ((size_t)(j * 8 + h) * 64 + nt * 16 + lr) * 64 + kb * 32 + 8 * lq;
            const f32x4_t y0 = *(const f32x4_t*)sp, y1 = *(const f32x4_t*)(sp + 4);
            bfr[nt][kb] = (bf16x8_t){(short)f2bf(y0[0]), (short)f2bf(y0[1]), (short)f2bf(y0[2]), (short)f2bf(y0[3]), (short)f2bf(y1[0]), (short)f2bf(y1[1]), (short)f2bf(y1[2]), (short)f2bf(y1[3])};
        }
    }
    f32x4_t acc[4];
#pragma unroll
    for (int nt = 0; nt < 4; ++nt) { acc[nt] = (f32x4_t){0.f, 0.f, 0.f, 0.f};
#pragma unroll
        for (int kb = 0; kb < 2; ++kb) acc[nt] = __builtin_amdgcn_mfma_f32_16x16x32_bf16(af[kb], bfr[nt][kb], acc[nt], 0, 0, 0); }
#pragma unroll
    for (int r = 0; r < 4; ++r) {
        const int t = tb + 4 * lq + r;
        float o[4]; float sum = 0.f;
#pragma unroll
        for (int nt = 0; nt < 4; ++nt) { o[nt] = acc[nt][r] + ORAW[(size_t)t * 512 + h * 64 + nt * 16 + lr]; sum += o[nt]; }
        sum += __shfl_xor(sum, 1); sum += __shfl_xor(sum, 2); sum += __shfl_xor(sum, 4); sum += __shfl_xor(sum, 8);
        const float mean = sum * (1.f / 64.f); float q = 0.f;
#pragma unroll
        for (int nt = 0; nt < 4; ++nt) { o[nt] -= mean; q += o[nt] * o[nt]; }
        q += __shfl_xor(q, 1); q += __shfl_xor(q, 2); q += __shfl_xor(q, 4); q += __shfl_xor(q, 8);
        const float rstd = 1.f / sqrtf(q * (1.f / 64.f) + 64e-5f);
        const float bon = BON[t * 8 + h];
#pragma unroll
        for (int nt = 0; nt < 4; ++nt) { const int c = h * 64 + nt * 16 + lr;
            const float p = bf2f(P[(size_t)t * NP0 + 1792 + 1024 + c]);
            const float pp = t > 0 ? bf2f(P[(size_t)(t - 1) * NP0 + 1792 + 1024 + c]) : 0.f;
            const float vv = p + mu[1024 + c] * (pp - p);
            OMIX[(size_t)t * 1024 + 512 + c] = f2bf((o[nt] * rstd * lnw[c] + lnb[c] + bon * vv) * bf2f(G[(size_t)t * 512 + c])); }
    }
}

constexpr int GL_LD = 72;
constexpr int GL_BC = 0, GL_WA = 16384, GL_QD = 20480, GL_KD = 29696, GL_KT = 38912, GL_VT = 48128, GL_PM = 66560, GL_SP = 75776, GL_RED = 94208;
__device__ __forceinline__ void unpack8(const uint4 u, float (&f)[8]) {
    f[0] = __uint_as_float(u.x << 16); f[1] = __uint_as_float(u.x & 0xffff0000u); f[2] = __uint_as_float(u.y << 16); f[3] = __uint_as_float(u.y & 0xffff0000u);
    f[4] = __uint_as_float(u.z << 16); f[5] = __uint_as_float(u.z & 0xffff0000u); f[6] = __uint_as_float(u.w << 16); f[7] = __uint_as_float(u.w & 0xffff0000u);
}
__device__ __forceinline__ void gla_decay_cumsum(int n, int h, int tl, LAS unsigned char* lds, const bf16* P, const float* wa2, const float* ba) {
    LAS float* bc = (LAS float*)(lds + GL_BC); LAS float* wa = (LAS float*)(lds + GL_WA);
    for (int i = tl; i < 1024; i += 512) wa[i] = wa2[(i >> 6) * 256 + h * 64 + (i & 63)];
    __syncthreads();
    const int t = tl >> 3, oq = tl & 7; const size_t row = (size_t)n * 64 + t;
    float a[16];
    { const uint4* ap = (const uint4*)(P + row * NP0 + 1536); float f[8]; unpack8(ap[0], f);
#pragma unroll
      for (int e = 0; e < 8; ++e) a[e] = f[e];
      unpack8(ap[1], f);
#pragma unroll
      for (int e = 0; e < 8; ++e) a[8 + e] = f[e]; }
#pragma unroll
    for (int e = 0; e < 8; ++e) { const int d = oq * 8 + e; float s = ba[h * 64 + d];
#pragma unroll
        for (int r = 0; r < 16; ++r) s += a[r] * wa[r * 64 + d];
        bc[t * 64 + d] = (fminf(s, 0.f) - __logf(1.f + __expf(-fabsf(s)))) * (1.f / 16.f); }
    __syncthreads();
    if (tl < 64) { float acc = 0.f;
#pragma unroll 8
        for (int tt = 0; tt < 64; ++tt) { acc += bc[tt * 64 + tl]; bc[tt * 64 + tl] = acc; } }
    __syncthreads();
}
__device__ __forceinline__ void gla_stage_vt(int n, int h, int tl, LAS unsigned char* lds, const bf16* P) {
    LAS bf16* vt = (LAS bf16*)(lds + GL_VT);
    const int t = tl >> 3, oq = tl & 7; const size_t row = (size_t)n * 64 + t;
#pragma unroll
    for (int half = 0; half < 2; ++half) { const int oct = oq + 8 * half; const uint4 u = *(const uint4*)(P + row * NP0 + 512 + h * 128 + oct * 8);
        const unsigned w[4] = {u.x, u.y, u.z, u.w};
#pragma unroll
        for (int e = 0; e < 8; ++e) vt[(oct * 8 + e) * GL_LD + t] = (bf16)((e & 1) ? (w[e >> 1] >> 16) : (w[e >> 1] & 0xffffu)); }
}
__device__ __forceinline__ bf16x8_t lds_frag(const LAS bf16* base, int row, int k0) { return *(const LAS bf16x8_t*)(base + row * GL_LD + k0); }
__device__ __forceinline__ void gla_state_item(int item, int tl, LAS unsigned char* lds, const bf16* P, const float* wa2, const float* ba, float* KVS, float* DEC) {
    const int n = item >> 2, h = item & 3, wv = tl >> 6, ln = tl & 63, lr = ln & 15, lq = ln >> 4;
    gla_decay_cumsum(n, h, tl, lds, P, wa2, ba);
    LAS float* bc = (LAS float*)(lds + GL_BC); LAS bf16* kt = (LAS bf16*)(lds + GL_KT); LAS bf16* vt = (LAS bf16*)(lds + GL_VT);
    { const int t = tl >> 3, oq = tl & 7; const size_t row = (size_t)n * 64 + t; float k[8]; unpack8(*(const uint4*)(P + row * NP0 + 256 + h * 64 + oq * 8), k);
#pragma unroll
      for (int e = 0; e < 8; ++e) { const int d = oq * 8 + e; kt[d * GL_LD + t] = f2bf(k[e] * __expf(bc[63 * 64 + d] - bc[t * 64 + d])); } }
    gla_stage_vt(n, h, tl, lds, P);
    __syncthreads();
    f32x4_t acc[4];
#pragma unroll
    for (int nt = 0; nt < 4; ++nt) acc[nt] = (f32x4_t){0.f, 0.f, 0.f, 0.f};
#pragma unroll
    for (int kb = 0; kb < 2; ++kb) { const bf16x8_t a = lds_frag(vt, 16 * wv + lr, kb * 32 + 8 * lq);
#pragma unroll
        for (int nt = 0; nt < 4; ++nt) acc[nt] = __builtin_amdgcn_mfma_f32_16x16x32_bf16(a, lds_frag(kt, 16 * nt + lr, kb * 32 + 8 * lq), acc[nt], 0, 0, 0); }
    float* kv = KVS + (size_t)(n * 4 + h) * 128 * 64;
#pragma unroll
    for (int nt = 0; nt < 4; ++nt)
#pragma unroll
        for (int r = 0; r < 4; ++r) kv[(16 * wv + 4 * lq + r) * 64 + 16 * nt + lr] = acc[nt][r];
    if (tl < 64) DEC[(n * 4 + h) * 64 + tl] = __expf(bc[63 * 64 + tl]);
    __syncthreads();
}
__device__ __forceinline__ void gla_out_item(int item, int tl, LAS unsigned char* lds, const bf16* P, const float* wa2, const float* ba, const float* KVS, const float* norm_g, bf16* OMIX) {
    const int n = item >> 2, h = item & 3, wv = tl >> 6, ln = tl & 63, lr = ln & 15, lq = ln >> 4;
    gla_decay_cumsum(n, h, tl, lds, P, wa2, ba);
    LAS float* bc = (LAS float*)(lds + GL_BC); LAS bf16* qd = (LAS bf16*)(lds + GL_QD); LAS bf16* kd = (LAS bf16*)(lds + GL_KD); LAS bf16* vt = (LAS bf16*)(lds + GL_VT);
    LAS bf16* pm = (LAS bf16*)(lds + GL_PM); LAS bf16* sp = (LAS bf16*)(lds + GL_SP); LAS float* red = (LAS float*)(lds + GL_RED);
    { const int t = tl >> 3, oq = tl & 7; const size_t row = (size_t)n * 64 + t; float q[8], k[8];
      unpack8(*(const uint4*)(P + row * NP0 + h * 64 + oq * 8), q); unpack8(*(const uint4*)(P + row * NP0 + 256 + h * 64 + oq * 8), k);
      unsigned qw[4], kw[4];
#pragma unroll
      for (int e = 0; e < 8; e += 2) { const float b0 = bc[t * 64 + oq * 8 + e], b1 = bc[t * 64 + oq * 8 + e + 1];
          qw[e >> 1] = (unsigned)f2bf(q[e] * 0.125f * __expf(b0)) | ((unsigned)f2bf(q[e + 1] * 0.125f * __expf(b1)) << 16);
          kw[e >> 1] = (unsigned)f2bf(k[e] * __expf(-b0)) | ((unsigned)f2bf(k[e + 1] * __expf(-b1)) << 16); }
      *(LAS u32x4_t*)(qd + t * GL_LD + oq * 8) = (u32x4_t){qw[0], qw[1], qw[2], qw[3]}; *(LAS u32x4_t*)(kd + t * GL_LD + oq * 8) = (u32x4_t){kw[0], kw[1], kw[2], kw[3]}; }
    gla_stage_vt(n, h, tl, lds, P);
    { const float* kv = KVS + (size_t)(n * 4 + h) * 128 * 64;
#pragma unroll
      for (int i = 0; i < 4; ++i) { const int idx = tl + 512 * i, v = idx >> 4, d4 = idx & 15; const f32x4_t x = *(const f32x4_t*)(kv + v * 64 + d4 * 4);
          *(LAS u32x2_t*)(sp + v * GL_LD + d4 * 4) = (u32x2_t){(unsigned)f2bf(x[0]) | ((unsigned)f2bf(x[1]) << 16), (unsigned)f2bf(x[2]) | ((unsigned)f2bf(x[3]) << 16)}; } }
    __syncthreads();
    const int mt = wv & 3;
    {
        const int nt0 = (wv >> 2) * 2; f32x4_t acc[2] = {(f32x4_t){0.f, 0.f, 0.f, 0.f}, (f32x4_t){0.f, 0.f, 0.f, 0.f}};
#pragma unroll
        for (int kb = 0; kb < 2; ++kb) { const bf16x8_t a = lds_frag(qd, 16 * mt + lr, kb * 32 + 8 * lq);
#pragma unroll
            for (int nn = 0; nn < 2; ++nn) acc[nn] = __builtin_amdgcn_mfma_f32_16x16x32_bf16(a, lds_frag(kd, 16 * (nt0 + nn) + lr, kb * 32 + 8 * lq), acc[nn], 0, 0, 0); }
#pragma unroll
        for (int nn = 0; nn < 2; ++nn)
#pragma unroll
            for (int r = 0; r < 4; ++r) { const int i = 16 * mt + 4 * lq + r, j = 16 * (nt0 + nn) + lr; pm[i * GL_LD + j] = f2bf(j <= i ? acc[nn][r] : 0.f); }
    }
    __syncthreads();
    const int ntb = (wv >> 2) * 4; f32x4_t acc[4];
#pragma unroll
    for (int nn = 0; nn < 4; ++nn) acc[nn] = (f32x4_t){0.f, 0.f, 0.f, 0.f};
#pragma unroll
    for (int kb = 0; kb < 2; ++kb) { const bf16x8_t a1 = lds_frag(pm, 16 * mt + lr, kb * 32 + 8 * lq), a2 = lds_frag(qd, 16 * mt + lr, kb * 32 + 8 * lq);
#pragma unroll
        for (int nn = 0; nn < 4; ++nn) { acc[nn] = __builtin_amdgcn_mfma_f32_16x16x32_bf16(a1, lds_frag(vt, 16 * (ntb + nn) + lr, kb * 32 + 8 * lq), acc[nn], 0, 0, 0);
            acc[nn] = __builtin_amdgcn_mfma_f32_16x16x32_bf16(a2, lds_frag(sp, 16 * (ntb + nn) + lr, kb * 32 + 8 * lq), acc[nn], 0, 0, 0); } }
#pragma unroll
    for (int r = 0; r < 4; ++r) { float ss = 0.f;
#pragma unroll
        for (int nn = 0; nn < 4; ++nn) ss += acc[nn][r] * acc[nn][r];
        ss += __shfl_xor(ss, 1); ss += __shfl_xor(ss, 2); ss += __shfl_xor(ss, 4); ss += __shfl_xor(ss, 8);
        if (lr == 0) red[(16 * mt + 4 * lq + r) * 2 + (wv >> 2)] = ss; }
    __syncthreads();
#pragma unroll
    for (int r = 0; r < 4; ++r) { const int i = 16 * mt + 4 * lq + r; const float rstd = 1.f / sqrtf((red[i * 2] + red[i * 2 + 1]) * (1.f / 128.f) + 1e-5f);
        const size_t row = (size_t)n * 64 + i;
#pragma unroll
        for (int nn = 0; nn < 4; ++nn) { const int v = 16 * (ntb + nn) + lr; const float g = bf2f(P[row * NP0 + 1024 + h * 128 + v]);
            OMIX[row * 1024 + h * 128 + v] = f2bf(acc[nn][r] * rstd * norm_g[h * 128 + v] * (g / (1.f + __expf(-g)))); } }
    __syncthreads();
}
__device__ __forceinline__ void gla_state_scan(int e, float* KVS, const float* DEC) {
    const int h = e >> 13, vd = e & 8191, d = e & 63; float s = 0.f;
#pragma unroll 4
    for (int n = 0; n < 256; ++n) { float* p = KVS + (size_t)(n * 4 + h) * 8192 + vd; const float kv = *p, dec = DEC[(n * 4 + h) * 64 + d]; *p = s; s = dec * s + kv; }
}

constexpr int SD_LD = 136;
constexpr int SD_ACS = 0, SD_T0 = 4096, SD_T1 = SD_T0 + 128 * SD_LD * 2, SD_X = SD_T1 + 128 * SD_LD * 2, SD_PV = SD_X + 64 * SD_LD * 2;
static_assert(SD_PV + 64 * SD_LD * 2 <= 131072, "SSD LDS");
__device__ __forceinline__ void ssd_prep_oct(int idx, const bf16* P, const float* conv_w, const float* conv_b, bf16* XBC) {
    const int t = idx / 192, c0 = (idx % 192) * 8;
    float y[8];
#pragma unroll
    for (int e = 0; e < 8; ++e) y[e] = conv_b[c0 + e];
#pragma unroll
    for (int i = 0; i < 4; ++i) { const int tt = t - 3 + i; if (tt >= 0) { float x[8]; unpack8(*(const uint4*)(P + (size_t)tt * NP1 + 1024 + c0), x);
#pragma unroll
        for (int e = 0; e < 8; ++e) y[e] += conv_w[i * 1536 + c0 + e] * x[e]; } }
    unsigned w[4];
#pragma unroll
    for (int e = 0; e < 8; e += 2) { const float a = y[e] / (1.f + __expf(-y[e])), b = y[e + 1] / (1.f + __expf(-y[e + 1])); w[e >> 1] = (unsigned)f2bf(a) | ((unsigned)f2bf(b) << 16); }
    *(uint4*)(XBC + (size_t)t * 1536 + c0) = make_uint4(w[0], w[1], w[2], w[3]);
}
__device__ __forceinline__ void ssd_dt_item2(int idx, const bf16* P, const float* dt_bias, const float* a_log, float* DT, float* AA) {
    const int t = idx >> 4, h = idx & 15;
    const float x = bf2f(P[(size_t)t * NP1 + 4096 + h]) + dt_bias[h];
    const float dt = x > 20.f ? x : __logf(1.f + __expf(x));
    DT[idx] = dt; AA[idx] = -dt * __expf(a_log[h]);
}
__device__ __forceinline__ void ssd_acs(int c, int g, int wv, int ln, LAS float* acs, const float* AA) {
    const int h = g * 8 + wv, t0 = c * 128;
    const float a0 = AA[(size_t)(t0 + 2 * ln) * 16 + h], a1 = AA[(size_t)(t0 + 2 * ln + 1) * 16 + h];
    float s = a0 + a1;
#pragma unroll
    for (int o = 1; o < 64; o <<= 1) { const float u = __shfl_up(s, o); if (ln >= o) s += u; }
    acs[wv * 128 + 2 * ln] = s - a1; acs[wv * 128 + 2 * ln + 1] = s;
}
__device__ __forceinline__ bf16x8_t sd_frag(const LAS bf16* base, int row, int k0) { return *(const LAS bf16x8_t*)(base + row * SD_LD + k0); }
__device__ __forceinline__ void ssd_state_item(int item, int tl, LAS unsigned char* lds, const bf16* XBC, const float* DT, const float* AA, float* ST, float* CDEC) {
    const int c = item >> 1, g = item & 1, wv = tl >> 6, ln = tl & 63, lr = ln & 15, lq = ln >> 4, t0 = c * 128;
    LAS float* acs = (LAS float*)(lds + SD_ACS); LAS bf16* bt = (LAS bf16*)(lds + SD_T0); LAS bf16* xdt = (LAS bf16*)(lds + SD_X);
    ssd_acs(c, g, wv, ln, acs, AA);
#pragma unroll
    for (int i = 0; i < 4; ++i) { const int task = tl + 512 * i, sidx = task >> 4, noct = task & 15; const uint4 u = *(const uint4*)(XBC + (size_t)(t0 + sidx) * 1536 + 1024 + g * 128 + noct * 8);
        const unsigned w[4] = {u.x, u.y, u.z, u.w};
#pragma unroll
        for (int e = 0; e < 8; ++e) bt[(noct * 8 + e) * SD_LD + sidx] = (bf16)((e & 1) ? (w[e >> 1] >> 16) : (w[e >> 1] & 0xffffu)); }
    __syncthreads();
#pragma unroll 1
    for (int hh = 0; hh < 8; ++hh) {
        const int h = g * 8 + hh; const float alast = acs[hh * 128 + 127];
#pragma unroll
        for (int i = 0; i < 2; ++i) { const int task = tl + 512 * i, sidx = task >> 3, poct = task & 7; float x[8]; unpack8(*(const uint4*)(XBC + (size_t)(t0 + sidx) * 1536 + h * 64 + poct * 8), x);
            const float f = DT[(size_t)(t0 + sidx) * 16 + h] * __expf(alast - acs[hh * 128 + sidx]);
#pragma unroll
            for (int e = 0; e < 8; ++e) xdt[(poct * 8 + e) * SD_LD + sidx] = f2bf(x[e] * f); }
        __syncthreads();
        const int mt = wv & 3, ntb = (wv >> 2) * 4; f32x4_t acc[4];
#pragma unroll
        for (int nn = 0; nn < 4; ++nn) acc[nn] = (f32x4_t){0.f, 0.f, 0.f, 0.f};
#pragma unroll
        for (int kb = 0; kb < 4; ++kb) { const bf16x8_t a = sd_frag(xdt, 16 * mt + lr, kb * 32 + 8 * lq);
#pragma unroll
            for (int nn = 0; nn < 4; ++nn) acc[nn] = __builtin_amdgcn_mfma_f32_16x16x32_bf16(a, sd_frag(bt, 16 * (ntb + nn) + lr, kb * 32 + 8 * lq), acc[nn], 0, 0, 0); }
        float* st = ST + (size_t)(c * 16 + h) * 8192;
#pragma unroll
        for (int nn = 0; nn < 4; ++nn)
#pragma unroll
            for (int r = 0; r < 4; ++r) st[(16 * mt + 4 * lq + r) * 128 + 16 * (ntb + nn) + lr] = acc[nn][r];
        if (tl == 0) CDEC[c * 16 + h] = __expf(alast);
        __syncthreads();
    }
}
__device__ __forceinline__ void ssd_state_scan(int e, float* ST, const float* CDEC) {
    const int h = e >> 13; float s = 0.f;
#pragma unroll 4
    for (int c = 0; c < 128; ++c) { float* p = ST + (size_t)c * 131072 + e; const float st = *p, dec = CDEC[c * 16 + h]; *p = s; s = dec * s + st; }
}
__device__ __forceinline__ void ssd_out_item(int item, int tl, LAS unsigned char* lds, const bf16* P, const bf16* XBC, const float* DT, const float* AA, const float* ST, const float* d_skip, const float* norm_g, bf16* OMIX) {
    const int c = item >> 1, g = item & 1, wv = tl >> 6, ln = tl & 63, lr = ln & 15, lq = ln >> 4, t0 = c * 128;
    LAS float* acs = (LAS float*)(lds + SD_ACS); LAS bf16* cc = (LAS bf16*)(lds + SD_T0); LAS bf16* bb = (LAS bf16*)(lds + SD_T1); LAS bf16* pw = bb;
    LAS bf16* xdt = (LAS bf16*)(lds + SD_X); LAS bf16* pv = (LAS bf16*)(lds + SD_PV);
    ssd_acs(c, g, wv, ln, acs, AA);
#pragma unroll
    for (int i = 0; i < 4; ++i) { const int task = tl + 512 * i, sidx = task >> 4, noct = task & 15; const bf16* src = XBC + (size_t)(t0 + sidx) * 1536 + 1024 + g * 128 + noct * 8;
        const uint4 ub = *(const uint4*)src, uc = *(const uint4*)(src + 256);
        *(LAS u32x4_t*)(bb + sidx * SD_LD + noct * 8) = (u32x4_t){ub.x, ub.y, ub.z, ub.w}; *(LAS u32x4_t*)(cc + sidx * SD_LD + noct * 8) = (u32x4_t){uc.x, uc.y, uc.z, uc.w}; }
    __syncthreads();
    bf16x8_t cf[4]; f32x4_t cb[8];
#pragma unroll
    for (int kb = 0; kb < 4; ++kb) cf[kb] = sd_frag(cc, 16 * wv + lr, kb * 32 + 8 * lq);
#pragma unroll
    for (int nt = 0; nt < 8; ++nt) { cb[nt] = (f32x4_t){0.f, 0.f, 0.f, 0.f};
#pragma unroll
        for (int kb = 0; kb < 4; ++kb) cb[nt] = __builtin_amdgcn_mfma_f32_16x16x32_bf16(cf[kb], sd_frag(bb, 16 * nt + lr, kb * 32 + 8 * lq), cb[nt], 0, 0, 0); }
    __syncthreads();
    float ss[4] = {0.f, 0.f, 0.f, 0.f};
#pragma unroll 1
    for (int hh = 0; hh < 8; ++hh) {
        const int h = g * 8 + hh;
#pragma unroll
        for (int i = 0; i < 2; ++i) { const int task = tl + 512 * i, sidx = task >> 3, poct = task & 7; float x[8]; unpack8(*(const uint4*)(XBC + (size_t)(t0 + sidx) * 1536 + h * 64 + poct * 8), x);
            const float f = DT[(size_t)(t0 + sidx) * 16 + h];
#pragma unroll
            for (int e = 0; e < 8; ++e) xdt[(poct * 8 + e) * SD_LD + sidx] = f2bf(x[e] * f); }
        { const float* st = ST + (size_t)(c * 16 + h) * 8192;
#pragma unroll
          for (int i = 0; i < 4; ++i) { const int idx = tl + 512 * i, p = idx >> 5, n4 = idx & 31; const f32x4_t x = *(const f32x4_t*)(st + p * 128 + n4 * 4);
              *(LAS u32x2_t*)(pv + p * SD_LD + n4 * 4) = (u32x2_t){(unsigned)f2bf(x[0]) | ((unsigned)f2bf(x[1]) << 16), (unsigned)f2bf(x[2]) | ((unsigned)f2bf(x[3]) << 16)}; } }
        float al[4];
#pragma unroll
        for (int r = 0; r < 4; ++r) al[r] = acs[hh * 128 + 16 * wv + 4 * lq + r];
#pragma unroll
        for (int nt = 0; nt < 8; ++nt) { const int sidx = 16 * nt + lr; const float as = acs[hh * 128 + sidx];
#pragma unroll
            for (int r = 0; r < 4; ++r) { const int l = 16 * wv + 4 * lq + r; pw[l * SD_LD + sidx] = f2bf(sidx <= l ? cb[nt][r] * __expf(al[r] - as) : 0.f); } }
        __syncthreads();
        f32x4_t yd[4], yo[4];
#pragma unroll
        for (int nn = 0; nn < 4; ++nn) { yd[nn] = (f32x4_t){0.f, 0.f, 0.f, 0.f}; yo[nn] = (f32x4_t){0.f, 0.f, 0.f, 0.f}; }
#pragma unroll
        for (int kb = 0; kb < 4; ++kb) { const bf16x8_t a = sd_frag(pw, 16 * wv + lr, kb * 32 + 8 * lq);
#pragma unroll
            for (int nn = 0; nn < 4; ++nn) { yd[nn] = __builtin_amdgcn_mfma_f32_16x16x32_bf16(a, sd_frag(xdt, 16 * nn + lr, kb * 32 + 8 * lq), yd[nn], 0, 0, 0);
                yo[nn] = __builtin_amdgcn_mfma_f32_16x16x32_bf16(cf[kb], sd_frag(pv, 16 * nn + lr, kb * 32 + 8 * lq), yo[nn], 0, 0, 0); } }
        const float dsk = d_skip[h];
#pragma unroll
        for (int r = 0; r < 4; ++r) { const size_t row = (size_t)t0 + 16 * wv + 4 * lq + r; const float ea = __expf(al[r]);
#pragma unroll
            for (int nn = 0; nn < 4; ++nn) { const int ch = h * 64 + 16 * nn + lr;
                const float x = bf2f(XBC[row * 1536 + ch]), z = bf2f(P[row * NP1 + ch]);
                const float val = (yd[nn][r] + ea * yo[nn][r] + dsk * x) * (z / (1.f + __expf(-z)));
                ss[r] += val * val; OMIX[row * 1536 + ch] = f2bf(val); } }
        __syncthreads();
    }
#pragma unroll
    for (int r = 0; r < 4; ++r) { float q = ss[r]; q += __shfl_xor(q, 1); q += __shfl_xor(q, 2); q += __shfl_xor(q, 4); q += __shfl_xor(q, 8); ss[r] = 1.f / sqrtf(q * (1.f / 512.f) + 1e-5f); }
#pragma unroll 1
    for (int hh = 0; hh < 8; ++hh)
#pragma unroll
        for (int r = 0; r < 4; ++r) { const size_t row = (size_t)t0 + 16 * wv + 4 * lq + r;
#pragma unroll
            for (int nn = 0; nn < 4; ++nn) { const int ch = (g * 8 + hh) * 64 + 16 * nn + lr; bf16* o = OMIX + row * 1536 + ch; *o = f2bf(bf2f(*o) * ss[r] * norm_g[ch]); } }
    __syncthreads();
}

constexpr int MB_QS = 1024, MB_KS = MB_QS + 64 * 72 * 2, MB_VT = MB_KS + 256 * 72 * 2, MB_PM = MB_VT + 64 * 264 * 2, MB_RED = MB_PM + 64 * 264 * 2, MB_PREF = MB_RED + 1024;
static_assert(MB_PREF + 520 * 4 <= 131072, "MoBA LDS");
__device__ __forceinline__ int moba_lbase(int j) { return 256 * (63 * j - (j * (j - 1)) / 2); }
__device__ __forceinline__ void moba_gate_item(int item, int ln, const bf16* P, const float* KM, int* CNT, int* LIST) {
    const int h = item & 7, tgp = item >> 3, t = tgp * 64 + ln, own = tgp >> 2;
    if (own == 0) return;
    float q[64];
#pragma unroll
    for (int o = 0; o < 8; ++o) { float f[8]; unpack8(*(const uint4*)(P + (size_t)t * NP1 + 2560 + h * 64 + o * 8), f);
#pragma unroll
        for (int e = 0; e < 8; ++e) q[o * 8 + e] = f[e]; }
    float b0 = -INFINITY, b1 = -INFINITY, b2 = -INFINITY; int i0 = 0, i1 = 0, i2 = 0;
#pragma unroll 1
    for (int j = 0; j < own; ++j) {
        const f32x4_t* km = (const f32x4_t*)(KM + (size_t)(h * 64 + j) * 64); float g0 = 0.f, g1 = 0.f;
#pragma unroll
        for (int d4 = 0; d4 < 16; ++d4) { const f32x4_t k = km[d4]; g0 += q[4 * d4] * k[0] + q[4 * d4 + 2] * k[2]; g1 += q[4 * d4 + 1] * k[1] + q[4 * d4 + 3] * k[3]; }
        const float g = g0 + g1;
        if (g > b0) { b2 = b1; i2 = i1; b1 = b0; i1 = i0; b0 = g; i0 = j; }
        else if (g > b1) { b2 = b1; i2 = i1; b1 = g; i1 = j; }
        else if (g > b2) { b2 = g; i2 = j; }
    }
    const int nsel = own < 3 ? own : 3;
#pragma unroll
    for (int u = 0; u < 3; ++u) if (u < nsel) { const int j = (u == 0) ? i0 : (u == 1 ? i1 : i2);
        const int pos = atomicAdd(CNT + h * 64 + j, 1);
        LIST[(size_t)h * 516096 + moba_lbase(j) + pos] = t * 4 + (u + 1); }
}
__device__ __forceinline__ bf16x8_t mb_frag(const LAS bf16* base, int ld, int row, int k0) { return *(const LAS bf16x8_t*)(base + row * ld + k0); }
__device__ __forceinline__ void moba_attn_tile(int h, int j, bool causal, int tl, LAS unsigned char* lds, const bf16* P, float* PML, bf16* PO) {
    const int wv = tl >> 6, ln = tl & 63, lr = ln & 15, lq = ln >> 4;
    LAS int* tq = (LAS int*)lds; LAS int* sl = tq + 64;
    LAS bf16* qs = (LAS bf16*)(lds + MB_QS); LAS bf16* ks = (LAS bf16*)(lds + MB_KS); LAS bf16* vt = (LAS bf16*)(lds + MB_VT); LAS bf16* pm = (LAS bf16*)(lds + MB_PM);
    LAS float* red = (LAS float*)(lds + MB_RED); LAS float* red2 = red + 128;
    { const int row = tl >> 3, oq = tl & 7; int t = tq[row]; if (t < 0) t = 0; const uint4 u = *(const uint4*)(P + (size_t)t * NP1 + 2560 + h * 64 + oq * 8);
      *(LAS u32x4_t*)(qs + row * 72 + oq * 8) = (u32x4_t){u.x, u.y, u.z, u.w}; }
#pragma unroll
    for (int i = 0; i < 4; ++i) { const int task = tl + 512 * i, key = task >> 3, oct = task & 7; const bf16* src = P + (size_t)(j * 256 + key) * NP1 + 3072 + h * 64 + oct * 8;
        const uint4 uk = *(const uint4*)src, uv = *(const uint4*)(src + 512);
        *(LAS u32x4_t*)(ks + key * 72 + oct * 8) = (u32x4_t){uk.x, uk.y, uk.z, uk.w};
        const unsigned w[4] = {uv.x, uv.y, uv.z, uv.w};
#pragma unroll
        for (int e = 0; e < 8; ++e) vt[(oct * 8 + e) * 264 + key] = (bf16)((e & 1) ? (w[e >> 1] >> 16) : (w[e >> 1] & 0xffffu)); }
    __syncthreads();
    const int mt = wv & 3, half = wv >> 2, nb = half * 8;
    f32x4_t acc[8];
#pragma unroll
    for (int nn = 0; nn < 8; ++nn) acc[nn] = (f32x4_t){0.f, 0.f, 0.f, 0.f};
#pragma unroll
    for (int kb = 0; kb < 2; ++kb) { const bf16x8_t a = mb_frag(qs, 72, 16 * mt + lr, kb * 32 + 8 * lq);
#pragma unroll
        for (int nn = 0; nn < 8; ++nn) acc[nn] = __builtin_amdgcn_mfma_f32_16x16x32_bf16(a, mb_frag(ks, 72, 16 * (nb + nn) + lr, kb * 32 + 8 * lq), acc[nn], 0, 0, 0); }
    const float slope = exp2f(-(float)(h + 1));
    int tr[4]; float mx[4];
#pragma unroll
    for (int r = 0; r < 4; ++r) { tr[r] = tq[16 * mt + 4 * lq + r]; mx[r] = -INFINITY; }
#pragma unroll
    for (int nn = 0; nn < 8; ++nn) { const int sk = j * 256 + 16 * (nb + nn) + lr;
#pragma unroll
        for (int r = 0; r < 4; ++r) { float v = 0.125f * acc[nn][r] - slope * (float)(tr[r] - sk); if (causal && sk > tr[r]) v = -INFINITY; acc[nn][r] = v; mx[r] = fmaxf(mx[r], v); } }
#pragma unroll
    for (int r = 0; r < 4; ++r) { float v = mx[r]; v = fmaxf(v, __shfl_xor(v, 1)); v = fmaxf(v, __shfl_xor(v, 2)); v = fmaxf(v, __shfl_xor(v, 4)); v = fmaxf(v, __shfl_xor(v, 8));
        if (lr == 0) red[(16 * mt + 4 * lq + r) * 2 + half] = v; }
    __syncthreads();
#pragma unroll
    for (int r = 0; r < 4; ++r) { const int row = 16 * mt + 4 * lq + r; float m = fmaxf(red[row * 2], red[row * 2 + 1]); if (m == -INFINITY) m = 0.f; mx[r] = m; }
    float ls[4] = {0.f, 0.f, 0.f, 0.f};
#pragma unroll
    for (int nn = 0; nn < 8; ++nn)
#pragma unroll
        for (int r = 0; r < 4; ++r) { const float p = __expf(acc[nn][r] - mx[r]); ls[r] += p; pm[(16 * mt + 4 * lq + r) * 264 + 16 * (nb + nn) + lr] = f2bf(p); }
#pragma unroll
    for (int r = 0; r < 4; ++r) { float v = ls[r]; v += __shfl_xor(v, 1); v += __shfl_xor(v, 2); v += __shfl_xor(v, 4); v += __shfl_xor(v, 8);
        if (lr == 0) red2[(16 * mt + 4 * lq + r) * 2 + half] = v; }
    __syncthreads();
    f32x4_t oa[2] = {(f32x4_t){0.f, 0.f, 0.f, 0.f}, (f32x4_t){0.f, 0.f, 0.f, 0.f}};
#pragma unroll
    for (int kb = 0; kb < 8; ++kb) { const bf16x8_t a = mb_frag(pm, 264, 16 * mt + lr, kb * 32 + 8 * lq);
#pragma unroll
        for (int nn = 0; nn < 2; ++nn) oa[nn] = __builtin_amdgcn_mfma_f32_16x16x32_bf16(a, mb_frag(vt, 264, 16 * (half * 2 + nn) + lr, kb * 32 + 8 * lq), oa[nn], 0, 0, 0); }
#pragma unroll
    for (int r = 0; r < 4; ++r) { const int row = 16 * mt + 4 * lq + r; const int t = tr[r];
        if (t >= 0) { const size_t pi = ((size_t)t * 8 + h) * 4 + sl[row];
#pragma unroll
            for (int nn = 0; nn < 2; ++nn) PO[pi * 64 + 16 * (half * 2 + nn) + lr] = f2bf(oa[nn][r]);
            if (half == 0 && lr == 0) { PML[pi * 2] = mx[r]; PML[pi * 2 + 1] = red2[row * 2] + red2[row * 2 + 1]; } } }
    __syncthreads();
}
__device__ __forceinline__ void moba_attn_phase(int bx, int G, int tl, LAS unsigned char* lds, const bf16* P, const int* CNT, const int* LIST, float* PML, bf16* PO) {
    LAS int* tq = (LAS int*)lds; LAS int* sl = tq + 64; LAS int* pref = (LAS int*)(lds + MB_PREF);
    {
        const int wv = tl >> 6, ln = tl & 63; int v = (CNT[tl] + 63) >> 6;
#pragma unroll
        for (int o = 1; o < 64; o <<= 1) { const int u = __shfl_up(v, o); if (ln >= o) v += u; }
        if (ln == 63) pref[512 + wv] = v;
        __syncthreads();
        int add = 0;
        for (int w = 0; w < wv; ++w) add += pref[512 + w];
        __syncthreads();
        pref[tl] = v + add;
        __syncthreads();
    }
    const int total = pref[511];
    for (int it = bx; it < 2048 + total; it += G) {
        int h, j; bool causal;
        if (it < 2048) { h = it & 7; const int qt = it >> 3; j = qt >> 2; causal = true; if (tl < 64) { tq[tl] = qt * 64 + tl; sl[tl] = 0; } }
        else { const int x = it - 2048; int lo = 0, hi = 511;
            while (lo < hi) { const int mid = (lo + hi) >> 1; if (pref[mid] > x) hi = mid; else lo = mid + 1; }
            h = lo >> 6; j = lo & 63; causal = false;
            const int tile = x - (lo ? pref[lo - 1] : 0), cnt = CNT[lo];
            if (tl < 64) { const int e = tile * 64 + tl; if (e < cnt) { const int v = LIST[(size_t)h * 516096 + moba_lbase(j) + e]; tq[tl] = v >> 2; sl[tl] = v & 3; } else { tq[tl] = -1; sl[tl] = 0; } } }
        __syncthreads();
        moba_attn_tile(h, j, causal, tl, lds, P, PML, PO);
    }
}
__device__ __forceinline__ void moba_merge_item(int idx, const float* PML, const bf16* PO, bf16* OMIX) {
    const int oc = idx & 7, h = (idx >> 3) & 7, t = idx >> 6, own = t >> 8, ns = 1 + (own < 3 ? own : 3);
    const size_t pi = ((size_t)t * 8 + h) * 4;
    float m[4], l[4]; float mmax = -INFINITY;
#pragma unroll
    for (int u = 0; u < 4; ++u) if (u < ns) { m[u] = PML[(pi + u) * 2]; l[u] = PML[(pi + u) * 2 + 1]; mmax = fmaxf(mmax, m[u]); }
    float L = 0.f, o[8];
#pragma unroll
    for (int e = 0; e < 8; ++e) o[e] = 0.f;
#pragma unroll
    for (int u = 0; u < 4; ++u) if (u < ns) { const float w = __expf(m[u] - mmax); L += w * l[u]; float f[8]; unpack8(*(const uint4*)(PO + (pi + u) * 64 + oc * 8), f);
#pragma unroll
        for (int e = 0; e < 8; ++e) o[e] += w * f[e]; }
    const float inv = 1.f / L; unsigned w4[4];
#pragma unroll
    for (int e = 0; e < 8; e += 2) w4[e >> 1] = (unsigned)f2bf(o[e] * inv) | ((unsigned)f2bf(o[e + 1] * inv) << 16);
    *(uint4*)(OMIX + (size_t)t * 1536 + 1024 + h * 64 + oc * 8) = make_uint4(w4[0], w4[1], w4[2], w4[3]);
}

namespace pg8 {
typedef short bf16x8 __attribute__((ext_vector_type(8)));
typedef float f32x4 __attribute__((ext_vector_type(4)));
typedef unsigned u32x4 __attribute__((ext_vector_type(4)));
constexpr int BM = 256, BK = 64, HALF = 128, HTB = HALF * BK * 2, STAGE_BYTES = 8 * HTB, NXCD = 8, WGM = 8;
__host__ __device__ __forceinline__ int lds_byte(int r, int c) { const int st = (r >> 4) * 2 + (c >> 5), rr = r & 15, cc = c & 31, ob = rr * 64 + cc * 2; return st * 1024 + (ob ^ (((ob >> 9) & 1) << 5)); }
__host__ __device__ __forceinline__ void stage_rc(int b, int& R, int& C) { const int st = b / 1024, sb = b % 1024, swz = sb ^ (((sb >> 9) & 1) << 5); R = (st >> 1) * 16 + swz / 64; C = (st & 1) * 32 + (swz % 64) / 2; }
__host__ __device__ __forceinline__ int perm32(int rho) { const int n = rho >> 4, i = rho & 15; return 8 * (i >> 2) + 4 * n + (i & 3); }
struct Unit { int pm, pn; };
struct Gemm { const bf16* A; const bf16* Bt; const int* tile_e; size_t a_pn_step, b_tstep, b_estep; int lda, ldb, K, pad; };
struct StaticOrder {
    int nM, nN, nwg, G, c;
    __device__ void init(int Mr, int N, int G_, int c_) { nM = Mr / BM; nN = N / BM; nwg = nM * nN; G = G_; c = c_; }
    __device__ bool next(int i, Unit& u) const {
        const long L = (long)i * G + c; if (L >= nwg) return false;
        int wgid = (int)L; { const int q = nwg / NXCD, r = nwg % NXCD, xcd = wgid % NXCD, off = wgid / NXCD; wgid = (xcd < r ? xcd * (q + 1) : r * (q + 1) + (xcd - r) * q) + off; }
        const int nig = WGM * nN, gid = wgid / nig, fm = gid * WGM, gsz = (nM - fm) < WGM ? (nM - fm) : WGM;
        u.pm = fm + ((wgid % nig) % gsz); u.pn = (wgid % nig) / gsz; return true;
    }
    __device__ __forceinline__ void a_ready(const Unit&) const {}
    __device__ __forceinline__ void done(const Unit&) const {}
};
__device__ __forceinline__ unsigned cvt_pk_bf16(float lo, float hi) { unsigned r; asm volatile("v_cvt_pk_bf16_f32 %0, %1, %2" : "=v"(r) : "v"(lo), "v"(hi)); return r; }
__device__ __forceinline__ u32x4 pack8(const f32x4 v0, const f32x4 v1) { u32x4 w; w.x = cvt_pk_bf16(v0[0], v0[1]); w.y = cvt_pk_bf16(v0[2], v0[3]); w.z = cvt_pk_bf16(v1[0], v1[1]); w.w = cvt_pk_bf16(v1[2], v1[3]); return w; }
struct EpBf {
    static constexpr bool PERM = true, AFTER_DRAIN = false;
    bf16* O; int ldc; float scale;
    __device__ __forceinline__ void operator()(const f32x4 (&acc)[2][2][4][2], const Unit& u, int wr, int wc, int fr, int fq) const {
        const int row0 = u.pm * BM + wr * 64 + fr, col0 = u.pn * BM + wc * 32 + 8 * fq;
#pragma unroll
        for (int ai = 0; ai < 2; ++ai)
#pragma unroll
            for (int m = 0; m < 4; ++m) { bf16* rowp = O + (size_t)(row0 + ai * HALF + m * 16) * ldc + col0;
#pragma unroll
                for (int bj = 0; bj < 2; ++bj) *(u32x4*)(rowp + bj * HALF) = pack8(acc[ai][bj][m][0] * scale, acc[ai][bj][m][1] * scale); }
    }
};
struct EpRes {
    static constexpr bool PERM = false, AFTER_DRAIN = false;
    const float* base; float* out;
    __device__ __forceinline__ void operator()(const f32x4 (&acc)[2][2][4][2], const Unit& u, int wr, int wc, int fr, int fq) const {
        const int row0 = u.pm * BM + wr * 64 + fr, col0 = u.pn * BM + wc * 32 + 4 * fq;
#pragma unroll
        for (int ai = 0; ai < 2; ++ai)
#pragma unroll
            for (int m = 0; m < 4; ++m) { const size_t off = (size_t)(row0 + ai * HALF + m * 16) * D + col0;
#pragma unroll
                for (int bj = 0; bj < 2; ++bj)
#pragma unroll
                    for (int n = 0; n < 2; ++n) { const f32x4 bs = *(const f32x4*)(base + off + bj * HALF + n * 16); *(f32x4*)(out + off + bj * HALF + n * 16) = bs * ALPHA + acc[ai][bj][m][n]; } }
    }
};
struct EpSilu {
    static constexpr bool PERM = true, AFTER_DRAIN = false;
    bf16* O; int ldc; int pad;
    __device__ __forceinline__ void operator()(const f32x4 (&acc)[2][2][4][2], const Unit& u, int wr, int wc, int fr, int fq) const {
        const int row0 = u.pm * BM + wr * 64 + fr, col0 = u.pn * HALF + wc * 32 + 8 * fq;
#pragma unroll
        for (int ai = 0; ai < 2; ++ai)
#pragma unroll
            for (int m = 0; m < 4; ++m) { f32x4 h[2];
#pragma unroll
                for (int n = 0; n < 2; ++n)
#pragma unroll
                    for (int j = 0; j < 4; ++j) { const float g = acc[ai][0][m][n][j]; h[n][j] = g / (1.f + __expf(-g)) * acc[ai][1][m][n][j]; }
                *(u32x4*)(O + (size_t)(row0 + ai * HALF + m * 16) * ldc + col0) = pack8(h[0], h[1]); }
    }
};
struct EpYR {
    static constexpr bool PERM = true, AFTER_DRAIN = false;
    bf16* YR; const int* row_tok; const int* tile_e; const int* meta; int row_off; int pad;
    __device__ __forceinline__ void operator()(const f32x4 (&acc)[2][2][4][2], const Unit& u, int wr, int wc, int fr, int fq) const {
        const int row0 = u.pm * BM + wr * 64 + fr, col0 = u.pn * BM + wc * 32 + 8 * fq;
        const int shift = row_off - meta[8 + tile_e[u.pm]];
#pragma unroll
        for (int ai = 0; ai < 2; ++ai)
#pragma unroll
            for (int m = 0; m < 4; ++m) { const int r = row0 + ai * HALF + m * 16;
                if (row_tok[r] >= 0) { bf16* rowp = YR + (size_t)(r + shift) * D + col0;
#pragma unroll
                    for (int bj = 0; bj < 2; ++bj) *(u32x4*)(rowp + bj * HALF) = pack8(acc[ai][bj][m][0], acc[ai][bj][m][1]); } }
    }
};
struct EpSoftmax {
    static constexpr bool PERM = true, AFTER_DRAIN = true;
    bf16* O; int ldc; int pad;
    __device__ __forceinline__ void fused(f32x4 (&acc)[2][2][4][2], const Unit& u, int wr, int wc, int fr, int fq, LAS unsigned char* lds, int wid, int lane) const {
        LAS float* T1 = (LAS float*)lds; LAS float* T2 = T1 + 1024;
#pragma unroll
        for (int ai = 0; ai < 2; ++ai)
#pragma unroll
            for (int m = 0; m < 4; ++m) { float v = -INFINITY;
#pragma unroll
                for (int bj = 0; bj < 2; ++bj)
#pragma unroll
                    for (int n = 0; n < 2; ++n) { const f32x4 x = acc[ai][bj][m][n]; v = fmaxf(v, fmaxf(fmaxf(x[0], x[1]), fmaxf(x[2], x[3]))); }
                v = fmaxf(v, __shfl_xor(v, 16)); v = fmaxf(v, __shfl_xor(v, 32));
                if (fq == 0) T1[(ai * HALF + wr * 64 + m * 16 + fr) * 4 + wc] = v; }
        asm volatile("s_waitcnt lgkmcnt(0)" ::: "memory"); __builtin_amdgcn_s_barrier(); asm volatile("" ::: "memory");
#pragma unroll
        for (int ai = 0; ai < 2; ++ai)
#pragma unroll
            for (int m = 0; m < 4; ++m) { const int r = ai * HALF + wr * 64 + m * 16 + fr; const f32x4 t = *(const LAS f32x4*)(T1 + r * 4);
                const float mx = fmaxf(fmaxf(t[0], t[1]), fmaxf(t[2], t[3])); float s = 0.f;
#pragma unroll
                for (int bj = 0; bj < 2; ++bj)
#pragma unroll
                    for (int n = 0; n < 2; ++n)
#pragma unroll
                        for (int j = 0; j < 4; ++j) { const float e = __expf(acc[ai][bj][m][n][j] - mx); acc[ai][bj][m][n][j] = e; s += e; }
                s += __shfl_xor(s, 16); s += __shfl_xor(s, 32);
                if (fq == 0) T2[r * 4 + wc] = s; }
        asm volatile("s_waitcnt lgkmcnt(0)" ::: "memory"); __builtin_amdgcn_s_barrier(); asm volatile("" ::: "memory");
        const int row0 = u.pm * BM + wr * 64 + fr, col0 = u.pn * BM + wc * 32 + 8 * fq;
#pragma unroll
        for (int ai = 0; ai < 2; ++ai)
#pragma unroll
            for (int m = 0; m < 4; ++m) { const int r = ai * HALF + wr * 64 + m * 16 + fr; const f32x4 t = *(const LAS f32x4*)(T2 + r * 4);
                const float inv = 1.f / ((t[0] + t[1]) + (t[2] + t[3]));
                bf16* rowp = O + (size_t)(row0 + ai * HALF + m * 16) * ldc + col0;
#pragma unroll
                for (int bj = 0; bj < 2; ++bj) *(u32x4*)(rowp + bj * HALF) = pack8(acc[ai][bj][m][0] * inv, acc[ai][bj][m][1] * inv); }
        asm volatile("s_waitcnt lgkmcnt(0)" ::: "memory"); __builtin_amdgcn_s_barrier(); asm volatile("" ::: "memory");
    }
};

template <class Epi, class Sched, bool ALIGN_EPI, bool SP2>
__device__ __forceinline__ void gemm_phase(LAS unsigned char* lds, const Gemm g, const Sched& S, const Epi& E, const int tid) {
    const int wid = __builtin_amdgcn_readfirstlane(tid >> 6), lane = tid & 63, wr = wid >> 2, wc = wid & 3, fr = lane & 15, fq = lane >> 4;
    const int K = g.K, nt = K / BK;
    unsigned voffA[2], voffB[2];
#pragma unroll
    for (int i = 0; i < 2; ++i) { int R, C; stage_rc(tid * 16 + i * 8192, R, C); const int Rb = Epi::PERM ? ((R & ~31) + perm32(R & 31)) : R;
        voffA[i] = (unsigned)(R * g.lda + C) * 2u; voffB[i] = (unsigned)(Rb * g.ldb + C) * 2u; }
    const size_t kstep = (size_t)(BK * 2);
    const size_t hstepA = (size_t)HALF * g.lda * 2, hstepB = (size_t)HALF * g.ldb * 2;
    const size_t tstepA = 2 * hstepA;
    const unsigned ldsw = (unsigned)wid * 1024u;
    const int aoff = lds_byte(wr * 64 + fr, fq * 8), boff = lds_byte(wc * 32 + fr, fq * 8);
#define PG8_SA(b, h) (((b) * 2 + (h)) * HTB)
#define PG8_SB(b, h) ((4 + (b) * 2 + (h)) * HTB)
#define PG8_STAGE(bufoff, gbase, voff) do { _Pragma("unroll") for (int _i = 0; _i < 2; ++_i) \
        __builtin_amdgcn_global_load_lds((const unsigned*)((const char*)(gbase) + (voff)[_i]), (LAS unsigned*)(lds + (bufoff) + ldsw + _i * 8192), 16, 0, 0); } while (0)
#define PG8_LDA(dst, b, h) do { _Pragma("unroll") for (int m = 0; m < 4; ++m) _Pragma("unroll") for (int k = 0; k < 2; ++k) dst[m][k] = *(const LAS bf16x8*)(lds + PG8_SA(b, h) + aoff + m * 2048 + k * 1024); } while (0)
#define PG8_LDB(dst, b, h) do { _Pragma("unroll") for (int n = 0; n < 2; ++n) _Pragma("unroll") for (int k = 0; k < 2; ++k) dst[n][k] = *(const LAS bf16x8*)(lds + PG8_SB(b, h) + boff + n * 2048 + k * 1024); } while (0)
#define PG8_MMA(ai, bj, At, Bt) do { __builtin_amdgcn_s_setprio(1); _Pragma("unroll") for (int m = 0; m < 4; ++m) _Pragma("unroll") for (int n = 0; n < 2; ++n) _Pragma("unroll") for (int k = 0; k < 2; ++k) \
        acc[ai][bj][m][n] = __builtin_amdgcn_mfma_f32_16x16x32_bf16(Bt[n][k], At[m][k], acc[ai][bj][m][n], 0, 0, 0); __builtin_amdgcn_s_setprio(0); } while (0)
#define PG8_WAIT_V(n) asm volatile("s_waitcnt vmcnt(" #n ")" ::: "memory")
#define PG8_WAIT_L(n) asm volatile("s_waitcnt lgkmcnt(" #n ")" ::: "memory")
#define PG8_BAR __builtin_amdgcn_s_barrier()
#define PG8_SCHED __builtin_amdgcn_sched_barrier(0)
#define PG8_APTR(u) ((const char*)g.A + (size_t)(u).pm * tstepA + (size_t)(u).pn * g.a_pn_step)
#define PG8_BPTR(u) ((const char*)g.Bt + (size_t)(u).pn * g.b_tstep + (g.tile_e ? (size_t)g.tile_e[(u).pm] * g.b_estep : (size_t)0))
    Unit cur, nxt; int ui = 0;
    if (!S.next(0, cur)) return;
    f32x4 acc[2][2][4][2];
#pragma unroll
    for (int a = 0; a < 2; ++a)
#pragma unroll
        for (int b = 0; b < 2; ++b)
#pragma unroll
            for (int m = 0; m < 4; ++m)
#pragma unroll
                for (int n = 0; n < 2; ++n) acc[a][b][m][n] = (f32x4){0.f, 0.f, 0.f, 0.f};
    bf16x8 At[4][2], B0[2][2], B1[2][2];
    const char* cA = PG8_APTR(cur); const char* cB = PG8_BPTR(cur);
    S.a_ready(cur);
    if constexpr (SP2) {
        PG8_STAGE(PG8_SB(0, 0), cB, voffB); PG8_STAGE(PG8_SB(0, 1), cB + hstepB, voffB); PG8_STAGE(PG8_SA(0, 0), cA, voffA); PG8_STAGE(PG8_SA(0, 1), cA + hstepA, voffA);
        if (wr == 1) PG8_BAR;
        PG8_WAIT_V(2); PG8_BAR;
        PG8_STAGE(PG8_SB(1, 0), cB + kstep, voffB); PG8_STAGE(PG8_SA(1, 0), cA + kstep, voffA); PG8_STAGE(PG8_SB(1, 1), cB + hstepB + kstep, voffB);
        PG8_WAIT_V(6); PG8_BAR;
    } else {
        PG8_STAGE(PG8_SB(0, 0), cB, voffB); PG8_STAGE(PG8_SA(0, 0), cA, voffA); PG8_STAGE(PG8_SB(0, 1), cB + hstepB, voffB); PG8_STAGE(PG8_SA(0, 1), cA + hstepA, voffA);
        if (wr == 1) PG8_BAR;
        PG8_WAIT_V(4); PG8_BAR;
        PG8_STAGE(PG8_SB(1, 0), cB + kstep, voffB); PG8_STAGE(PG8_SA(1, 0), cA + kstep, voffA); PG8_STAGE(PG8_SB(1, 1), cB + hstepB + kstep, voffB);
        PG8_WAIT_V(6); PG8_BAR;
    }
    for (;;) {
        const bool has_next = S.next(ui + 1, nxt);
        const char* nA = has_next ? PG8_APTR(nxt) : cA; const char* nB = has_next ? PG8_BPTR(nxt) : cB;
        for (int t = 0; t < nt; t += 2) {
            const bool last = (t == nt - 2);
            const char* a1 = cA + (size_t)(t + 1) * kstep;
            const char* a2 = last ? nA : cA + (size_t)(t + 2) * kstep; const char* b2 = last ? nB : cB + (size_t)(t + 2) * kstep;
            const char* a3 = a2 + kstep; const char* b3 = b2 + kstep;
            if (last && has_next) S.a_ready(nxt);
            if constexpr (SP2) {
            PG8_LDB(B0, 0, 0); PG8_LDB(B1, 0, 1); PG8_SCHED; PG8_LDA(At, 0, 0); PG8_STAGE(PG8_SA(1, 1), a1 + hstepA, voffA);
            PG8_WAIT_V(8); PG8_WAIT_L(0); PG8_BAR; PG8_MMA(0, 0, At, B0); PG8_MMA(0, 1, At, B1); PG8_BAR; PG8_SCHED;
            PG8_LDA(At, 0, 1); PG8_STAGE(PG8_SB(0, 0), b2, voffB); PG8_STAGE(PG8_SB(0, 1), b2 + hstepB, voffB); PG8_STAGE(PG8_SA(0, 0), a2, voffA);
            PG8_WAIT_V(8); PG8_WAIT_L(0); PG8_BAR; PG8_MMA(1, 0, At, B0); PG8_MMA(1, 1, At, B1); PG8_BAR; PG8_SCHED;
            PG8_LDB(B0, 1, 0); PG8_LDB(B1, 1, 1); PG8_SCHED; PG8_LDA(At, 1, 0); PG8_STAGE(PG8_SA(0, 1), a2 + hstepA, voffA);
            PG8_WAIT_V(8); PG8_WAIT_L(0); PG8_BAR; PG8_MMA(0, 0, At, B0); PG8_MMA(0, 1, At, B1); PG8_BAR; PG8_SCHED;
            PG8_LDA(At, 1, 1); PG8_STAGE(PG8_SB(1, 0), b3, voffB); PG8_STAGE(PG8_SB(1, 1), b3 + hstepB, voffB); PG8_STAGE(PG8_SA(1, 0), a3, voffA);
            PG8_WAIT_V(8); PG8_WAIT_L(0); PG8_BAR; PG8_MMA(1, 0, At, B0); PG8_MMA(1, 1, At, B1); PG8_BAR; PG8_SCHED;
            } else {
            PG8_LDB(B0, 0, 0); PG8_SCHED; PG8_LDA(At, 0, 0); PG8_STAGE(PG8_SA(1, 1), a1 + hstepA, voffA);
            PG8_WAIT_L(8); PG8_BAR; PG8_WAIT_L(0); PG8_MMA(0, 0, At, B0); PG8_BAR; PG8_SCHED;
            PG8_LDB(B1, 0, 1); PG8_STAGE(PG8_SB(0, 0), b2, voffB);
            PG8_BAR; PG8_WAIT_L(0); PG8_MMA(0, 1, At, B1); PG8_BAR;
            PG8_LDA(At, 0, 1); PG8_STAGE(PG8_SA(0, 0), a2, voffA);
            PG8_BAR; PG8_WAIT_L(0); PG8_MMA(1, 0, At, B0); PG8_BAR; PG8_SCHED;
            PG8_STAGE(PG8_SB(0, 1), b2 + hstepB, voffB);
            PG8_WAIT_V(6); PG8_BAR; PG8_MMA(1, 1, At, B1); PG8_BAR;
            PG8_LDB(B0, 1, 0); PG8_SCHED; PG8_LDA(At, 1, 0); PG8_STAGE(PG8_SA(0, 1), a2 + hstepA, voffA);
            PG8_WAIT_L(8); PG8_BAR; PG8_WAIT_L(0); PG8_MMA(0, 0, At, B0); PG8_BAR; PG8_SCHED;
            PG8_LDB(B1, 1, 1); PG8_STAGE(PG8_SB(1, 0), b3, voffB);
            PG8_BAR; PG8_WAIT_L(0); PG8_MMA(0, 1, At, B1); PG8_BAR;
            PG8_LDA(At, 1, 1); PG8_STAGE(PG8_SA(1, 0), a3, voffA);
            PG8_BAR; PG8_WAIT_L(0); PG8_MMA(1, 0, At, B0); PG8_BAR; PG8_SCHED;
            PG8_STAGE(PG8_SB(1, 1), b3 + hstepB, voffB);
            PG8_WAIT_V(6); PG8_BAR; PG8_MMA(1, 1, At, B1); PG8_BAR;
            }
        }
        if constexpr (ALIGN_EPI) { if (wr == 0) PG8_BAR; }
        if constexpr (!Epi::AFTER_DRAIN) { E(acc, cur, wr, wc, fr, fq); S.done(cur); }
        if (!has_next) break;
#pragma unroll
        for (int a = 0; a < 2; ++a)
#pragma unroll
            for (int b = 0; b < 2; ++b)
#pragma unroll
                for (int m = 0; m < 4; ++m)
#pragma unroll
                    for (int n = 0; n < 2; ++n) acc[a][b][m][n] = (f32x4){0.f, 0.f, 0.f, 0.f};
        cur = nxt; cA = nA; cB = nB; ++ui;
        if constexpr (ALIGN_EPI) { if (wr == 1) PG8_BAR; }
    }
    PG8_WAIT_V(0);
    if constexpr (!ALIGN_EPI) { if (wr == 0) PG8_BAR; }
    PG8_BAR;
    if constexpr (Epi::AFTER_DRAIN) { E.fused(acc, cur, wr, wc, fr, fq, lds, wid, lane); S.done(cur); }
#undef PG8_SA
#undef PG8_SB
#undef PG8_STAGE
#undef PG8_LDA
#undef PG8_LDB
#undef PG8_MMA
#undef PG8_WAIT_V
#undef PG8_WAIT_L
#undef PG8_BAR
#undef PG8_SCHED
#undef PG8_APTR
#undef PG8_BPTR
}
}

#define XB_TMO      128
#define XB_XCNT(j)  (256  + 64 * (j))
#define XB_XSUB(j)  (1280 + 64 * (j))
#define XB_XGEN(j)  (2304 + 64 * (j))
#define XB_TOP      3328
#define XB_TOPGEN   3392
#define XCD_BAR_WORDS 3456
#define XB_SPIN_CAP (1u << 28)
__device__ __forceinline__ unsigned xb_ld(unsigned* p)              { return __hip_atomic_load(p, __ATOMIC_RELAXED, __HIP_MEMORY_SCOPE_AGENT); }
__device__ __forceinline__ unsigned xb_add(unsigned* p, unsigned v) { return __hip_atomic_fetch_add(p, v, __ATOMIC_RELAXED, __HIP_MEMORY_SCOPE_AGENT); }
__device__ __forceinline__ unsigned xb_xcc_id() { return (unsigned)__builtin_amdgcn_s_getreg((3 << 11) | 20) & 0xFu; }
#define XB_SPIN(cond, bar) do { unsigned _sp = 0; while (cond) { __builtin_amdgcn_s_sleep(1); \
    if ((++_sp & 255u) == 0u) { if (xb_ld(&(bar)[XB_TMO])) break; if (_sp > XB_SPIN_CAP) { atomicAdd(&(bar)[XB_TMO], 1u); break; } } } } while (0)
struct XcdBarrier { unsigned* bar; unsigned x; volatile LAS unsigned* st; };
__device__ __forceinline__ XcdBarrier xcd_barrier_post(unsigned* bar, volatile LAS unsigned* st) {
    XcdBarrier b; b.bar = bar; b.x = xb_xcc_id(); b.st = st;
    if (threadIdx.x == 0) (void)xb_add(&bar[XB_XCNT(b.x)], 1u);
    return b;
}
__device__ __forceinline__ void xcd_barrier_complete(unsigned* bar, unsigned x, unsigned& nloc, unsigned& nx) {
    const unsigned G = gridDim.x * gridDim.y * gridDim.z;
    unsigned sum, cnt, mine, sp = 0u;
    for (;;) {
        sum = 0u; cnt = 0u; mine = 0u;
#pragma unroll
        for (unsigned j = 0; j < 16; ++j) { const unsigned c = xb_ld(&bar[XB_XCNT(j)]); sum += c; cnt += (c > 0u) ? 1u : 0u; mine = (j == x) ? c : mine; }
        if (sum == G) break;
        __builtin_amdgcn_s_sleep(1);
        if ((++sp & 255u) == 0u) { if (xb_ld(&bar[XB_TMO])) break; if (sp > XB_SPIN_CAP) { atomicAdd(&bar[XB_TMO], 1u); break; } }
    }
    nloc = mine > 0u ? mine : 1u; nx = cnt > 0u ? cnt : 1u;
}
__device__ __forceinline__ void xcd_barrier(const XcdBarrier& b) {
    asm volatile("s_waitcnt vmcnt(0)" ::: "memory");
    __syncthreads();
    if (threadIdx.x == 0) {
        unsigned* bar = b.bar;
        __builtin_amdgcn_s_waitcnt(0);
        unsigned nloc = b.st[0], nx = b.st[1];
        if (nloc == 0u) { xcd_barrier_complete(bar, b.x, nloc, nx); b.st[0] = nloc; b.st[1] = nx; }
        const unsigned old = xb_add(&bar[XB_XSUB(b.x)], 1u);
        const unsigned gen = old / nloc;
        if (old + 1u == (gen + 1u) * nloc) {
            __builtin_amdgcn_fence(__ATOMIC_RELEASE, "agent");
            asm volatile("s_waitcnt vmcnt(0)" ::: "memory");
            const unsigned og = xb_add(&bar[XB_TOP], 1u);
            const unsigned tg = og / nx;
            if (og + 1u == (tg + 1u) * nx) xb_add(&bar[XB_TOPGEN], 1u);
            else XB_SPIN(xb_ld(&bar[XB_TOPGEN]) == tg, bar);
            __builtin_amdgcn_fence(__ATOMIC_ACQUIRE, "agent");
            xb_add(&bar[XB_XGEN(b.x)], 1u);
            asm volatile("s_waitcnt vmcnt(0)" ::: "memory");
        } else {
            XB_SPIN(xb_ld(&bar[XB_XGEN(b.x)]) == gen, bar);
            __builtin_amdgcn_fence(__ATOMIC_ACQUIRE, "agent");
            asm volatile("s_waitcnt vmcnt(0)" ::: "memory");
        }
    }
    __syncthreads();
}

constexpr int NWAVES = 8;
constexpr int RING_BYTES = 131072, LDSCTL_OFF = RING_BYTES, MISC_OFF = LDSCTL_OFF + 320, LDS_BYTES = 147456;
constexpr int CW_BAR = 4096;
constexpr size_t W_GU0 = 209 * MiB, W_D0 = 220 * MiB, W_OUT0 = 225 * MiB + 512 * 1024, W_XQ0 = 227 * MiB + 512 * 1024, W_XO0 = 229 * MiB + 512 * 1024;
constexpr size_t W_IN0 = 265 * MiB, W_XK0 = 272 * MiB, W_XV0 = 274 * MiB;
constexpr size_t W_IN1 = 409 * MiB, W_OUT1 = 417 * MiB + 512 * 1024, W_XQ1 = 420 * MiB + 512 * 1024, W_XK1 = 422 * MiB + 512 * 1024, W_XV1 = 424 * MiB + 512 * 1024, W_XO1 = 426 * MiB + 512 * 1024;
constexpr size_t WS_MEMB = 428 * MiB + 512 * 1024, WS_KMEM0 = 429 * MiB, WS_VT0 = 429 * MiB + 512 * 1024, WS_KMEM1 = 430 * MiB, WS_VT1 = 430 * MiB + 512 * 1024;
constexpr size_t WS_HM = 65 * MiB, WS_XG = 159 * MiB, WS_YR = 227 * MiB, WS_RT = 291 * MiB, W_EGU = 292 * MiB, W_ED = 380 * MiB;
constexpr size_t EGU_STEP = 11 * MiB, ED_STEP = 5 * MiB + 512 * 1024;
constexpr size_t RT_TOPE = 0, RT_GATE = 128 * 1024, RT_ROWTOK = 256 * 1024, RT_SLOTROW = 512 * 1024, RT_TILEE = 640 * 1024, RT_META = 704 * 1024, RT_BC = 768 * 1024;

struct MArgs { const float* in[54]; float* out; unsigned char* ws; int ph_lo, ph_hi, li, pad; };
constexpr int PTAB_OFF = MISC_OFF + 128;
struct PTab { const LAS unsigned* t;
    __device__ __forceinline__ const float* operator[](int i) const { const unsigned lo = __builtin_amdgcn_readfirstlane(t[2 * i]), hi = __builtin_amdgcn_readfirstlane(t[2 * i + 1]);
        return (const float*)(((unsigned long long)hi << 32) | lo); } };
struct Ctx { PTab in; float* out; unsigned char* ws; };

struct CvtJob { const float* W0; const float* W1; bf16* dst; int ld, K, ndst, mode; };
__device__ __forceinline__ const float* cvt_src(const CvtJob& j, int n) {
    switch (j.mode) {
        case 0: return j.W0 + n;
        case 1: return n < 1552 ? j.W0 + n : (n < 1792 ? nullptr : j.W0 + (n - 240));
        case 2: return n < 2560 ? j.W0 + n : (n < 4096 ? j.W0 + (n + 16) : (n < 4112 ? j.W0 + (2560 + n - 4096) : nullptr));
        default: { const int pn = n >> 8, r = n & 255; return r < 128 ? j.W0 + (128 * pn + r) : j.W1 + (128 * pn + r - 128); }
    }
}
__device__ __forceinline__ unsigned pk2(float lo, float hi) { return (unsigned)f2bf(lo) | ((unsigned)f2bf(hi) << 16); }
__device__ __forceinline__ void cvt_item(const CvtJob& j, LAS float* scr, int item, int lane) {
    const int nblk = j.ndst / 32, kb = item / nblk, nb = item % nblk, k0 = 64 * kb, n0 = 32 * nb;
    const float* colp = cvt_src(j, n0 + (lane & 31));
#pragma unroll 8
    for (int i = 0; i < 32; ++i) { const int kk = 2 * i + (lane >> 5); scr[kk * 33 + (lane & 31)] = colp ? colp[(size_t)(k0 + kk) * j.ld] : 0.f; }
    asm volatile("s_waitcnt lgkmcnt(0)" ::: "memory");
    const int c = lane & 7;
#pragma unroll
    for (int jj = 0; jj < 4; ++jj) { const int n = (lane >> 3) + 8 * jj; const LAS float* sp = scr + (8 * c) * 33 + n;
        uint4 o; o.x = pk2(sp[0 * 33], sp[1 * 33]); o.y = pk2(sp[2 * 33], sp[3 * 33]); o.z = pk2(sp[4 * 33], sp[5 * 33]); o.w = pk2(sp[6 * 33], sp[7 * 33]);
        *(uint4*)(j.dst + (size_t)(n0 + n) * j.K + k0 + 8 * c) = o; }
    asm volatile("s_waitcnt lgkmcnt(0)" ::: "memory");
}
__device__ __forceinline__ CvtJob get_cvt_job(int idx, const Ctx& a) {
    unsigned char* ws = a.ws; CvtJob j; j.W1 = nullptr; j.mode = 0; j.ld = 1024; j.K = 1024; j.ndst = 1024;
    switch (idx) {
        case 0: j.W0 = a.in[2]; j.dst = (bf16*)(ws + W_IN0); j.ld = 3344; j.ndst = NP0; j.mode = 1; break;
        case 1: j.W0 = a.in[17]; j.dst = (bf16*)(ws + W_OUT0); break;
        case 2: j.W0 = a.in[20]; j.dst = (bf16*)(ws + W_XQ0); break;
        case 3: j.W0 = a.in[21]; j.dst = (bf16*)(ws + W_XK0); break;
        case 4: j.W0 = a.in[22]; j.dst = (bf16*)(ws + W_XV0); break;
        case 5: j.W0 = a.in[23]; j.dst = (bf16*)(ws + W_XO0); break;
        case 6: j.W0 = a.in[26]; j.W1 = a.in[27]; j.dst = (bf16*)(ws + W_GU0); j.ld = 2816; j.ndst = 5632; j.mode = 3; break;
        case 7: j.W0 = a.in[28]; j.dst = (bf16*)(ws + W_D0); j.K = 2816; break;
        case 8: j.W0 = a.in[31]; j.dst = (bf16*)(ws + W_IN1); j.ld = 4112; j.ndst = NP1; j.mode = 2; break;
        case 9: j.W0 = a.in[38]; j.dst = (bf16*)(ws + W_OUT1); j.K = 1536; break;
        case 10: j.W0 = a.in[41]; j.dst = (bf16*)(ws + W_XQ1); break;
        case 11: j.W0 = a.in[42]; j.dst = (bf16*)(ws + W_XK1); break;
        case 12: j.W0 = a.in[43]; j.dst = (bf16*)(ws + W_XV1); break;
        case 13: j.W0 = a.in[44]; j.dst = (bf16*)(ws + W_XO1); break;
        default: { const int e = (idx - 14) >> 1;
            if ((idx & 1) == 0) { j.W0 = a.in[49] + (size_t)e * 1024 * 2816; j.W1 = a.in[50] + (size_t)e * 1024 * 2816; j.dst = (bf16*)(ws + W_EGU + e * EGU_STEP); j.ld = 2816; j.ndst = 5632; j.mode = 3; }
            else { j.W0 = a.in[51] + (size_t)e * 2816 * 1024; j.dst = (bf16*)(ws + W_ED + e * ED_STEP); j.K = 2816; } } break;
    }
    return j;
}
__device__ __forceinline__ void cvt_jobs(int j_lo, int j_hi, const Ctx& args, LAS float* scr, int gw, int NGW, int ln) {
    int base = 0;
    for (int ji = j_lo; ji < j_hi; ++ji) {
        const CvtJob j = get_cvt_job(ji, args);
        const int nitems = (j.K / 64) * (j.ndst / 32);
        const int first = (gw - base % NGW + NGW) % NGW;
        for (int it = first; it < nitems; it += NGW) cvt_item(j, scr, it, ln);
        base += nitems;
    }
}
__device__ __forceinline__ void ln_row(const float* in, float* outf, bf16* outb, const float* g, const float* b, int lane, float4 (&o)[4]) {
    const float4* p = (const float4*)in + lane;
    float4 v[4]; float s = 0.f;
#pragma unroll
    for (int j = 0; j < 4; ++j) { v[j] = p[64 * j]; s += (v[j].x + v[j].y) + (v[j].z + v[j].w); }
    const float mean = wave_sum(s) * (1.f / D); float q = 0.f;
#pragma unroll
    for (int j = 0; j < 4; ++j) { v[j].x -= mean; v[j].y -= mean; v[j].z -= mean; v[j].w -= mean; q += (v[j].x * v[j].x + v[j].y * v[j].y) + (v[j].z * v[j].z + v[j].w * v[j].w); }
    const float rstd = 1.f / sqrtf(wave_sum(q) * (1.f / D) + 1e-5f);
#pragma unroll
    for (int j = 0; j < 4; ++j) {
        const int col = 4 * (lane + 64 * j);
        const float4 gg = *(const float4*)(g + col), bb = *(const float4*)(b + col);
        o[j].x = v[j].x * rstd * gg.x + bb.x; o[j].y = v[j].y * rstd * gg.y + bb.y; o[j].z = v[j].z * rstd * gg.z + bb.z; o[j].w = v[j].w * rstd * gg.w + bb.w;
        *(float4*)(outf + col) = o[j];
        if (outb) { uint2 w; w.x = pk2(o[j].x, o[j].y); w.y = pk2(o[j].z, o[j].w); *(uint2*)(outb + col) = w; }
    }
}
__device__ __forceinline__ int wave_sum_i(int v) {
#pragma unroll
    for (int o = 1; o < 64; o <<= 1) v += __shfl_xor(v, o);
    return v;
}

enum { K_PROLOGUE = 0, K_GEMM_BF, K_GEMM_RES, K_GEMM_SILU, K_GEMM_SOFTMAX, K_GEMM_YR, K_LN, K_L0_PREP, K_L0_SCAN, K_L0_COMB, K_L0_FIN, K_L1_PREP, K_L1_STATE, K_L1_SCAN, K_L1_FIN, K_MOE_ROUTE, K_MOE_ASSIGN, K_MOE_FINAL };
enum { F_KIND = 0, F_SYNC, F_MR, F_N, F_ROT, F_LDC, F_DYN, F_K, F_LDA, F_LDB, F_SCALE, F_PAD, F_A = 12, F_BT = 14, F_TILEE = 16, F_APN = 18, F_BTS = 20, F_BES = 22, F_O = 24, F_BASE = 26, F_OUTF = 28, F_LNG = 30, F_LNB = 32, STEP_DW = 40 };
enum StepId { S_PROLOGUE = 0, S_P0, S_KM0, S_VT0, S_KM1, S_VT1, S_L0_PREP, S_L0_SCAN, S_L0_COMB, S_L0_FIN, S_WOUT0, S_LN1_0, S_Q0, S_SM0, S_OX0, S_XO0, S_LN2_0, S_UP0, S_DOWN0, S_LN3_0,
              S_P1, S_L1_PREP, S_L1_STATE, S_L1_SCAN, S_L1_FIN, S_WOUT1, S_LN1_1, S_Q1, S_SM1, S_OX1, S_XO1, S_ROUTE, S_ASSIGN, S_UP_C0, S_DOWN_C0, S_UP_C1, S_DOWN_C1, S_FINAL, N_STEPS };
constexpr int STAB_OFF = PTAB_OFF + 576;
static_assert(STAB_OFF + N_STEPS * STEP_DW * 4 <= LDS_BYTES, "LDS control area");
struct StepW { LAS unsigned* d;
    __device__ __forceinline__ void i(int f, int v) const { d[f] = (unsigned)v; }
    __device__ __forceinline__ void f(int fi, float v) const { d[fi] = __float_as_uint(v); }
    __device__ __forceinline__ void p(int f, const void* v) const { const unsigned long long q = (unsigned long long)v; d[f] = (unsigned)q; d[f + 1] = (unsigned)(q >> 32); }
    __device__ __forceinline__ void u(int f, size_t q) const { d[f] = (unsigned)q; d[f + 1] = (unsigned)(q >> 32); } };
struct StepR { const LAS unsigned* d;
    __device__ __forceinline__ int i(int f) const { return (int)__builtin_amdgcn_readfirstlane(d[f]); }
    __device__ __forceinline__ float f(int fi) const { return __uint_as_float(__builtin_amdgcn_readfirstlane(d[fi])); }
    __device__ __forceinline__ unsigned long long u(int f) const { const unsigned lo = __builtin_amdgcn_readfirstlane(d[f]), hi = __builtin_amdgcn_readfirstlane(d[f + 1]); return ((unsigned long long)hi << 32) | lo; }
    template <class T> __device__ __forceinline__ T* p(int f) const { return (T*)u(f); } };
__device__ __forceinline__ void build_step(int s, LAS unsigned* d, const float* const* in, float* out, unsigned char* ws) {
    float* XFA = (float*)(ws + WS_XFA); float* XFB = out; bf16* XB = (bf16*)(ws + WS_XB); bf16* P = (bf16*)(ws + WS_P); bf16* OMIX = (bf16*)(ws + WS_OMIX);
    bf16* Q = (bf16*)(ws + WS_P); bf16* PATT = (bf16*)(ws + WS_P + 32 * MiB); bf16* OX = (bf16*)(ws + WS_P + 64 * MiB); bf16* H = (bf16*)(ws + WS_P);
    bf16* MEMB = (bf16*)(ws + WS_MEMB);
    const StepW t{d};
    for (int k = 0; k < STEP_DW; ++k) d[k] = 0u;
    t.i(F_KIND, K_GEMM_BF); t.i(F_SYNC, 1); t.i(F_MR, M); t.i(F_N, 1024); t.i(F_LDC, 1024); t.f(F_SCALE, 1.f);
    t.p(F_A, XB); t.u(F_BTS, (size_t)256 * 1024 * 2); t.i(F_LDA, 1024); t.i(F_LDB, 1024); t.i(F_K, 1024);
    const int L = (s >= S_P1) ? 1 : 0;
    switch (s) {
        case S_PROLOGUE: t.i(F_KIND, K_PROLOGUE); break;
        case S_P0: t.p(F_BT, ws + W_IN0); t.i(F_N, NP0); t.p(F_O, P); t.i(F_LDC, NP0); t.i(F_SYNC, 0); break;
        case S_KM0: t.p(F_A, MEMB); t.p(F_BT, ws + W_XK0); t.i(F_MR, 256); t.p(F_O, ws + WS_KMEM0); t.i(F_SYNC, 0); t.i(F_ROT, 128); break;
        case S_VT0: t.p(F_A, ws + W_XV0); t.p(F_BT, MEMB); t.i(F_MR, 1024); t.i(F_N, 256); t.p(F_O, ws + WS_VT0); t.i(F_LDC, 256); t.i(F_SYNC, 0); t.i(F_ROT, 132); break;
        case S_KM1: t.p(F_A, MEMB); t.p(F_BT, ws + W_XK1); t.i(F_MR, 256); t.p(F_O, ws + WS_KMEM1); t.i(F_SYNC, 0); t.i(F_ROT, 136); break;
        case S_VT1: t.p(F_A, ws + W_XV1); t.p(F_BT, MEMB); t.i(F_MR, 1024); t.i(F_N, 256); t.p(F_O, ws + WS_VT1); t.i(F_LDC, 256); t.i(F_ROT, 140); break;
        case S_L0_PREP: t.i(F_KIND, K_L0_PREP); break;
        case S_L0_SCAN: t.i(F_KIND, K_L0_SCAN); break;
        case S_L0_COMB: t.i(F_KIND, K_L0_COMB); break;
        case S_L0_FIN: t.i(F_KIND, K_L0_FIN); break;
        case S_WOUT0: t.i(F_KIND, K_GEMM_RES); t.p(F_A, OMIX); t.p(F_BT, ws + W_OUT0); t.p(F_BASE, in[0]); t.p(F_OUTF, XFA); break;
        case S_LN1_0: t.i(F_KIND, K_LN); t.p(F_OUTF, XFA); t.p(F_LNG, in[18]); t.p(F_LNB, in[19]); break;
        case S_Q0: case S_Q1: t.p(F_BT, ws + (L ? W_XQ1 : W_XQ0)); t.p(F_O, Q); t.f(F_SCALE, 0.0625f); break;
        case S_SM0: case S_SM1: t.i(F_KIND, K_GEMM_SOFTMAX); t.p(F_A, Q); t.u(F_APN, 512); t.p(F_BT, ws + (L ? WS_KMEM1 : WS_KMEM0)); t.u(F_BTS, 512); t.i(F_K, 256); t.p(F_O, PATT); break;
        case S_OX0: case S_OX1: t.p(F_A, PATT); t.u(F_APN, 512); t.p(F_BT, ws + (L ? WS_VT1 : WS_VT0)); t.i(F_LDB, 256); t.u(F_BTS, (size_t)256 * 256 * 2); t.i(F_K, 256); t.p(F_O, OX); break;
        case S_XO0: t.i(F_KIND, K_GEMM_RES); t.p(F_A, OX); t.p(F_BT, ws + W_XO0); t.p(F_BASE, XFA); t.p(F_OUTF, XFB); break;
        case S_LN2_0: t.i(F_KIND, K_LN); t.p(F_OUTF, XFB); t.p(F_LNG, in[24]); t.p(F_LNB, in[25]); break;
        case S_UP0: t.i(F_KIND, K_GEMM_SILU); t.p(F_BT, ws + W_GU0); t.i(F_N, 5632); t.p(F_O, H); t.i(F_LDC, 2816); break;
        case S_DOWN0: t.i(F_KIND, K_GEMM_RES); t.p(F_A, H); t.i(F_LDA, 2816); t.i(F_K, 2816); t.p(F_BT, ws + W_D0); t.i(F_LDB, 2816); t.u(F_BTS, (size_t)256 * 2816 * 2); t.p(F_BASE, XFB); t.p(F_OUTF, XFA); break;
        case S_LN3_0: t.i(F_KIND, K_LN); t.p(F_OUTF, XFA); t.p(F_LNG, in[29]); t.p(F_LNB, in[30]); break;
        case S_P1: t.p(F_BT, ws + W_IN1); t.i(F_N, NP1); t.p(F_O, P); t.i(F_LDC, NP1); break;
        case S_L1_PREP: t.i(F_KIND, K_L1_PREP); break;
        case S_L1_STATE: t.i(F_KIND, K_L1_STATE); break;
        case S_L1_SCAN: t.i(F_KIND, K_L1_SCAN); break;
        case S_L1_FIN: t.i(F_KIND, K_L1_FIN); break;
        case S_WOUT1: t.i(F_KIND, K_GEMM_RES); t.p(F_A, OMIX); t.i(F_LDA, 1536); t.i(F_K, 1536); t.p(F_BT, ws + W_OUT1); t.i(F_LDB, 1536); t.u(F_BTS, (size_t)256 * 1536 * 2); t.p(F_BASE, XFA); t.p(F_OUTF, XFB); break;
        case S_LN1_1: t.i(F_KIND, K_LN); t.p(F_OUTF, XFB); t.p(F_LNG, in[39]); t.p(F_LNB, in[40]); break;
        case S_XO1: t.i(F_KIND, K_GEMM_RES); t.p(F_A, OX); t.p(F_BT, ws + W_XO1); t.p(F_BASE, XFB); t.p(F_OUTF, XFA); break;
        case S_ROUTE: t.i(F_KIND, K_MOE_ROUTE); t.p(F_OUTF, XFA); t.p(F_LNG, in[45]); t.p(F_LNB, in[46]); break;
        case S_ASSIGN: t.i(F_KIND, K_MOE_ASSIGN); break;
        case S_UP_C0: case S_UP_C1: t.i(F_KIND, K_GEMM_SILU); t.i(F_DYN, s == S_UP_C0 ? 1 : 2); t.p(F_TILEE, ws + WS_RT + RT_TILEE); t.p(F_A, ws + WS_XG); t.p(F_BT, ws + W_EGU); t.u(F_BES, EGU_STEP); t.i(F_N, 5632); t.p(F_O, ws + WS_HM); t.i(F_LDC, 2816); break;
        case S_DOWN_C0: case S_DOWN_C1: t.i(F_KIND, K_GEMM_YR); t.i(F_DYN, s == S_DOWN_C0 ? 1 : 2); t.p(F_TILEE, ws + WS_RT + RT_TILEE); t.p(F_A, ws + WS_HM); t.i(F_LDA, 2816); t.i(F_K, 2816); t.p(F_BT, ws + W_ED); t.i(F_LDB, 2816);
            t.u(F_BTS, (size_t)256 * 2816 * 2); t.u(F_BES, ED_STEP); t.p(F_O, ws + WS_YR); break;
        default: t.i(F_KIND, K_MOE_FINAL); break;
    }
}
struct GemmSetup { pg8::Gemm g; int Mr, N, rot, row_off; };
__device__ __forceinline__ GemmSetup load_gemm(const StepR& r, const unsigned char* ws) {
    GemmSetup q; q.g.A = r.p<const bf16>(F_A); q.g.Bt = r.p<const bf16>(F_BT); q.g.tile_e = r.p<const int>(F_TILEE); q.g.a_pn_step = r.u(F_APN); q.g.b_tstep = r.u(F_BTS); q.g.b_estep = r.u(F_BES);
    q.g.lda = r.i(F_LDA); q.g.ldb = r.i(F_LDB); q.g.K = r.i(F_K); q.g.pad = 0; q.Mr = r.i(F_MR); q.N = r.i(F_N); q.rot = r.i(F_ROT); q.row_off = 0;
    const int dyn = r.i(F_DYN);
    if (dyn) {
        const int ntl = __builtin_amdgcn_readfirstlane(((const int*)(ws + WS_RT + RT_META))[16]) >> 8, T0 = (ntl + 1) >> 1, toff = (dyn == 2) ? T0 : 0, nt = (dyn == 2) ? ntl - T0 : T0;
        q.Mr = nt * 256; q.row_off = toff * 256; q.g.tile_e += toff;
        if (q.g.lda == 1024) q.g.A += (size_t)toff * 256 * 1024;
    }
    return q;
}

__global__ void __launch_bounds__(NWAVES * 64, 2) mega(MArgs args) {
    extern __shared__ __attribute__((aligned(16))) unsigned char lds_raw[];
    LAS unsigned char* lds = (LAS unsigned char*)lds_raw;
    volatile LAS unsigned* MISC = (volatile LAS unsigned*)(lds + MISC_OFF);
    const int tid = threadIdx.x, lane = tid & 63, wave = __builtin_amdgcn_readfirstlane(tid >> 6);
    const int G = gridDim.x; const int bx = blockIdx.x;
    const int vcu = (G % 8 == 0) ? (bx % 8) * (G / 8) + bx / 8 : bx;
    for (int u = tid; u < (LDS_BYTES - LDSCTL_OFF) / 4; u += NWAVES * 64) ((LAS unsigned*)(lds + LDSCTL_OFF))[u] = 0u;
    __syncthreads();
    unsigned* ctl = (unsigned*)(args.ws + WS_CTL);
    XcdBarrier bar = xcd_barrier_post(ctl + CW_BAR + args.li * XCD_BAR_WORDS, MISC + 8);
    const int gw = vcu * NWAVES + wave, NGW = G * NWAVES;
    if (tid < 54) { const unsigned long long p = (unsigned long long)args.in[tid]; LAS unsigned* pt = (LAS unsigned*)(lds + PTAB_OFF); pt[2 * tid] = (unsigned)p; pt[2 * tid + 1] = (unsigned)(p >> 32); }
    if (tid == 64)
#pragma unroll 1
        for (int k = 0; k < N_STEPS; ++k) build_step(k, (LAS unsigned*)(lds + STAB_OFF) + k * STEP_DW, args.in, args.out, args.ws);
    __syncthreads();
    const int ph_hi = args.ph_hi;

    for (int s = args.ph_lo; s < ph_hi; ++s) {
        Ctx cx; cx.in.t = (const LAS unsigned*)(lds + PTAB_OFF); cx.out = args.out; cx.ws = args.ws;
        asm volatile("" : "+s"(cx.ws), "+s"(cx.out));
        unsigned char* const ws = cx.ws;
        const StepR st{(const LAS unsigned*)(lds + STAB_OFF) + s * STEP_DW};
        const int kind = st.i(F_KIND);
        int tl = tid; asm volatile("" : "+v"(tl));
        const int ln = tl & 63;
        const int gt = (vcu * NWAVES + wave) * 64 + ln, GT = NGW * 64;
        switch (kind) {
            case K_PROLOGUE: {
                cvt_jobs(0, 14, cx, (LAS float*)(lds + wave * 16384), gw, NGW, ln);
                const float4* x4 = (const float4*)cx.in[0]; uint2* o2 = (uint2*)(ws + WS_XB);
                for (size_t i = (size_t)gw * 64 + ln; i < (size_t)M * D / 4; i += (size_t)NGW * 64) { const float4 v = x4[i]; uint2 w; w.x = pk2(v.x, v.y); w.y = pk2(v.z, v.w); o2[i] = w; }
                const float4* m4 = (const float4*)cx.in[1]; uint2* mo = (uint2*)(ws + WS_MEMB);
                for (size_t i = (size_t)gw * 64 + ln; i < (size_t)256 * D / 4; i += (size_t)NGW * 64) { const float4 v = m4[i]; uint2 w; w.x = pk2(v.x, v.y); w.y = pk2(v.z, v.w); mo[i] = w; }
            } break;
            case K_GEMM_BF: { const GemmSetup q = load_gemm(st, ws); pg8::StaticOrder S; S.init(q.Mr, q.N, G, (bx + G - q.rot) % G); pg8::EpBf E{st.p<bf16>(F_O), st.i(F_LDC), st.f(F_SCALE)};
                pg8::gemm_phase<pg8::EpBf, pg8::StaticOrder, true, true>(lds, q.g, S, E, tl); } break;
            case K_GEMM_RES: { const GemmSetup q = load_gemm(st, ws); pg8::StaticOrder S; S.init(q.Mr, q.N, G, bx); pg8::EpRes E{st.p<const float>(F_BASE), st.p<float>(F_OUTF)};
                pg8::gemm_phase<pg8::EpRes, pg8::StaticOrder, true, true>(lds, q.g, S, E, tl); } break;
            case K_GEMM_SILU: { const GemmSetup q = load_gemm(st, ws); pg8::StaticOrder S; S.init(q.Mr, q.N, G, bx); pg8::EpSilu E{st.p<bf16>(F_O), st.i(F_LDC), 0};
                pg8::gemm_phase<pg8::EpSilu, pg8::StaticOrder, true, true>(lds, q.g, S, E, tl); } break;
            case K_GEMM_SOFTMAX: { const GemmSetup q = load_gemm(st, ws); pg8::StaticOrder S; S.init(q.Mr, q.N, G, bx); pg8::EpSoftmax E{st.p<bf16>(F_O), st.i(F_LDC), 0};
                pg8::gemm_phase<pg8::EpSoftmax, pg8::StaticOrder, false, true>(lds, q.g, S, E, tl); } break;
            case K_GEMM_YR: { const GemmSetup q = load_gemm(st, ws); pg8::StaticOrder S; S.init(q.Mr, q.N, G, bx);
                pg8::EpYR E{st.p<bf16>(F_O), (const int*)(ws + WS_RT + RT_ROWTOK) + q.row_off, q.g.tile_e, (const int*)(ws + WS_RT + RT_META), q.row_off, 0};
                pg8::gemm_phase<pg8::EpYR, pg8::StaticOrder, true, true>(lds, q.g, S, E, tl); } break;
            case K_LN: {
                bf16* XB = (bf16*)(ws + WS_XB); float4 o[4];
                float* xf = st.p<float>(F_OUTF); const float* lg = st.p<const float>(F_LNG); const float* lb = st.p<const float>(F_LNB);
                for (int r = gw; r < M; r += NGW) ln_row(xf + (size_t)r * D, xf + (size_t)r * D, XB + (size_t)r * D, lg, lb, ln, o);
            } break;
            case K_L0_PREP: {
                const bf16* P = (const bf16*)(ws + WS_P);
                for (int it = bx; it < 1024; it += G) gla_state_item(it, tl, lds, P, cx.in[3], cx.in[4], (float*)cx.out, (float*)(ws + WS_CTL + 128 * 1024));
                float* VEC = (float*)(ws + WS_SCR); bf16* Gt = (bf16*)(ws + WS_XB + 16 * MiB); float* BON = (float*)(ws + WS_CTL + 512 * 1024);
                for (int grp = bx; grp < M / 16; grp += G) rwkv_prep_group(grp * 16, tl, (LAS float*)lds, P, cx.in[6], cx.in[7], cx.in[8], cx.in[9], cx.in[10], cx.in[11], cx.in[12], cx.in[13], cx.in[14], VEC, Gt, BON);
            } break;
            case K_L0_SCAN: {
                const bf16* P = (const bf16*)(ws + WS_P);
                if (wave < 4) rwkv_scan_seg(vcu * 4 + wave, ln, (LAS float*)(lds + wave * 12288), P, cx.in[6], (const float*)(ws + WS_SCR), (float*)(ws + WS_XFA), (float*)(ws + WS_XFA + 32 * MiB),
                                            (float*)cx.out + (size_t)8 * 1024 * 1024, (float*)cx.out + (size_t)12 * 1024 * 1024);
                else if (vcu < 128) gla_state_scan((vcu * 4 + (wave - 4)) * 64 + ln, (float*)cx.out, (const float*)(ws + WS_CTL + 128 * 1024));
            } break;
            case K_L0_COMB: {
                if (vcu < 64) rwkv_combine_row(vcu * 8 + wave, ln, (float*)cx.out + (size_t)8 * 1024 * 1024, (const float*)cx.out + (size_t)12 * 1024 * 1024);
                else for (int it = vcu - 64; it < 1024; it += G - 64) gla_out_item(it, tl, lds, (const bf16*)(ws + WS_P), cx.in[3], cx.in[4], (const float*)cx.out, cx.in[5], (bf16*)(ws + WS_OMIX));
            } break;
            case K_L0_FIN: {
                const bf16* P = (const bf16*)(ws + WS_P); bf16* OMIX = (bf16*)(ws + WS_OMIX);
                for (int it = gw; it < RW_J * 64; it += NGW) rwkv_fin_item(it, ln, P, cx.in[6], (const float*)(ws + WS_XFA), (const float*)(ws + WS_XFA + 32 * MiB), (const float*)cx.out + (size_t)8 * 1024 * 1024,
                                                                              (const bf16*)(ws + WS_XB + 16 * MiB), (const float*)(ws + WS_CTL + 512 * 1024), cx.in[15], cx.in[16], OMIX);
            } break;
            case K_L1_PREP: {
                const bf16* P = (const bf16*)(ws + WS_P);
                bf16* XBC = (bf16*)(ws + WS_SCR); float* DT = (float*)(ws + WS_SCR + 48 * MiB); float* AA = (float*)(ws + WS_SCR + 49 * MiB); float* KM = (float*)(ws + WS_SCR + 50 * MiB);
                for (int idx = gt; idx < M * 192; idx += GT) ssd_prep_oct(idx, P, cx.in[32], cx.in[33], XBC);
                for (int idx = gt; idx < M * 16; idx += GT) ssd_dt_item2(idx, P, cx.in[34], cx.in[35], DT, AA);
                for (int idx = gt; idx < 8 * 64 * 64; idx += GT) moba_kmean_item(idx, P, KM);
            } break;
            case K_L1_STATE: {
                if (bx < 256) ssd_state_item(bx, tl, lds, (const bf16*)(ws + WS_SCR), (const float*)(ws + WS_SCR + 48 * MiB), (const float*)(ws + WS_SCR + 49 * MiB), (float*)cx.out, (float*)(ws + WS_SCR + 51 * MiB));
                for (int it = gw; it < 2048; it += NGW) moba_gate_item(it, ln, (const bf16*)(ws + WS_P), (const float*)(ws + WS_SCR + 50 * MiB), (int*)(ws + WS_CTL + 32768), (int*)(ws + WS_XB));
            } break;
            case K_L1_SCAN: {
                ssd_state_scan(gt, (float*)cx.out, (const float*)(ws + WS_SCR + 51 * MiB));
                moba_attn_phase(bx, G, tl, lds, (const bf16*)(ws + WS_P), (const int*)(ws + WS_CTL + 32768), (const int*)(ws + WS_XB), (float*)(ws + WS_SCR + 54 * MiB), (bf16*)(ws + WS_SCR + 58 * MiB));
            } break;
            case K_L1_FIN: {
                if (bx < 256) ssd_out_item(bx, tl, lds, (const bf16*)(ws + WS_P), (const bf16*)(ws + WS_SCR), (const float*)(ws + WS_SCR + 48 * MiB), (const float*)(ws + WS_SCR + 49 * MiB), (const float*)cx.out,
                                           cx.in[36], cx.in[37], (bf16*)(ws + WS_OMIX));
                for (int idx = gt; idx < M * 64; idx += GT) moba_merge_item(idx, (const float*)(ws + WS_SCR + 54 * MiB), (const bf16*)(ws + WS_SCR + 58 * MiB), (bf16*)(ws + WS_OMIX));
            } break;
            case K_MOE_ROUTE: {
                volatile LAS int* cnt = (volatile LAS int*)(MISC + 16);
                if (tl < 8) cnt[tl] = 0;
                __syncthreads();
                bf16* XB = (bf16*)(ws + WS_XB); int* TOPE = (int*)(ws + WS_RT + RT_TOPE); float* GATE = (float*)(ws + WS_RT + RT_GATE);
                const float* wr = cx.in[47]; const float* br = cx.in[48]; float* xf = st.p<float>(F_OUTF); const float* lg = st.p<const float>(F_LNG); const float* lb = st.p<const float>(F_LNB);
                for (int k = 0; k < 8; ++k) {
                    const int r = vcu * 64 + wave * 8 + k; float4 o[4];
                    ln_row(xf + (size_t)r * D, xf + (size_t)r * D, XB + (size_t)r * D, lg, lb, ln, o);
                    float acc[8];
#pragma unroll
                    for (int e = 0; e < 8; ++e) acc[e] = 0.f;
#pragma unroll
                    for (int j = 0; j < 4; ++j) { const int col = 4 * (ln + 64 * j); const float xs[4] = {o[j].x, o[j].y, o[j].z, o[j].w};
#pragma unroll
                        for (int u = 0; u < 4; ++u) { const float4 w0 = *(const float4*)(wr + (size_t)(col + u) * 8), w1 = *(const float4*)(wr + (size_t)(col + u) * 8 + 4);
                            acc[0] += xs[u] * w0.x; acc[1] += xs[u] * w0.y; acc[2] += xs[u] * w0.z; acc[3] += xs[u] * w0.w; acc[4] += xs[u] * w1.x; acc[5] += xs[u] * w1.y; acc[6] += xs[u] * w1.z; acc[7] += xs[u] * w1.w; } }
#pragma unroll
                    for (int e = 0; e < 8; ++e) acc[e] = wave_sum(acc[e]) + br[e];
                    int e0 = 0; float l0 = acc[0];
#pragma unroll
                    for (int e = 1; e < 8; ++e) if (acc[e] > l0) { l0 = acc[e]; e0 = e; }
                    int e1 = -1; float l1 = -INFINITY;
#pragma unroll
                    for (int e = 0; e < 8; ++e) if (e != e0 && acc[e] > l1) { l1 = acc[e]; e1 = e; }
                    const float ex = __expf(l1 - l0), g0 = 1.f / (1.f + ex);
                    if (ln == 0) { TOPE[2 * r] = e0; TOPE[2 * r + 1] = e1; GATE[2 * r] = g0; GATE[2 * r + 1] = ex * g0;
                        __hip_atomic_fetch_add((int*)(cnt + e0), 1, __ATOMIC_RELAXED, __HIP_MEMORY_SCOPE_WORKGROUP); __hip_atomic_fetch_add((int*)(cnt + e1), 1, __ATOMIC_RELAXED, __HIP_MEMORY_SCOPE_WORKGROUP); }
                }
                __syncthreads();
                if (tl < 8) ((int*)(ws + WS_RT + RT_BC))[vcu * 8 + tl] = cnt[tl];
                cvt_jobs(14, 30, cx, (LAS float*)(lds + wave * 16384), gw, NGW, ln);
            } break;
            case K_MOE_ASSIGN: {
                LAS int* sm = (LAS int*)lds;
                const int* BC = (const int*)(ws + WS_RT + RT_BC); const int* TOPE = (const int*)(ws + WS_RT + RT_TOPE);
                int* ROW_TOK = (int*)(ws + WS_RT + RT_ROWTOK); int* SLOT_ROW = (int*)(ws + WS_RT + RT_SLOTROW); int* TILE_E = (int*)(ws + WS_RT + RT_TILEE); int* META = (int*)(ws + WS_RT + RT_META);
                const bf16* XB = (const bf16*)(ws + WS_XB); bf16* XG = (bf16*)(ws + WS_XG);
                {   const int e = wave; int tot = 0, off = 0;
                    for (int b = ln; b < 256; b += 64) { const int c = BC[b * 8 + e]; tot += c; if (b < vcu) off += c; }
                    tot = wave_sum_i(tot); off = wave_sum_i(off);
                    if (ln == 0) { sm[e] = tot; sm[8 + e] = off; } }
                __syncthreads();
                if (tl == 0) { int p = 0, us = 0; for (int e = 0; e < 8; ++e) { sm[16 + e] = p; sm[32 + e] = us; p += (sm[e] + 255) / 256 * 256; us += sm[e]; } sm[24] = p; }
                __syncthreads();
                if (tl < 128) sm[64 + tl] = TOPE[vcu * 128 + tl];
                __syncthreads();
                if (tl < 128) { const int e = sm[64 + tl]; int rank = 0; for (int i = 0; i < tl; ++i) rank += (sm[64 + i] == e) ? 1 : 0;
                    const int pos = sm[16 + e] + sm[8 + e] + rank; SLOT_ROW[vcu * 128 + tl] = pos; ROW_TOK[pos] = vcu * 64 + (tl >> 1); sm[192 + tl] = pos; }
                __syncthreads();
                for (int i = wave; i < 128; i += 8) { const int pos = sm[192 + i], tok = vcu * 64 + (i >> 1);
                    const uint4* src = (const uint4*)(XB + (size_t)tok * D); uint4* dst = (uint4*)(XG + (size_t)pos * D); dst[ln] = src[ln]; dst[ln + 64] = src[ln + 64]; }
                for (int k = gw; k < 2048; k += NGW) { const int e = k >> 8, j = k & 255, row = sm[16 + e] + sm[e] + j;
                    if (row < sm[17 + e]) { if (ln == 0) ROW_TOK[row] = -1; uint4* dst = (uint4*)(XG + (size_t)row * D); const uint4 zz = {0u, 0u, 0u, 0u}; dst[ln] = zz; dst[ln + 64] = zz; } }
                if (bx == 0) {
                    if (tl < 8) { META[tl] = sm[16 + tl]; META[8 + tl] = sm[16 + tl] - sm[32 + tl]; }
                    if (tl == 8) META[16] = sm[24];
                    if (tl < RMAX / 256) { const int r = tl * 256; int e = 0; for (int x = 1; x < 8; ++x) if (r >= sm[16 + x]) e = x; TILE_E[tl] = e; }
                }
                __syncthreads();
            } break;
            default: {
                const float* XF = (const float*)(ws + WS_XFA); const bf16* YR = (const bf16*)(ws + WS_YR);
                const int* TOPE = (const int*)(ws + WS_RT + RT_TOPE); const float* GATE = (const float*)(ws + WS_RT + RT_GATE); const int* SLOT_ROW = (const int*)(ws + WS_RT + RT_SLOTROW); const int* META = (const int*)(ws + WS_RT + RT_META);
                const float* g = cx.in[52]; const float* b = cx.in[53];
                for (int t = gw; t < M; t += NGW) {
                    const int e0 = TOPE[2 * t], e1 = TOPE[2 * t + 1]; const float g0 = GATE[2 * t], g1 = GATE[2 * t + 1];
                    const bf16* y0 = YR + (size_t)(SLOT_ROW[2 * t] - META[8 + e0]) * D; const bf16* y1 = YR + (size_t)(SLOT_ROW[2 * t + 1] - META[8 + e1]) * D;
                    float4 v[4]; float sum = 0.f;
#pragma unroll
                    for (int j = 0; j < 4; ++j) { const int col = 4 * (ln + 64 * j); const float4 x = *(const float4*)(XF + (size_t)t * D + col);
                        const uint2 a0 = *(const uint2*)(y0 + col), a1 = *(const uint2*)(y1 + col);
                        v[j].x = ALPHA * x.x + g0 * __uint_as_float(a0.x << 16) + g1 * __uint_as_float(a1.x << 16);
                        v[j].y = ALPHA * x.y + g0 * __uint_as_float(a0.x & 0xffff0000u) + g1 * __uint_as_float(a1.x & 0xffff0000u);
                        v[j].z = ALPHA * x.z + g0 * __uint_as_float(a0.y << 16) + g1 * __uint_as_float(a1.y << 16);
                        v[j].w = ALPHA * x.w + g0 * __uint_as_float(a0.y & 0xffff0000u) + g1 * __uint_as_float(a1.y & 0xffff0000u);
                        sum += (v[j].x + v[j].y) + (v[j].z + v[j].w); }
                    const float mean = wave_sum(sum) * (1.f / D); float q = 0.f;
#pragma unroll
                    for (int j = 0; j < 4; ++j) { v[j].x -= mean; v[j].y -= mean; v[j].z -= mean; v[j].w -= mean; q += (v[j].x * v[j].x + v[j].y * v[j].y) + (v[j].z * v[j].z + v[j].w * v[j].w); }
                    const float rstd = 1.f / sqrtf(wave_sum(q) * (1.f / D) + 1e-5f);
#pragma unroll
                    for (int j = 0; j < 4; ++j) { const int col = 4 * (ln + 64 * j); const float4 gg = *(const float4*)(g + col), bb = *(const float4*)(b + col);
                        float4 o; o.x = v[j].x * rstd * gg.x + bb.x; o.y = v[j].y * rstd * gg.y + bb.y; o.z = v[j].z * rstd * gg.z + bb.z; o.w = v[j].w * rstd * gg.w + bb.w;
                        *(float4*)(cx.out + (size_t)t * D + col) = o; }
                }
            } break;
        }
        if (st.i(F_SYNC) && s + 1 < ph_hi) xcd_barrier(bar);
    }
}
}

extern "C" void kernel_launch(void* const* d_in, const int* in_sizes, int n_in, void* d_out, int out_size, void* d_ws, size_t ws_size, hipStream_t stream) {
    if (n_in != 54 || ws_size < WS_END) { fprintf(stderr, "kernel_launch: unexpected n_in %d / ws_size %zu (need %zu)\n", n_in, ws_size, (size_t)WS_END); return; }
    static int grid = 0;
    if (grid == 0) {
        int dev = 0, cus = 0;
        if (hipGetDevice(&dev) != hipSuccess || hipDeviceGetAttribute(&cus, hipDeviceAttributeMultiprocessorCount, dev) != hipSuccess) { fprintf(stderr, "kernel_launch: device query failed\n"); grid = -1; return; }
        if (hipFuncSetAttribute((const void*)mega, hipFuncAttributeMaxDynamicSharedMemorySize, LDS_BYTES) != hipSuccess) { fprintf(stderr, "kernel_launch: hipFuncSetAttribute failed\n"); grid = -1; return; }
        (void)hipGetLastError();
        grid = cus;
        if (grid != 256) fprintf(stderr, "kernel_launch: %d CUs (expected 256)\n", grid);
    }
    if (grid < 0) return;
    (void)hipMemsetAsync((unsigned char*)d_ws + WS_CTL, 0, 64 * 1024, stream);
    MArgs a{};
    for (int i = 0; i < 54; ++i) a.in[i] = (const float*)d_in[i];
    a.out = (float*)d_out; a.ws = (unsigned char*)d_ws;
    a.ph_lo = 0; a.ph_hi = N_STEPS; a.li = 0;
    hipLaunchKernelGGL(mega, dim3(grid), dim3(NWAVES * 64), LDS_BYTES, stream, a);
}
```

```cpp
#include <hip/hip_runtime.h>
#include <cstdio>
#include <cstdint>
#include <cstddef>

typedef unsigned short bf16;
#define LAS __attribute__((address_space(3)))

namespace {
constexpr int M = 16384, D = 1024;
constexpr int NP0 = 3584, NP1 = 4352;
constexpr float ALPHA = 1.4142135623730951f;
constexpr int RMAX = 34816;
constexpr size_t MiB = 1ull << 20;
constexpr size_t WS_CTL = 0, WS_XFA = 1 * MiB, WS_XB = 65 * MiB, WS_P = 97 * MiB, WS_OMIX = 233 * MiB, WS_SCR = 281 * MiB, WS_END = 433 * MiB;

__device__ __forceinline__ float bf2f(bf16 v) { return __uint_as_float(((unsigned)v) << 16); }
__device__ __forceinline__ bf16 f2bf(float f) { unsigned u = __float_as_uint(f); u += 0x7fffu + ((u >> 16) & 1u); return (bf16)(u >> 16); }
__device__ __forceinline__ float sigm(float x) { return 1.f / (1.f + __expf(-x)); }
__device__ __forceinline__ float tanh_fast(float x) { return 1.f - 2.f / (__expf(2.f * x) + 1.f); }
__device__ __forceinline__ float siluf(float x) { return x * sigm(x); }
__device__ __forceinline__ void unpack8(const uint4 u, float (&f)[8]) {
    f[0] = __uint_as_float(u.x << 16); f[1] = __uint_as_float(u.x & 0xffff0000u); f[2] = __uint_as_float(u.y << 16); f[3] = __uint_as_float(u.y & 0xffff0000u);
    f[4] = __uint_as_float(u.z << 16); f[5] = __uint_as_float(u.z & 0xffff0000u); f[6] = __uint_as_float(u.w << 16); f[7] = __uint_as_float(u.w & 0xffff0000u);
}
__device__ __forceinline__ unsigned pk2(float lo, float hi) { return (unsigned)f2bf(lo) | ((unsigned)f2bf(hi) << 16); }
__device__ __forceinline__ float wave_sum(float v) {
#pragma unroll
    for (int o = 1; o < 64; o <<= 1) v += __shfl_xor(v, o);
    return v;
}
__device__ __forceinline__ float wave_max(float v) {
#pragma unroll
    for (int o = 1; o < 64; o <<= 1) v = fmaxf(v, __shfl_xor(v, o));
    return v;
}

__device__ __forceinline__ void moba_kmean_item(int idx, const bf16* P, float* KM) {
    const int d = idx & 63, j = (idx >> 6) & 63, h = idx >> 12;
    float s = 0.f;
    for (int i = 0; i < 256; ++i) s += bf2f(P[(size_t)(j * 256 + i) * NP1 + 3072 + h * 64 + d]);
    KM[idx] = s * (1.f / 256.f);
}

constexpr int RW_J = 128, RW_SEG = 128;
typedef short bf16x8_t __attribute__((ext_vector_type(8)));
typedef float f32x4_t __attribute__((ext_vector_type(4)));
typedef unsigned u32x4_t __attribute__((ext_vector_type(4)));
typedef unsigned u32x2_t __attribute__((ext_vector_type(2)));
constexpr int RP_PS = 0, RP_XL = 65536, RP_XLD = 264;
__device__ __forceinline__ void rwkv_wlr_build(int idx, const float* w2, const float* a2, const float* g2, bf16* WLR) {
    const int e = idx & 7, lane = (idx >> 3) & 63, f = (idx >> 9) & 31, h = idx >> 14, lr = lane & 15, lq = lane >> 4;
    const float* Wm; int nt, kb;
    if (f < 8) { Wm = w2; nt = f >> 1; kb = f & 1; } else if (f < 16) { Wm = a2; nt = (f - 8) >> 1; kb = f & 1; } else { Wm = g2; nt = (f - 16) >> 2; kb = f & 3; }
    WLR[idx] = f2bf(Wm[(size_t)(kb * 32 + 8 * lq + e) * 512 + h * 64 + 16 * nt + lr]);
}
__device__ __forceinline__ void rwkv_prep_group(int t0, int tl, LAS unsigned char* lds, const bf16* WLR, const float* w0, const float* a0, const float* kkw, const float* kaw, const float* rkw,
                                                const bf16* P, const float* mu, float* VEC, bf16* G, float* BON) {
    LAS float* ps = (LAS float*)(lds + RP_PS); LAS bf16* xl = (LAS bf16*)(lds + RP_XL);
    const int wv = tl >> 6, ln = tl & 63, lr = ln & 15, lq = ln >> 4, h = wv;
#pragma unroll
    for (int i = 0; i < 5; ++i) { const int task = tl + 512 * i, t = task / 160, oc = task % 160, c = oc < 128 ? oc * 8 : 1536 + (oc - 128) * 8, tt = t0 + t;
        float p[8], pp[8]; unpack8(*(const uint4*)(P + (size_t)tt * NP0 + 1792 + c), p);
        if (tt > 0) unpack8(*(const uint4*)(P + (size_t)(tt - 1) * NP0 + 1792 + c), pp); else {
#pragma unroll
            for (int e = 0; e < 8; ++e) pp[e] = 0.f; }
        const f32x4_t m0 = *(const f32x4_t*)(mu + c), m1 = *(const f32x4_t*)(mu + c + 4);
        float v[8];
#pragma unroll
        for (int e = 0; e < 8; ++e) v[e] = p[e] + (e < 4 ? m0[e] : m1[e - 4]) * (pp[e] - p[e]);
        if (oc < 128) { *(LAS f32x4_t*)(ps + t * 1024 + c) = (f32x4_t){v[0], v[1], v[2], v[3]}; *(LAS f32x4_t*)(ps + t * 1024 + c + 4) = (f32x4_t){v[4], v[5], v[6], v[7]}; }
        else { const int xc = c - 1536;
#pragma unroll
            for (int e = 0; e < 8; ++e) v[e] = (xc < 64) ? tanh_fast(v[e]) : (xc < 128 ? v[e] : sigm(v[e]));
            *(LAS u32x4_t*)(xl + t * RP_XLD + xc) = (u32x4_t){pk2(v[0], v[1]), pk2(v[2], v[3]), pk2(v[4], v[5]), pk2(v[6], v[7])}; } }
    __syncthreads();
    f32x4_t aw[4], aa[4], ag[4];
#pragma unroll
    for (int nt = 0; nt < 4; ++nt) { aw[nt] = (f32x4_t){0.f, 0.f, 0.f, 0.f}; aa[nt] = aw[nt]; ag[nt] = aw[nt]; }
    const bf16x8_t* wl = (const bf16x8_t*)WLR + (size_t)h * 32 * 64 + ln;
#pragma unroll
    for (int kb = 0; kb < 2; ++kb) { const bf16x8_t xw = *(const LAS bf16x8_t*)(xl + lr * RP_XLD + kb * 32 + 8 * lq), xa = *(const LAS bf16x8_t*)(xl + lr * RP_XLD + 64 + kb * 32 + 8 * lq);
#pragma unroll
        for (int nt = 0; nt < 4; ++nt) { aw[nt] = __builtin_amdgcn_mfma_f32_16x16x32_bf16(xw, wl[(nt * 2 + kb) * 64], aw[nt], 0, 0, 0); aa[nt] = __builtin_amdgcn_mfma_f32_16x16x32_bf16(xa, wl[(8 + nt * 2 + kb) * 64], aa[nt], 0, 0, 0); } }
#pragma unroll
    for (int kb = 0; kb < 4; ++kb) { const bf16x8_t xg = *(const LAS bf16x8_t*)(xl + lr * RP_XLD + 128 + kb * 32 + 8 * lq);
#pragma unroll
        for (int nt = 0; nt < 4; ++nt) ag[nt] = __builtin_amdgcn_mfma_f32_16x16x32_bf16(xg, wl[(16 + nt * 4 + kb) * 64], ag[nt], 0, 0, 0); }
    float w0c[4], a0c[4], kkc[4], kac[4], rkc[4];
#pragma unroll
    for (int nt = 0; nt < 4; ++nt) { const int c = h * 64 + 16 * nt + lr; w0c[nt] = w0[c]; a0c[nt] = a0[c]; kkc[nt] = kkw[c]; kac[nt] = kaw[c]; rkc[nt] = rkw[c]; }
#pragma unroll
    for (int r = 0; r < 4; ++r) { const int t = 4 * lq + r, tt = t0 + t;
        float a[4], k2[4], kr[4], ss = 0.f, bon = 0.f;
#pragma unroll
        for (int nt = 0; nt < 4; ++nt) { const int c = h * 64 + 16 * nt + lr; a[nt] = sigm(aa[nt][r] + a0c[nt]);
            const float rr = ps[t * 1024 + c], k = ps[t * 1024 + 512 + c];
            kr[nt] = k * kkc[nt]; ss += kr[nt] * kr[nt]; k2[nt] = k * (1.f + (a[nt] - 1.f) * kac[nt]); bon += rr * k2[nt] * rkc[nt]; }
        ss += __shfl_xor(ss, 1); ss += __shfl_xor(ss, 2); ss += __shfl_xor(ss, 4); ss += __shfl_xor(ss, 8);
        bon += __shfl_xor(bon, 1); bon += __shfl_xor(bon, 2); bon += __shfl_xor(bon, 4); bon += __shfl_xor(bon, 8);
        const float inv = 1.f / sqrtf(fmaxf(ss, 1e-24f));
        float* ve = VEC + ((size_t)tt * 8 + h) * 256;
#pragma unroll
        for (int nt = 0; nt < 4; ++nt) { const int l = 16 * nt + lr; const float kk = kr[nt] * inv;
            ve[l] = k2[nt]; ve[64 + l] = __expf(-0.6065306597126334f * sigm(aw[nt][r] + w0c[nt])); ve[128 + l] = kk; ve[192 + l] = kk * a[nt];
            G[(size_t)tt * 512 + h * 64 + l] = f2bf(ag[nt][r]); }
        if (lr == 0) BON[tt * 8 + h] = bon; }
    __syncthreads();
}
template <int I> __device__ __forceinline__ float row_share(float x) { return __uint_as_float((unsigned)__builtin_amdgcn_update_dpp(0, (int)__float_as_uint(x), 0x150 + I, 0xf, 0xf, true)); }
#define RW_FOR16(M, Q) M(Q, 0) M(Q, 1) M(Q, 2) M(Q, 3) M(Q, 4) M(Q, 5) M(Q, 6) M(Q, 7) M(Q, 8) M(Q, 9) M(Q, 10) M(Q, 11) M(Q, 12) M(Q, 13) M(Q, 14) M(Q, 15)
#define RW_FOR64(M) RW_FOR16(M, 0) RW_FOR16(M, 1) RW_FOR16(M, 2) RW_FOR16(M, 3)
#define RW_FMAC_DPP(ACC, X, Y, I) asm("v_fmac_f32_dpp %0, %1, %2 row_newbcast:" #I " row_mask:0xf bank_mask:0xf bound_ctrl:1" : "+v"(ACC) : "v"(X), "v"(Y))
#define RW_MULIP_DPP(SV, X, I) asm("v_mul_f32_dpp %0, %1, %0 row_newbcast:" #I " row_mask:0xf bank_mask:0xf bound_ctrl:1" : "+v"(SV) : "v"(X))
template <bool ISM>
__device__ __forceinline__ float rwkv_step(float (&S)[64], const float (&k2q)[4], const float (&wq)[4], const float (&kkq)[4], const float (&bq)[4], const float (&rq)[4], float vcur) {
    float a[4] = {0.f, 0.f, 0.f, 0.f};
#define RW_DOT(Q, I) RW_FMAC_DPP(a[(I) & 3], kkq[Q], S[16 * (Q) + (I)], I);
    RW_FOR64(RW_DOT)
#undef RW_DOT
    const float nS = -((a[0] + a[1]) + (a[2] + a[3]));
    float o[4] = {0.f, 0.f, 0.f, 0.f};
#define RW_UPD(Q, I) { RW_MULIP_DPP(S[16 * (Q) + (I)], wq[Q], I); RW_FMAC_DPP(S[16 * (Q) + (I)], bq[Q], nS, I); if (!ISM) { RW_FMAC_DPP(S[16 * (Q) + (I)], k2q[Q], vcur, I); } RW_FMAC_DPP(o[(I) & 3], rq[Q], S[16 * (Q) + (I)], I); }
    RW_FOR64(RW_UPD)
#undef RW_UPD
    return (o[0] + o[1]) + (o[2] + o[3]);
}
template <bool ISM>
__device__ __forceinline__ void rwkv_scan_half(int item, int ln, LAS float* stg, const bf16* P, const float* mu, const float* VEC, float* OUT, float* ENDST) {
    const int h = item & 7, j = item >> 3, t0 = j * RW_SEG, lr = ln & 15;
    float S[64];
#pragma unroll
    for (int k = 0; k < 64; ++k) S[k] = (ISM && k == ln) ? 1.f : 0.f;
    const float mur = mu[h * 64 + ln], muv = mu[1024 + h * 64 + ln];
    const bf16* Pr = P + 1792 + h * 64 + ln;
    float rp = t0 > 0 ? bf2f(Pr[(size_t)(t0 - 1) * NP0]) : 0.f, vp = (!ISM && t0 > 0) ? bf2f(Pr[(size_t)(t0 - 1) * NP0 + 1024]) : 0.f;
    f32x4_t vv[8]; bf16 pr[8], pv[8];
#pragma unroll
    for (int u = 0; u < 8; ++u) { const int t = t0 + u; vv[u] = *(const f32x4_t*)(VEC + ((size_t)t * 8 + h) * 256 + 4 * ln); pr[u] = Pr[(size_t)t * NP0]; pv[u] = ISM ? (bf16)0 : Pr[(size_t)t * NP0 + 1024]; }
#pragma unroll 1
    for (int g = 0; g < RW_SEG / 8; ++g) {
#pragma unroll
        for (int u = 0; u < 8; ++u) { *(LAS f32x4_t*)(stg + u * 384 + 4 * ln) = vv[u];
            const float prf = bf2f(pr[u]); stg[u * 384 + 256 + ln] = prf + mur * (rp - prf); rp = prf;
            if (!ISM) { const float pvf = bf2f(pv[u]); stg[u * 384 + 320 + ln] = pvf + muv * (vp - pvf); vp = pvf; } }
        if (g + 1 < RW_SEG / 8) {
#pragma unroll
            for (int u = 0; u < 8; ++u) { const int t = t0 + (g + 1) * 8 + u; vv[u] = *(const f32x4_t*)(VEC + ((size_t)t * 8 + h) * 256 + 4 * ln); pr[u] = Pr[(size_t)t * NP0]; pv[u] = ISM ? (bf16)0 : Pr[(size_t)t * NP0 + 1024]; } }
        asm volatile("s_waitcnt lgkmcnt(0)" ::: "memory");
        float A_k2[4], A_w[4], A_kk[4], A_b[4], A_r[4], B_k2[4], B_w[4], B_kk[4], B_b[4], B_r[4];
#pragma unroll
        for (int q = 0; q < 4; ++q) { const LAS float* sp = stg + 16 * q + lr; A_k2[q] = sp[0]; A_w[q] = sp[64]; A_kk[q] = sp[128]; A_b[q] = sp[192]; A_r[q] = sp[256]; }
#pragma unroll 1
        for (int u = 0; u < 8; u += 2) {
#pragma unroll
            for (int q = 0; q < 4; ++q) { const LAS float* sp = stg + (u + 1) * 384 + 16 * q + lr; B_k2[q] = sp[0]; B_w[q] = sp[64]; B_kk[q] = sp[128]; B_b[q] = sp[192]; B_r[q] = sp[256]; }
            const float v0 = ISM ? 0.f : stg[u * 384 + 320 + ln], v1 = ISM ? 0.f : stg[(u + 1) * 384 + 320 + ln];
            const float o0 = rwkv_step<ISM>(S, A_k2, A_w, A_kk, A_b, A_r, v0);
            OUT[(size_t)(t0 + g * 8 + u) * 512 + h * 64 + ln] = o0;
#pragma unroll
            for (int q = 0; q < 4; ++q) { const LAS float* sp = stg + ((u + 2) & 7) * 384 + 16 * q + lr; A_k2[q] = sp[0]; A_w[q] = sp[64]; A_kk[q] = sp[128]; A_b[q] = sp[192]; A_r[q] = sp[256]; }
            const float o1 = rwkv_step<ISM>(S, B_k2, B_w, B_kk, B_b, B_r, v1);
            OUT[(size_t)(t0 + g * 8 + u + 1) * 512 + h * 64 + ln] = o1;
        }
    }
    float* sl = ENDST + ((size_t)(j * 8 + h) * 64 + ln) * 64;
#pragma unroll
    for (int q = 0; q < 16; ++q) *(f32x4_t*)(sl + 4 * q) = (f32x4_t){S[4 * q], S[4 * q + 1], S[4 * q + 2], S[4 * q + 3]};
}
__device__ __forceinline__ void rwkv_combine_row(int row, int ln, float* SLOC, const float* MEND) {
    const int h = row >> 6, v = row & 63;
    float s = 0.f;
    float m[64];
#pragma unroll
    for (int i = 0; i < 64; ++i) m[i] = MEND[((size_t)(0 * 8 + h) * 64 + i) * 64 + ln];
#pragma unroll 1
    for (int j = 0; j < RW_J; ++j) {
        float* slot = SLOC + ((size_t)(j * 8 + h) * 64 + v) * 64 + ln;
        const float l = *slot;
        float mn[64];
        const int jn = (j + 1 < RW_J) ? j + 1 : j;
#pragma unroll
        for (int i = 0; i < 64; ++i) mn[i] = MEND[((size_t)(jn * 8 + h) * 64 + i) * 64 + ln];
        *slot = s;
        float a0 = l, a1 = 0.f;
#pragma unroll
        for (int i = 0; i < 64; i += 2) { a0 += __uint_as_float(__builtin_amdgcn_readlane(__float_as_uint(s), i)) * m[i]; a1 += __uint_as_float(__builtin_amdgcn_readlane(__float_as_uint(s), i + 1)) * m[i + 1]; }
        s = a0 + a1;
#pragma unroll
        for (int i = 0; i < 64; ++i) m[i] = mn[i];
    }
}
__device__ __forceinline__ void rwkv_fin_item(int item, int ln, const bf16* P, const float* mu, const float* ORAW, const float* CB, const float* SINIT, const bf16* G, const float* BON,
                                              const float* lnw, const float* lnb, bf16* OMIX) {
    const int tg = item & 7, h = (item >> 3) & 7, j = item >> 6;
    const int tb = j * RW_SEG + tg * 16, lr = ln & 15, lq = ln >> 4;
    bf16x8_t af[2], bfr[4][2];
#pragma unroll
    for (int kb = 0; kb < 2; ++kb) {
        const float* cp = CB + (size_t)(tb + lr) * 512 + h * 64 + kb * 32 + 8 * lq;
        const f32x4_t x0 = *(const f32x4_t*)cp, x1 = *(const f32x4_t*)(cp + 4);
        af[kb] = (bf16x8_t){(short)f2bf(x0[0]), (short)f2bf(x0[1]), (short)f2bf(x0[2]), (short)f2bf(x0[3]), (short)f2bf(x1[0]), (short)f2bf(x1[1]), (short)f2bf(x1[2]), (short)f2bf(x1[3])};
#pragma unroll
        for (int nt = 0; nt < 4; ++nt) {
            const float* sp = SINIT + ((size_t)(j * 8 + h) * 64 + nt * 16 + lr) * 64 + kb * 32 + 8 * lq;
            const f32x4_t y0 = *(const f32x4_t*)sp, y1 = *(const f32x4_t*)(sp + 4);
            bfr[nt][kb] = (bf16x8_t){(short)f2bf(y0[0]), (short)f2bf(y0[1]), (short)f2bf(y0[2]), (short)f2bf(y0[3]), (short)f2bf(y1[0]), (short)f2bf(y1[1]), (short)f2bf(y1[2]), (short)f2bf(y1[3])};
        }
    }
    f32x4_t acc[4];
#pragma unroll
    for (int nt = 0; nt < 4; ++nt) { acc[nt] = (f32x4_t){0.f, 0.f, 0.f, 0.f};
#pragma unroll
        for (int kb = 0; kb < 2; ++kb) acc[nt] = __builtin_amdgcn_mfma_f32_16x16x32_bf16(af[kb], bfr[nt][kb], acc[nt], 0, 0, 0); }
#pragma unroll
    for (int r = 0; r < 4; ++r) {
        const int t = tb + 4 * lq + r;
        float o[4]; float sum = 0.f;
#pragma unroll
        for (int nt = 0; nt < 4; ++nt) { o[nt] = acc[nt][r] + ORAW[(size_t)t * 512 + h * 64 + nt * 16 + lr]; sum += o[nt]; }
        sum += __shfl_xor(sum, 1); sum += __shfl_xor(sum, 2); sum += __shfl_xor(sum, 4); sum += __shfl_xor(sum, 8);
        const float mean = sum * (1.f / 64.f); float q = 0.f;
#pragma unroll
        for (int nt = 0; nt < 4; ++nt) { o[nt] -= mean; q += o[nt] * o[nt]; }
        q += __shfl_xor(q, 1); q += __shfl_xor(q, 2); q += __shfl_xor(q, 4); q += __shfl_xor(q, 8);
        const float rstd = 1.f / sqrtf(q * (1.f / 64.f) + 64e-5f);
        const float bon = BON[t * 8 + h];
#pragma unroll
        for (int nt = 0; nt < 4; ++nt) { const int c = h * 64 + nt * 16 + lr;
            const float p = bf2f(P[(size_t)t * NP0 + 1792 + 1024 + c]);
            const float pp = t > 0 ? bf2f(P[(size_t)(t - 1) * NP0 + 1792 + 1024 + c]) : 0.f;
            const float vv = p + mu[1024 + c] * (pp - p);
            OMIX[(size_t)t * 1024 + 512 + c] = f2bf((o[nt] * rstd * lnw[c] + lnb[c] + bon * vv) * bf2f(G[(size_t)t * 512 + c])); }
    }
}

constexpr int GL_LD = 72;
constexpr int GL_BC = 0, GL_WA = 16384, GL_QD = 20480, GL_KD = 29696, GL_KT = 38912, GL_VT = 48128, GL_PM = 66560, GL_SP = 75776, GL_RED = 94208;
__device__ __forceinline__ void gla_decay_cumsum(int n, int h, int tl, LAS unsigned char* lds, const bf16* P, const float* wa2, const float* ba) {
    LAS float* bc = (LAS float*)(lds + GL_BC); LAS float* wa = (LAS float*)(lds + GL_WA);
    for (int i = tl; i < 1024; i += 512) wa[i] = wa2[(i >> 6) * 256 + h * 64 + (i & 63)];
    __syncthreads();
    const int t = tl >> 3, oq = tl & 7; const size_t row = (size_t)n * 64 + t;
    float a[16];
    { const uint4* ap = (const uint4*)(P + row * NP0 + 1536); float f[8]; unpack8(ap[0], f);
#pragma unroll
      for (int e = 0; e < 8; ++e) a[e] = f[e];
      unpack8(ap[1], f);
#pragma unroll
      for (int e = 0; e < 8; ++e) a[8 + e] = f[e]; }
#pragma unroll
    for (int e = 0; e < 8; ++e) { const int d = oq * 8 + e; float s = ba[h * 64 + d];
#pragma unroll
        for (int r = 0; r < 16; ++r) s += a[r] * wa[r * 64 + d];
        bc[t * 64 + d] = (fminf(s, 0.f) - __logf(1.f + __expf(-fabsf(s)))) * (1.f / 16.f); }
    __syncthreads();
    if (tl < 64) { float acc = 0.f;
#pragma unroll 8
        for (int tt = 0; tt < 64; ++tt) { acc += bc[tt * 64 + tl]; bc[tt * 64 + tl] = acc; } }
    __syncthreads();
}
__device__ __forceinline__ void gla_stage_vt(int n, int h, int tl, LAS unsigned char* lds, const bf16* P) {
    LAS bf16* vt = (LAS bf16*)(lds + GL_VT);
    const int t = tl >> 3, oq = tl & 7; const size_t row = (size_t)n * 64 + t;
#pragma unroll
    for (int half = 0; half < 2; ++half) { const int oct = oq + 8 * half; const uint4 u = *(const uint4*)(P + row * NP0 + 512 + h * 128 + oct * 8);
        const unsigned w[4] = {u.x, u.y, u.z, u.w};
#pragma unroll
        for (int e = 0; e < 8; ++e) vt[(oct * 8 + e) * GL_LD + t] = (bf16)((e & 1) ? (w[e >> 1] >> 16) : (w[e >> 1] & 0xffffu)); }
}
__device__ __forceinline__ bf16x8_t lds_frag(const LAS bf16* base, int row, int k0) { return *(const LAS bf16x8_t*)(base + row * GL_LD + k0); }
__device__ __forceinline__ void gla_state_item(int item, int tl, LAS unsigned char* lds, const bf16* P, const float* wa2, const float* ba, float* KVS, float* DEC) {
    const int n = item >> 2, h = item & 3, wv = tl >> 6, ln = tl & 63, lr = ln & 15, lq = ln >> 4;
    gla_decay_cumsum(n, h, tl, lds, P, wa2, ba);
    LAS float* bc = (LAS float*)(lds + GL_BC); LAS bf16* kt = (LAS bf16*)(lds + GL_KT); LAS bf16* vt = (LAS bf16*)(lds + GL_VT);
    { const int t = tl >> 3, oq = tl & 7; const size_t row = (size_t)n * 64 + t; float k[8]; unpack8(*(const uint4*)(P + row * NP0 + 256 + h * 64 + oq * 8), k);
#pragma unroll
      for (int e = 0; e < 8; ++e) { const int d = oq * 8 + e; kt[d * GL_LD + t] = f2bf(k[e] * __expf(bc[63 * 64 + d] - bc[t * 64 + d])); } }
    gla_stage_vt(n, h, tl, lds, P);
    __syncthreads();
    f32x4_t acc[4];
#pragma unroll
    for (int nt = 0; nt < 4; ++nt) acc[nt] = (f32x4_t){0.f, 0.f, 0.f, 0.f};
#pragma unroll
    for (int kb = 0; kb < 2; ++kb) { const bf16x8_t a = lds_frag(vt, 16 * wv + lr, kb * 32 + 8 * lq);
#pragma unroll
        for (int nt = 0; nt < 4; ++nt) acc[nt] = __builtin_amdgcn_mfma_f32_16x16x32_bf16(a, lds_frag(kt, 16 * nt + lr, kb * 32 + 8 * lq), acc[nt], 0, 0, 0); }
    float* kv = KVS + (size_t)(n * 4 + h) * 128 * 64;
#pragma unroll
    for (int nt = 0; nt < 4; ++nt)
#pragma unroll
        for (int r = 0; r < 4; ++r) kv[(16 * wv + 4 * lq + r) * 64 + 16 * nt + lr] = acc[nt][r];
    if (tl < 64) DEC[(n * 4 + h) * 64 + tl] = __expf(bc[63 * 64 + tl]);
    __syncthreads();
}
__device__ __forceinline__ void gla_out_item(int item, int tl, LAS unsigned char* lds, const bf16* P, const float* wa2, const float* ba, const float* KVS, const float* norm_g, bf16* OMIX) {
    const int n = item >> 2, h = item & 3, wv = tl >> 6, ln = tl & 63, lr = ln & 15, lq = ln >> 4;
    gla_decay_cumsum(n, h, tl, lds, P, wa2, ba);
    LAS float* bc = (LAS float*)(lds + GL_BC); LAS bf16* qd = (LAS bf16*)(lds + GL_QD); LAS bf16* kd = (LAS bf16*)(lds + GL_KD); LAS bf16* vt = (LAS bf16*)(lds + GL_VT);
    LAS bf16* pm = (LAS bf16*)(lds + GL_PM); LAS bf16* sp = (LAS bf16*)(lds + GL_SP); LAS float* red = (LAS float*)(lds + GL_RED);
    { const int t = tl >> 3, oq = tl & 7; const size_t row = (size_t)n * 64 + t; float q[8], k[8];
      unpack8(*(const uint4*)(P + row * NP0 + h * 64 + oq * 8), q); unpack8(*(const uint4*)(P + row * NP0 + 256 + h * 64 + oq * 8), k);
      unsigned qw[4], kw[4];
#pragma unroll
      for (int e = 0; e < 8; e += 2) { const float b0 = bc[t * 64 + oq * 8 + e], b1 = bc[t * 64 + oq * 8 + e + 1];
          qw[e >> 1] = (unsigned)f2bf(q[e] * 0.125f * __expf(b0)) | ((unsigned)f2bf(q[e + 1] * 0.125f * __expf(b1)) << 16);
          kw[e >> 1] = (unsigned)f2bf(k[e] * __expf(-b0)) | ((unsigned)f2bf(k[e + 1] * __expf(-b1)) << 16); }
      *(LAS u32x4_t*)(qd + t * GL_LD + oq * 8) = (u32x4_t){qw[0], qw[1], qw[2], qw[3]}; *(LAS u32x4_t*)(kd + t * GL_LD + oq * 8) = (u32x4_t){kw[0], kw[1], kw[2], kw[3]}; }
    gla_stage_vt(n, h, tl, lds, P);
    { const float* kv = KVS + (size_t)(n * 4 + h) * 128 * 64;
#pragma unroll
      for (int i = 0; i < 4; ++i) { const int idx = tl + 512 * i, v = idx >> 4, d4 = idx & 15; const f32x4_t x = *(const f32x4_t*)(kv + v * 64 + d4 * 4);
          *(LAS u32x2_t*)(sp + v * GL_LD + d4 * 4) = (u32x2_t){(unsigned)f2bf(x[0]) | ((unsigned)f2bf(x[1]) << 16), (unsigned)f2bf(x[2]) | ((unsigned)f2bf(x[3]) << 16)}; } }
    __syncthreads();
    const int mt = wv & 3;
    {
        const int nt0 = (wv >> 2) * 2; f32x4_t acc[2] = {(f32x4_t){0.f, 0.f, 0.f, 0.f}, (f32x4_t){0.f, 0.f, 0.f, 0.f}};
#pragma unroll
        for (int kb = 0; kb < 2; ++kb) { const bf16x8_t a = lds_frag(qd, 16 * mt + lr, kb * 32 + 8 * lq);
#pragma unroll
            for (int nn = 0; nn < 2; ++nn) acc[nn] = __builtin_amdgcn_mfma_f32_16x16x32_bf16(a, lds_frag(kd, 16 * (nt0 + nn) + lr, kb * 32 + 8 * lq), acc[nn], 0, 0, 0); }
#pragma unroll
        for (int nn = 0; nn < 2; ++nn)
#pragma unroll
            for (int r = 0; r < 4; ++r) { const int i = 16 * mt + 4 * lq + r, j = 16 * (nt0 + nn) + lr; pm[i * GL_LD + j] = f2bf(j <= i ? acc[nn][r] : 0.f); }
    }
    __syncthreads();
    const int ntb = (wv >> 2) * 4; f32x4_t acc[4];
#pragma unroll
    for (int nn = 0; nn < 4; ++nn) acc[nn] = (f32x4_t){0.f, 0.f, 0.f, 0.f};
#pragma unroll
    for (int kb = 0; kb < 2; ++kb) { const bf16x8_t a1 = lds_frag(pm, 16 * mt + lr, kb * 32 + 8 * lq), a2 = lds_frag(qd, 16 * mt + lr, kb * 32 + 8 * lq);
#pragma unroll
        for (int nn = 0; nn < 4; ++nn) { acc[nn] = __builtin_amdgcn_mfma_f32_16x16x32_bf16(a1, lds_frag(vt, 16 * (ntb + nn) + lr, kb * 32 + 8 * lq), acc[nn], 0, 0, 0);
            acc[nn] = __builtin_amdgcn_mfma_f32_16x16x32_bf16(a2, lds_frag(sp, 16 * (ntb + nn) + lr, kb * 32 + 8 * lq), acc[nn], 0, 0, 0); } }
#pragma unroll
    for (int r = 0; r < 4; ++r) { float ss = 0.f;
#pragma unroll
        for (int nn = 0; nn < 4; ++nn) ss += acc[nn][r] * acc[nn][r];
        ss += __shfl_xor(ss, 1); ss += __shfl_xor(ss, 2); ss += __shfl_xor(ss, 4); ss += __shfl_xor(ss, 8);
        if (lr == 0) red[(16 * mt + 4 * lq + r) * 2 + (wv >> 2)] = ss; }
    __syncthreads();
#pragma unroll
    for (int r = 0; r < 4; ++r) { const int i = 16 * mt + 4 * lq + r; const float rstd = 1.f / sqrtf((red[i * 2] + red[i * 2 + 1]) * (1.f / 128.f) + 1e-5f);
        const size_t row = (size_t)n * 64 + i;
#pragma unroll
        for (int nn = 0; nn < 4; ++nn) { const int v = 16 * (ntb + nn) + lr; const float g = bf2f(P[row * NP0 + 1024 + h * 128 + v]);
            OMIX[row * 1024 + h * 128 + v] = f2bf(acc[nn][r] * rstd * norm_g[h * 128 + v] * (g / (1.f + __expf(-g)))); } }
    __syncthreads();
}
__device__ __forceinline__ void gla_state_scan(int e, float* KVS, const float* DEC) {
    const int h = e >> 13, vd = e & 8191, d = e & 63; float s = 0.f;
#pragma unroll 16
    for (int n = 0; n < 256; ++n) { float* p = KVS + (size_t)(n * 4 + h) * 8192 + vd; const float kv = *p, dec = DEC[(n * 4 + h) * 64 + d]; *p = s; s = dec * s + kv; }
}

constexpr int SD_LD = 136;
constexpr int SD_ACS = 0, SD_T0 = 4096, SD_T1 = SD_T0 + 128 * SD_LD * 2, SD_X = SD_T1 + 128 * SD_LD * 2, SD_PV = SD_X + 64 * SD_LD * 2;
static_assert(SD_PV + 64 * SD_LD * 2 <= 131072, "SSD LDS");
__device__ __forceinline__ void ssd_prep_oct(int idx, const bf16* P, const float* conv_w, const float* conv_b, bf16* XBC) {
    const int t = idx / 192, c0 = (idx % 192) * 8;
    float y[8];
#pragma unroll
    for (int e = 0; e < 8; ++e) y[e] = conv_b[c0 + e];
#pragma unroll
    for (int i = 0; i < 4; ++i) { const int tt = t - 3 + i; if (tt >= 0) { float x[8]; unpack8(*(const uint4*)(P + (size_t)tt * NP1 + 1024 + c0), x);
#pragma unroll
        for (int e = 0; e < 8; ++e) y[e] += conv_w[i * 1536 + c0 + e] * x[e]; } }
    unsigned w[4];
#pragma unroll
    for (int e = 0; e < 8; e += 2) { const float a = y[e] / (1.f + __expf(-y[e])), b = y[e + 1] / (1.f + __expf(-y[e + 1])); w[e >> 1] = (unsigned)f2bf(a) | ((unsigned)f2bf(b) << 16); }
    *(uint4*)(XBC + (size_t)t * 1536 + c0) = make_uint4(w[0], w[1], w[2], w[3]);
}
__device__ __forceinline__ void ssd_dt_item2(int idx, const bf16* P, const float* dt_bias, const float* a_log, float* DT, float* AA) {
    const int t = idx >> 4, h = idx & 15;
    const float x = bf2f(P[(size_t)t * NP1 + 4096 + h]) + dt_bias[h];
    const float dt = x > 20.f ? x : __logf(1.f + __expf(x));
    DT[idx] = dt; AA[idx] = -dt * __expf(a_log[h]);
}
__device__ __forceinline__ void ssd_acs(int c, int g, int wv, int ln, LAS float* acs, const float* AA) {
    const int h = g * 8 + wv, t0 = c * 128;
    const float a0 = AA[(size_t)(t0 + 2 * ln) * 16 + h], a1 = AA[(size_t)(t0 + 2 * ln + 1) * 16 + h];
    float s = a0 + a1;
#pragma unroll
    for (int o = 1; o < 64; o <<= 1) { const float u = __shfl_up(s, o); if (ln >= o) s += u; }
    acs[wv * 128 + 2 * ln] = s - a1; acs[wv * 128 + 2 * ln + 1] = s;
}
__device__ __forceinline__ bf16x8_t sd_frag(const LAS bf16* base, int row, int k0) { return *(const LAS bf16x8_t*)(base + row * SD_LD + k0); }
__device__ __forceinline__ void ssd_state_item(int item, int tl, LAS unsigned char* lds, const bf16* XBC, const float* DT, const float* AA, float* ST, float* CDEC) {
    const int c = item >> 1, g = item & 1, wv = tl >> 6, ln = tl & 63, lr = ln & 15, lq = ln >> 4, t0 = c * 128;
    LAS float* acs = (LAS float*)(lds + SD_ACS); LAS bf16* bt = (LAS bf16*)(lds + SD_T0); LAS bf16* xdt = (LAS bf16*)(lds + SD_X);
    ssd_acs(c, g, wv, ln, acs, AA);
#pragma unroll
    for (int i = 0; i < 4; ++i) { const int task = tl + 512 * i, sidx = task >> 4, noct = task & 15; const uint4 u = *(const uint4*)(XBC + (size_t)(t0 + sidx) * 1536 + 1024 + g * 128 + noct * 8);
        const unsigned w[4] = {u.x, u.y, u.z, u.w};
#pragma unroll
        for (int e = 0; e < 8; ++e) bt[(noct * 8 + e) * SD_LD + sidx] = (bf16)((e & 1) ? (w[e >> 1] >> 16) : (w[e >> 1] & 0xffffu)); }
    __syncthreads();
#pragma unroll 1
    for (int hh = 0; hh < 8; ++hh) {
        const int h = g * 8 + hh; const float alast = acs[hh * 128 + 127];
#pragma unroll
        for (int i = 0; i < 2; ++i) { const int task = tl + 512 * i, sidx = task >> 3, poct = task & 7; float x[8]; unpack8(*(const uint4*)(XBC + (size_t)(t0 + sidx) * 1536 + h * 64 + poct * 8), x);
            const float f = DT[(size_t)(t0 + sidx) * 16 + h] * __expf(alast - acs[hh * 128 + sidx]);
#pragma unroll
            for (int e = 0; e < 8; ++e) xdt[(poct * 8 + e) * SD_LD + sidx] = f2bf(x[e] * f); }
        __syncthreads();
        const int mt = wv & 3, ntb = (wv >> 2) * 4; f32x4_t acc[4];
#pragma unroll
        for (int nn = 0; nn < 4; ++nn) acc[nn] = (f32x4_t){0.f, 0.f, 0.f, 0.f};
#pragma unroll
        for (int kb = 0; kb < 4; ++kb) { const bf16x8_t a = sd_frag(xdt, 16 * mt + lr, kb * 32 + 8 * lq);
#pragma unroll
            for (int nn = 0; nn < 4; ++nn) acc[nn] = __builtin_amdgcn_mfma_f32_16x16x32_bf16(a, sd_frag(bt, 16 * (ntb + nn) + lr, kb * 32 + 8 * lq), acc[nn], 0, 0, 0); }
        float* st = ST + (size_t)(c * 16 + h) * 8192;
#pragma unroll
        for (int nn = 0; nn < 4; ++nn)
#pragma unroll
            for (int r = 0; r < 4; ++r) st[(16 * mt + 4 * lq + r) * 128 + 16 * (ntb + nn) + lr] = acc[nn][r];
        if (tl == 0) CDEC[c * 16 + h] = __expf(alast);
        __syncthreads();
    }
}
__device__ __forceinline__ void ssd_state_scan(int e, float* ST, const float* CDEC) {
    const int h = e >> 13; float s = 0.f;
#pragma unroll 16
    for (int c = 0; c < 128; ++c) { float* p = ST + (size_t)c * 131072 + e; const float st = *p, dec = CDEC[c * 16 + h]; *p = s; s = dec * s + st; }
}
__device__ __forceinline__ void ssd_out_item(int item, int tl, LAS unsigned char* lds, const bf16* P, const bf16* XBC, const float* DT, const float* AA, const float* ST, const float* d_skip, const float* norm_g, bf16* OMIX) {
    const int c = item >> 1, g = item & 1, wv = tl >> 6, ln = tl & 63, lr = ln & 15, lq = ln >> 4, t0 = c * 128;
    LAS float* acs = (LAS float*)(lds + SD_ACS); LAS bf16* cc = (LAS bf16*)(lds + SD_T0); LAS bf16* bb = (LAS bf16*)(lds + SD_T1); LAS bf16* pw = bb;
    LAS bf16* xdt = (LAS bf16*)(lds + SD_X); LAS bf16* pv = (LAS bf16*)(lds + SD_PV);
    ssd_acs(c, g, wv, ln, acs, AA);
#pragma unroll
    for (int i = 0; i < 4; ++i) { const int task = tl + 512 * i, sidx = task >> 4, noct = task & 15; const bf16* src = XBC + (size_t)(t0 + sidx) * 1536 + 1024 + g * 128 + noct * 8;
        const uint4 ub = *(const uint4*)src, uc = *(const uint4*)(src + 256);
        *(LAS u32x4_t*)(bb + sidx * SD_LD + noct * 8) = (u32x4_t){ub.x, ub.y, ub.z, ub.w}; *(LAS u32x4_t*)(cc + sidx * SD_LD + noct * 8) = (u32x4_t){uc.x, uc.y, uc.z, uc.w}; }
    __syncthreads();
    bf16x8_t cf[4]; f32x4_t cb[8];
#pragma unroll
    for (int kb = 0; kb < 4; ++kb) cf[kb] = sd_frag(cc, 16 * wv + lr, kb * 32 + 8 * lq);
#pragma unroll
    for (int nt = 0; nt < 8; ++nt) { cb[nt] = (f32x4_t){0.f, 0.f, 0.f, 0.f};
#pragma unroll
        for (int kb = 0; kb < 4; ++kb) cb[nt] = __builtin_amdgcn_mfma_f32_16x16x32_bf16(cf[kb], sd_frag(bb, 16 * nt + lr, kb * 32 + 8 * lq), cb[nt], 0, 0, 0); }
    __syncthreads();
    float ss[4] = {0.f, 0.f, 0.f, 0.f};
#pragma unroll 1
    for (int hh = 0; hh < 8; ++hh) {
        const int h = g * 8 + hh;
#pragma unroll
        for (int i = 0; i < 2; ++i) { const int task = tl + 512 * i, sidx = task >> 3, poct = task & 7; float x[8]; unpack8(*(const uint4*)(XBC + (size_t)(t0 + sidx) * 1536 + h * 64 + poct * 8), x);
            const float f = DT[(size_t)(t0 + sidx) * 16 + h];
#pragma unroll
            for (int e = 0; e < 8; ++e) xdt[(poct * 8 + e) * SD_LD + sidx] = f2bf(x[e] * f); }
        { const float* st = ST + (size_t)(c * 16 + h) * 8192;
#pragma unroll
          for (int i = 0; i < 4; ++i) { const int idx = tl + 512 * i, p = idx >> 5, n4 = idx & 31; const f32x4_t x = *(const f32x4_t*)(st + p * 128 + n4 * 4);
              *(LAS u32x2_t*)(pv + p * SD_LD + n4 * 4) = (u32x2_t){(unsigned)f2bf(x[0]) | ((unsigned)f2bf(x[1]) << 16), (unsigned)f2bf(x[2]) | ((unsigned)f2bf(x[3]) << 16)}; } }
        float al[4];
#pragma unroll
        for (int r = 0; r < 4; ++r) al[r] = acs[hh * 128 + 16 * wv + 4 * lq + r];
#pragma unroll
        for (int nt = 0; nt < 8; ++nt) { const int sidx = 16 * nt + lr; const float as = acs[hh * 128 + sidx];
#pragma unroll
            for (int r = 0; r < 4; ++r) { const int l = 16 * wv + 4 * lq + r; pw[l * SD_LD + sidx] = f2bf(sidx <= l ? cb[nt][r] * __expf(al[r] - as) : 0.f); } }
        __syncthreads();
        f32x4_t yd[4], yo[4];
#pragma unroll
        for (int nn = 0; nn < 4; ++nn) { yd[nn] = (f32x4_t){0.f, 0.f, 0.f, 0.f}; yo[nn] = (f32x4_t){0.f, 0.f, 0.f, 0.f}; }
#pragma unroll
        for (int kb = 0; kb < 4; ++kb) { const bf16x8_t a = sd_frag(pw, 16 * wv + lr, kb * 32 + 8 * lq);
#pragma unroll
            for (int nn = 0; nn < 4; ++nn) { yd[nn] = __builtin_amdgcn_mfma_f32_16x16x32_bf16(a, sd_frag(xdt, 16 * nn + lr, kb * 32 + 8 * lq), yd[nn], 0, 0, 0);
                yo[nn] = __builtin_amdgcn_mfma_f32_16x16x32_bf16(cf[kb], sd_frag(pv, 16 * nn + lr, kb * 32 + 8 * lq), yo[nn], 0, 0, 0); } }
        const float dsk = d_skip[h];
#pragma unroll
        for (int r = 0; r < 4; ++r) { const size_t row = (size_t)t0 + 16 * wv + 4 * lq + r; const float ea = __expf(al[r]);
#pragma unroll
            for (int nn = 0; nn < 4; ++nn) { const int ch = h * 64 + 16 * nn + lr;
                const float x = bf2f(XBC[row * 1536 + ch]), z = bf2f(P[row * NP1 + ch]);
                const float val = (yd[nn][r] + ea * yo[nn][r] + dsk * x) * (z / (1.f + __expf(-z)));
                ss[r] += val * val; OMIX[row * 1536 + ch] = f2bf(val); } }
        __syncthreads();
    }
#pragma unroll
    for (int r = 0; r < 4; ++r) { float q = ss[r]; q += __shfl_xor(q, 1); q += __shfl_xor(q, 2); q += __shfl_xor(q, 4); q += __shfl_xor(q, 8); ss[r] = 1.f / sqrtf(q * (1.f / 512.f) + 1e-5f); }
#pragma unroll 1
    for (int hh = 0; hh < 8; ++hh)
#pragma unroll
        for (int r = 0; r < 4; ++r) { const size_t row = (size_t)t0 + 16 * wv + 4 * lq + r;
#pragma unroll
            for (int nn = 0; nn < 4; ++nn) { const int ch = (g * 8 + hh) * 64 + 16 * nn + lr; bf16* o = OMIX + row * 1536 + ch; *o = f2bf(bf2f(*o) * ss[r] * norm_g[ch]); } }
    __syncthreads();
}

constexpr int MB_QS = 1024, MB_KS = MB_QS + 64 * 72 * 2, MB_VT = MB_KS + 256 * 72 * 2, MB_PM = MB_VT + 64 * 264 * 2, MB_RED = MB_PM + 64 * 264 * 2, MB_PREF = MB_RED + 1024;
static_assert(MB_PREF + 520 * 4 <= 131072, "MoBA LDS");
__device__ __forceinline__ int moba_lbase(int j) { return 256 * (63 * j - (j * (j - 1)) / 2); }
__device__ __forceinline__ void moba_gate_item(int item, int ln, const bf16* P, const float* KM, int* CNT, int* LIST) {
    const int h = item & 7, tgp = item >> 3, t = tgp * 64 + ln, own = tgp >> 2;
    if (own == 0) return;
    float q[64];
#pragma unroll
    for (int o = 0; o < 8; ++o) { float f[8]; unpack8(*(const uint4*)(P + (size_t)t * NP1 + 2560 + h * 64 + o * 8), f);
#pragma unroll
        for (int e = 0; e < 8; ++e) q[o * 8 + e] = f[e]; }
    float b0 = -INFINITY, b1 = -INFINITY, b2 = -INFINITY; int i0 = 0, i1 = 0, i2 = 0;
#pragma unroll 1
    for (int j = 0; j < own; ++j) {
        const f32x4_t* km = (const f32x4_t*)(KM + (size_t)(h * 64 + j) * 64); float g0 = 0.f, g1 = 0.f;
#pragma unroll
        for (int d4 = 0; d4 < 16; ++d4) { const f32x4_t k = km[d4]; g0 += q[4 * d4] * k[0] + q[4 * d4 + 2] * k[2]; g1 += q[4 * d4 + 1] * k[1] + q[4 * d4 + 3] * k[3]; }
        const float g = g0 + g1;
        if (g > b0) { b2 = b1; i2 = i1; b1 = b0; i1 = i0; b0 = g; i0 = j; }
        else if (g > b1) { b2 = b1; i2 = i1; b1 = g; i1 = j; }
        else if (g > b2) { b2 = g; i2 = j; }
    }
    const int nsel = own < 3 ? own : 3;
#pragma unroll
    for (int u = 0; u < 3; ++u) if (u < nsel) { const int j = (u == 0) ? i0 : (u == 1 ? i1 : i2);
        const int pos = atomicAdd(CNT + h * 64 + j, 1);
        LIST[(size_t)h * 516096 + moba_lbase(j) + pos] = t * 4 + (u + 1); }
}
__device__ __forceinline__ bf16x8_t mb_frag(const LAS bf16* base, int ld, int row, int k0) { return *(const LAS bf16x8_t*)(base + row * ld + k0); }
__device__ __forceinline__ void moba_attn_tile(int h, int j, bool causal, int tl, LAS unsigned char* lds, const bf16* P, float* PML, bf16* PO) {
    const int wv = tl >> 6, ln = tl & 63, lr = ln & 15, lq = ln >> 4;
    LAS int* tq = (LAS int*)lds; LAS int* sl = tq + 64;
    LAS bf16* qs = (LAS bf16*)(lds + MB_QS); LAS bf16* ks = (LAS bf16*)(lds + MB_KS); LAS bf16* vt = (LAS bf16*)(lds + MB_VT); LAS bf16* pm = (LAS bf16*)(lds + MB_PM);
    LAS float* red = (LAS float*)(lds + MB_RED); LAS float* red2 = red + 128;
    { const int row = tl >> 3, oq = tl & 7; int t = tq[row]; if (t < 0) t = 0; const uint4 u = *(const uint4*)(P + (size_t)t * NP1 + 2560 + h * 64 + oq * 8);
      *(LAS u32x4_t*)(qs + row * 72 + oq * 8) = (u32x4_t){u.x, u.y, u.z, u.w}; }
#pragma unroll
    for (int i = 0; i < 4; ++i) { const int task = tl + 512 * i, key = task >> 3, oct = task & 7; const bf16* src = P + (size_t)(j * 256 + key) * NP1 + 3072 + h * 64 + oct * 8;
        const uint4 uk = *(const uint4*)src, uv = *(const uint4*)(src + 512);
        *(LAS u32x4_t*)(ks + key * 72 + oct * 8) = (u32x4_t){uk.x, uk.y, uk.z, uk.w};
        const unsigned w[4] = {uv.x, uv.y, uv.z, uv.w};
#pragma unroll
        for (int e = 0; e < 8; ++e) vt[(oct * 8 + e) * 264 + key] = (bf16)((e & 1) ? (w[e >> 1] >> 16) : (w[e >> 1] & 0xffffu)); }
    __syncthreads();
    const int mt = wv & 3, half = wv >> 2, nb = half * 8;
    f32x4_t acc[8];
#pragma unroll
    for (int nn = 0; nn < 8; ++nn) acc[nn] = (f32x4_t){0.f, 0.f, 0.f, 0.f};
#pragma unroll
    for (int kb = 0; kb < 2; ++kb) { const bf16x8_t a = mb_frag(qs, 72, 16 * mt + lr, kb * 32 + 8 * lq);
#pragma unroll
        for (int nn = 0; nn < 8; ++nn) acc[nn] = __builtin_amdgcn_mfma_f32_16x16x32_bf16(a, mb_frag(ks, 72, 16 * (nb + nn) + lr, kb * 32 + 8 * lq), acc[nn], 0, 0, 0); }
    const float slope = exp2f(-(float)(h + 1));
    int tr[4]; float mx[4];
#pragma unroll
    for (int r = 0; r < 4; ++r) { tr[r] = tq[16 * mt + 4 * lq + r]; mx[r] = -INFINITY; }
#pragma unroll
    for (int nn = 0; nn < 8; ++nn) { const int sk = j * 256 + 16 * (nb + nn) + lr;
#pragma unroll
        for (int r = 0; r < 4; ++r) { float v = 0.125f * acc[nn][r] - slope * (float)(tr[r] - sk); if (causal && sk > tr[r]) v = -INFINITY; acc[nn][r] = v; mx[r] = fmaxf(mx[r], v); } }
#pragma unroll
    for (int r = 0; r < 4; ++r) { float v = mx[r]; v = fmaxf(v, __shfl_xor(v, 1)); v = fmaxf(v, __shfl_xor(v, 2)); v = fmaxf(v, __shfl_xor(v, 4)); v = fmaxf(v, __shfl_xor(v, 8));
        if (lr == 0) red[(16 * mt + 4 * lq + r) * 2 + half] = v; }
    __syncthreads();
#pragma unroll
    for (int r = 0; r < 4; ++r) { const int row = 16 * mt + 4 * lq + r; float m = fmaxf(red[row * 2], red[row * 2 + 1]); if (m == -INFINITY) m = 0.f; mx[r] = m; }
    float ls[4] = {0.f, 0.f, 0.f, 0.f};
#pragma unroll
    for (int nn = 0; nn < 8; ++nn)
#pragma unroll
        for (int r = 0; r < 4; ++r) { const float p = __expf(acc[nn][r] - mx[r]); ls[r] += p; pm[(16 * mt + 4 * lq + r) * 264 + 16 * (nb + nn) + lr] = f2bf(p); }
#pragma unroll
    for (int r = 0; r < 4; ++r) { float v = ls[r]; v += __shfl_xor(v, 1); v += __shfl_xor(v, 2); v += __shfl_xor(v, 4); v += __shfl_xor(v, 8);
        if (lr == 0) red2[(16 * mt + 4 * lq + r) * 2 + half] = v; }
    __syncthreads();
    f32x4_t oa[2] = {(f32x4_t){0.f, 0.f, 0.f, 0.f}, (f32x4_t){0.f, 0.f, 0.f, 0.f}};
#pragma unroll
    for (int kb = 0; kb < 8; ++kb) { const bf16x8_t a = mb_frag(pm, 264, 16 * mt + lr, kb * 32 + 8 * lq);
#pragma unroll
        for (int nn = 0; nn < 2; ++nn) oa[nn] = __builtin_amdgcn_mfma_f32_16x16x32_bf16(a, mb_frag(vt, 264, 16 * (half * 2 + nn) + lr, kb * 32 + 8 * lq), oa[nn], 0, 0, 0); }
#pragma unroll
    for (int r = 0; r < 4; ++r) { const int row = 16 * mt + 4 * lq + r; const int t = tr[r];
        if (t >= 0) { const size_t pi = ((size_t)t * 8 + h) * 4 + sl[row];
#pragma unroll
            for (int nn = 0; nn < 2; ++nn) PO[pi * 64 + 16 * (half * 2 + nn) + lr] = f2bf(oa[nn][r]);
            if (half == 0 && lr == 0) { PML[pi * 2] = mx[r]; PML[pi * 2 + 1] = red2[row * 2] + red2[row * 2 + 1]; } } }
    __syncthreads();
}
__device__ __forceinline__ void moba_attn_phase(int bx, int G, int tl, LAS unsigned char* lds, const bf16* P, const int* CNT, const int* LIST, float* PML, bf16* PO) {
    LAS int* tq = (LAS int*)lds; LAS int* sl = tq + 64; LAS int* pref = (LAS int*)(lds + MB_PREF);
    {
        const int wv = tl >> 6, ln = tl & 63; int v = (CNT[tl] + 63) >> 6;
#pragma unroll
        for (int o = 1; o < 64; o <<= 1) { const int u = __shfl_up(v, o); if (ln >= o) v += u; }
        if (ln == 63) pref[512 + wv] = v;
        __syncthreads();
        int add = 0;
        for (int w = 0; w < wv; ++w) add += pref[512 + w];
        __syncthreads();
        pref[tl] = v + add;
        __syncthreads();
    }
    const int total = pref[511];
    for (int it = bx; it < 2048 + total; it += G) {
        int h, j; bool causal;
        if (it < 2048) { h = it & 7; const int qt = it >> 3; j = qt >> 2; causal = true; if (tl < 64) { tq[tl] = qt * 64 + tl; sl[tl] = 0; } }
        else { const int x = it - 2048; int lo = 0, hi = 511;
            while (lo < hi) { const int mid = (lo + hi) >> 1; if (pref[mid] > x) hi = mid; else lo = mid + 1; }
            h = lo >> 6; j = lo & 63; causal = false;
            const int tile = x - (lo ? pref[lo - 1] : 0), cnt = CNT[lo];
            if (tl < 64) { const int e = tile * 64 + tl; if (e < cnt) { const int v = LIST[(size_t)h * 516096 + moba_lbase(j) + e]; tq[tl] = v >> 2; sl[tl] = v & 3; } else { tq[tl] = -1; sl[tl] = 0; } } }
        __syncthreads();
        moba_attn_tile(h, j, causal, tl, lds, P, PML, PO);
    }
}
__device__ __forceinline__ void moba_merge_item(int idx, const float* PML, const bf16* PO, bf16* OMIX) {
    const int oc = idx & 7, h = (idx >> 3) & 7, t = idx >> 6, own = t >> 8, ns = 1 + (own < 3 ? own : 3);
    const size_t pi = ((size_t)t * 8 + h) * 4;
    float m[4], l[4]; float mmax = -INFINITY;
#pragma unroll
    for (int u = 0; u < 4; ++u) if (u < ns) { m[u] = PML[(pi + u) * 2]; l[u] = PML[(pi + u) * 2 + 1]; mmax = fmaxf(mmax, m[u]); }
    float L = 0.f, o[8];
#pragma unroll
    for (int e = 0; e < 8; ++e) o[e] = 0.f;
#pragma unroll
    for (int u = 0; u < 4; ++u) if (u < ns) { const float w = __expf(m[u] - mmax); L += w * l[u]; float f[8]; unpack8(*(const uint4*)(PO + (pi + u) * 64 + oc * 8), f);
#pragma unroll
        for (int e = 0; e < 8; ++e) o[e] += w * f[e]; }
    const float inv = 1.f / L; unsigned w4[4];
#pragma unroll
    for (int e = 0; e < 8; e += 2) w4[e >> 1] = (unsigned)f2bf(o[e] * inv) | ((unsigned)f2bf(o[e + 1] * inv) << 16);
    *(uint4*)(OMIX + (size_t)t * 1536 + 1024 + h * 64 + oc * 8) = make_uint4(w4[0], w4[1], w4[2], w4[3]);
}

namespace pg8 {
typedef short bf16x8 __attribute__((ext_vector_type(8)));
typedef float f32x4 __attribute__((ext_vector_type(4)));
typedef unsigned u32x4 __attribute__((ext_vector_type(4)));
constexpr int BM = 256, BK = 64, HALF = 128, HTB = HALF * BK * 2, STAGE_BYTES = 8 * HTB, NXCD = 8, WGM = 8;
__host__ __device__ __forceinline__ int lds_byte(int r, int c) { const int st = (r >> 4) * 2 + (c >> 5), rr = r & 15, cc = c & 31, ob = rr * 64 + cc * 2; return st * 1024 + (ob ^ (((ob >> 9) & 1) << 5)); }
__host__ __device__ __forceinline__ void stage_rc(int b, int& R, int& C) { const int st = b / 1024, sb = b % 1024, swz = sb ^ (((sb >> 9) & 1) << 5); R = (st >> 1) * 16 + swz / 64; C = (st & 1) * 32 + (swz % 64) / 2; }
__host__ __device__ __forceinline__ int perm32(int rho) { const int n = rho >> 4, i = rho & 15; return 8 * (i >> 2) + 4 * n + (i & 3); }
struct Unit { int pm, pn; };
struct Gemm { const bf16* A; const bf16* Bt; const int* tile_e; size_t a_pn_step, b_tstep, b_estep; int lda, ldb, K, pad; };
struct StaticOrder {
    int nM, nN, nwg, G, c;
    __device__ void init(int Mr, int N, int G_, int c_) { nM = Mr / BM; nN = N / BM; nwg = nM * nN; G = G_; c = c_; }
    __device__ bool next(int i, Unit& u) const {
        const long L = (long)i * G + c; if (L >= nwg) return false;
        int wgid = (int)L; { const int q = nwg / NXCD, r = nwg % NXCD, xcd = wgid % NXCD, off = wgid / NXCD; wgid = (xcd < r ? xcd * (q + 1) : r * (q + 1) + (xcd - r) * q) + off; }
        const int nig = WGM * nN, gid = wgid / nig, fm = gid * WGM, gsz = (nM - fm) < WGM ? (nM - fm) : WGM;
        u.pm = fm + ((wgid % nig) % gsz); u.pn = (wgid % nig) / gsz; return true;
    }
    __device__ __forceinline__ void a_ready(const Unit&) const {}
    __device__ __forceinline__ void done(const Unit&) const {}
};
__device__ __forceinline__ unsigned cvt_pk_bf16(float lo, float hi) { unsigned r; asm volatile("v_cvt_pk_bf16_f32 %0, %1, %2" : "=v"(r) : "v"(lo), "v"(hi)); return r; }
__device__ __forceinline__ u32x4 pack8(const f32x4 v0, const f32x4 v1) { u32x4 w; w.x = cvt_pk_bf16(v0[0], v0[1]); w.y = cvt_pk_bf16(v0[2], v0[3]); w.z = cvt_pk_bf16(v1[0], v1[1]); w.w = cvt_pk_bf16(v1[2], v1[3]); return w; }
struct EpBf {
    static constexpr bool PERM = true, AFTER_DRAIN = false;
    bf16* O; int ldc; float scale;
    __device__ __forceinline__ void operator()(const f32x4 (&acc)[2][2][4][2], const Unit& u, int wr, int wc, int fr, int fq) const {
        const int row0 = u.pm * BM + wr * 64 + fr, col0 = u.pn * BM + wc * 32 + 8 * fq;
#pragma unroll
        for (int ai = 0; ai < 2; ++ai)
#pragma unroll
            for (int m = 0; m < 4; ++m) { bf16* rowp = O + (size_t)(row0 + ai * HALF + m * 16) * ldc + col0;
#pragma unroll
                for (int bj = 0; bj < 2; ++bj) *(u32x4*)(rowp + bj * HALF) = pack8(acc[ai][bj][m][0] * scale, acc[ai][bj][m][1] * scale); }
    }
};
struct EpRes {
    static constexpr bool PERM = false, AFTER_DRAIN = false;
    const float* base; float* out;
    __device__ __forceinline__ void operator()(const f32x4 (&acc)[2][2][4][2], const Unit& u, int wr, int wc, int fr, int fq) const {
        const int row0 = u.pm * BM + wr * 64 + fr, col0 = u.pn * BM + wc * 32 + 4 * fq;
#pragma unroll
        for (int ai = 0; ai < 2; ++ai)
#pragma unroll
            for (int m = 0; m < 4; ++m) { const size_t off = (size_t)(row0 + ai * HALF + m * 16) * D + col0;
#pragma unroll
                for (int bj = 0; bj < 2; ++bj)
#pragma unroll
                    for (int n = 0; n < 2; ++n) { const f32x4 bs = *(const f32x4*)(base + off + bj * HALF + n * 16); *(f32x4*)(out + off + bj * HALF + n * 16) = bs * ALPHA + acc[ai][bj][m][n]; } }
    }
};
struct EpSilu {
    static constexpr bool PERM = true, AFTER_DRAIN = false;
    bf16* O; int ldc; int pad;
    __device__ __forceinline__ void operator()(const f32x4 (&acc)[2][2][4][2], const Unit& u, int wr, int wc, int fr, int fq) const {
        const int row0 = u.pm * BM + wr * 64 + fr, col0 = u.pn * HALF + wc * 32 + 8 * fq;
#pragma unroll
        for (int ai = 0; ai < 2; ++ai)
#pragma unroll
            for (int m = 0; m < 4; ++m) { f32x4 h[2];
#pragma unroll
                for (int n = 0; n < 2; ++n)
#pragma unroll
                    for (int j = 0; j < 4; ++j) { const float g = acc[ai][0][m][n][j]; h[n][j] = g / (1.f + __expf(-g)) * acc[ai][1][m][n][j]; }
                *(u32x4*)(O + (size_t)(row0 + ai * HALF + m * 16) * ldc + col0) = pack8(h[0], h[1]); }
    }
};
struct EpYR {
    static constexpr bool PERM = true, AFTER_DRAIN = false;
    bf16* YR; const int* row_tok; const int* tile_e; const int* meta; int row_off; int pad;
    __device__ __forceinline__ void operator()(const f32x4 (&acc)[2][2][4][2], const Unit& u, int wr, int wc, int fr, int fq) const {
        const int row0 = u.pm * BM + wr * 64 + fr, col0 = u.pn * BM + wc * 32 + 8 * fq;
        const int shift = row_off - meta[8 + tile_e[u.pm]];
#pragma unroll
        for (int ai = 0; ai < 2; ++ai)
#pragma unroll
            for (int m = 0; m < 4; ++m) { const int r = row0 + ai * HALF + m * 16;
                if (row_tok[r] >= 0) { bf16* rowp = YR + (size_t)(r + shift) * D + col0;
#pragma unroll
                    for (int bj = 0; bj < 2; ++bj) *(u32x4*)(rowp + bj * HALF) = pack8(acc[ai][bj][m][0], acc[ai][bj][m][1]); } }
    }
};
struct EpSoftmax {
    static constexpr bool PERM = true, AFTER_DRAIN = true;
    bf16* O; int ldc; int pad;
    __device__ __forceinline__ void fused(f32x4 (&acc)[2][2][4][2], const Unit& u, int wr, int wc, int fr, int fq, LAS unsigned char* lds, int wid, int lane) const {
        LAS float* T1 = (LAS float*)lds; LAS float* T2 = T1 + 1024;
#pragma unroll
        for (int ai = 0; ai < 2; ++ai)
#pragma unroll
            for (int m = 0; m < 4; ++m) { float v = -INFINITY;
#pragma unroll
                for (int bj = 0; bj < 2; ++bj)
#pragma unroll
                    for (int n = 0; n < 2; ++n) { const f32x4 x = acc[ai][bj][m][n]; v = fmaxf(v, fmaxf(fmaxf(x[0], x[1]), fmaxf(x[2], x[3]))); }
                v = fmaxf(v, __shfl_xor(v, 16)); v = fmaxf(v, __shfl_xor(v, 32));
                if (fq == 0) T1[(ai * HALF + wr * 64 + m * 16 + fr) * 4 + wc] = v; }
        asm volatile("s_waitcnt lgkmcnt(0)" ::: "memory"); __builtin_amdgcn_s_barrier(); asm volatile("" ::: "memory");
#pragma unroll
        for (int ai = 0; ai < 2; ++ai)
#pragma unroll
            for (int m = 0; m < 4; ++m) { const int r = ai * HALF + wr * 64 + m * 16 + fr; const f32x4 t = *(const LAS f32x4*)(T1 + r * 4);
                const float mx = fmaxf(fmaxf(t[0], t[1]), fmaxf(t[2], t[3])); float s = 0.f;
#pragma unroll
                for (int bj = 0; bj < 2; ++bj)
#pragma unroll
                    for (int n = 0; n < 2; ++n)
#pragma unroll
                        for (int j = 0; j < 4; ++j) { const float e = __expf(acc[ai][bj][m][n][j] - mx); acc[ai][bj][m][n][j] = e; s += e; }
                s += __shfl_xor(s, 16); s += __shfl_xor(s, 32);
                if (fq == 0) T2[r * 4 + wc] = s; }
        asm volatile("s_waitcnt lgkmcnt(0)" ::: "memory"); __builtin_amdgcn_s_barrier(); asm volatile("" ::: "memory");
        const int row0 = u.pm * BM + wr * 64 + fr, col0 = u.pn * BM + wc * 32 + 8 * fq;
#pragma unroll
        for (int ai = 0; ai < 2; ++ai)
#pragma unroll
            for (int m = 0; m < 4; ++m) { const int r = ai * HALF + wr * 64 + m * 16 + fr; const f32x4 t = *(const LAS f32x4*)(T2 + r * 4);
                const float inv = 1.f / ((t[0] + t[1]) + (t[2] + t[3]));
                bf16* rowp = O + (size_t)(row0 + ai * HALF + m * 16) * ldc + col0;
#pragma unroll
                for (int bj = 0; bj < 2; ++bj) *(u32x4*)(rowp + bj * HALF) = pack8(acc[ai][bj][m][0] * inv, acc[ai][bj][m][1] * inv); }
        asm volatile("s_waitcnt lgkmcnt(0)" ::: "memory"); __builtin_amdgcn_s_barrier(); asm volatile("" ::: "memory");
    }
};

template <class Epi, class Sched, bool ALIGN_EPI, bool SP2>
__device__ __forceinline__ void gemm_phase(LAS unsigned char* lds, const Gemm g, const Sched& S, const Epi& E, const int tid) {
    const int wid = __builtin_amdgcn_readfirstlane(tid >> 6), lane = tid & 63, wr = wid >> 2, wc = wid & 3, fr = lane & 15, fq = lane >> 4;
    const int K = g.K, nt = K / BK;
    unsigned voffA[2], voffB[2];
#pragma unroll
    for (int i = 0; i < 2; ++i) { int R, C; stage_rc(tid * 16 + i * 8192, R, C); const int Rb = Epi::PERM ? ((R & ~31) + perm32(R & 31)) : R;
        voffA[i] = (unsigned)(R * g.lda + C) * 2u; voffB[i] = (unsigned)(Rb * g.ldb + C) * 2u; }
    const size_t kstep = (size_t)(BK * 2);
    const size_t hstepA = (size_t)HALF * g.lda * 2, hstepB = (size_t)HALF * g.ldb * 2;
    const size_t tstepA = 2 * hstepA;
    const unsigned ldsw = (unsigned)wid * 1024u;
    const int aoff = lds_byte(wr * 64 + fr, fq * 8), boff = lds_byte(wc * 32 + fr, fq * 8);
#define PG8_SA(b, h) (((b) * 2 + (h)) * HTB)
#define PG8_SB(b, h) ((4 + (b) * 2 + (h)) * HTB)
#define PG8_STAGE(bufoff, gbase, voff) do { _Pragma("unroll") for (int _i = 0; _i < 2; ++_i) \
        __builtin_amdgcn_global_load_lds((const unsigned*)((const char*)(gbase) + (voff)[_i]), (LAS unsigned*)(lds + (bufoff) + ldsw + _i * 8192), 16, 0, 0); } while (0)
#define PG8_LDA(dst, b, h) do { _Pragma("unroll") for (int m = 0; m < 4; ++m) _Pragma("unroll") for (int k = 0; k < 2; ++k) dst[m][k] = *(const LAS bf16x8*)(lds + PG8_SA(b, h) + aoff + m * 2048 + k * 1024); } while (0)
#define PG8_LDB(dst, b, h) do { _Pragma("unroll") for (int n = 0; n < 2; ++n) _Pragma("unroll") for (int k = 0; k < 2; ++k) dst[n][k] = *(const LAS bf16x8*)(lds + PG8_SB(b, h) + boff + n * 2048 + k * 1024); } while (0)
#define PG8_MMA(ai, bj, At, Bt) do { __builtin_amdgcn_s_setprio(1); _Pragma("unroll") for (int m = 0; m < 4; ++m) _Pragma("unroll") for (int n = 0; n < 2; ++n) _Pragma("unroll") for (int k = 0; k < 2; ++k) \
        acc[ai][bj][m][n] = __builtin_amdgcn_mfma_f32_16x16x32_bf16(Bt[n][k], At[m][k], acc[ai][bj][m][n], 0, 0, 0); __builtin_amdgcn_s_setprio(0); } while (0)
#define PG8_WAIT_V(n) asm volatile("s_waitcnt vmcnt(" #n ")" ::: "memory")
#define PG8_WAIT_L(n) asm volatile("s_waitcnt lgkmcnt(" #n ")" ::: "memory")
#define PG8_BAR __builtin_amdgcn_s_barrier()
#define PG8_SCHED __builtin_amdgcn_sched_barrier(0)
#define PG8_APTR(u) ((const char*)g.A + (size_t)(u).pm * tstepA + (size_t)(u).pn * g.a_pn_step)
#define PG8_BPTR(u) ((const char*)g.Bt + (size_t)(u).pn * g.b_tstep + (g.tile_e ? (size_t)g.tile_e[(u).pm] * g.b_estep : (size_t)0))
    Unit cur, nxt; int ui = 0;
    if (!S.next(0, cur)) return;
    f32x4 acc[2][2][4][2];
#pragma unroll
    for (int a = 0; a < 2; ++a)
#pragma unroll
        for (int b = 0; b < 2; ++b)
#pragma unroll
            for (int m = 0; m < 4; ++m)
#pragma unroll
                for (int n = 0; n < 2; ++n) acc[a][b][m][n] = (f32x4){0.f, 0.f, 0.f, 0.f};
    bf16x8 At[4][2], B0[2][2], B1[2][2];
    const char* cA = PG8_APTR(cur); const char* cB = PG8_BPTR(cur);
    S.a_ready(cur);
    if constexpr (SP2) {
        PG8_STAGE(PG8_SB(0, 0), cB, voffB); PG8_STAGE(PG8_SB(0, 1), cB + hstepB, voffB); PG8_STAGE(PG8_SA(0, 0), cA, voffA); PG8_STAGE(PG8_SA(0, 1), cA + hstepA, voffA);
        if (wr == 1) PG8_BAR;
        PG8_WAIT_V(2); PG8_BAR;
        PG8_STAGE(PG8_SB(1, 0), cB + kstep, voffB); PG8_STAGE(PG8_SA(1, 0), cA + kstep, voffA); PG8_STAGE(PG8_SB(1, 1), cB + hstepB + kstep, voffB);
        PG8_WAIT_V(6); PG8_BAR;
    } else {
        PG8_STAGE(PG8_SB(0, 0), cB, voffB); PG8_STAGE(PG8_SA(0, 0), cA, voffA); PG8_STAGE(PG8_SB(0, 1), cB + hstepB, voffB); PG8_STAGE(PG8_SA(0, 1), cA + hstepA, voffA);
        if (wr == 1) PG8_BAR;
        PG8_WAIT_V(4); PG8_BAR;
        PG8_STAGE(PG8_SB(1, 0), cB + kstep, voffB); PG8_STAGE(PG8_SA(1, 0), cA + kstep, voffA); PG8_STAGE(PG8_SB(1, 1), cB + hstepB + kstep, voffB);
        PG8_WAIT_V(6); PG8_BAR;
    }
    for (;;) {
        const bool has_next = S.next(ui + 1, nxt);
        const char* nA = has_next ? PG8_APTR(nxt) : cA; const char* nB = has_next ? PG8_BPTR(nxt) : cB;
        for (int t = 0; t < nt; t += 2) {
            const bool last = (t == nt - 2);
            const char* a1 = cA + (size_t)(t + 1) * kstep;
            const char* a2 = last ? nA : cA + (size_t)(t + 2) * kstep; const char* b2 = last ? nB : cB + (size_t)(t + 2) * kstep;
            const char* a3 = a2 + kstep; const char* b3 = b2 + kstep;
            if (last && has_next) S.a_ready(nxt);
            if constexpr (SP2) {
            PG8_LDB(B0, 0, 0); PG8_LDB(B1, 0, 1); PG8_SCHED; PG8_LDA(At, 0, 0); PG8_STAGE(PG8_SA(1, 1), a1 + hstepA, voffA);
            PG8_WAIT_V(8); PG8_WAIT_L(0); PG8_BAR; PG8_MMA(0, 0, At, B0); PG8_MMA(0, 1, At, B1); PG8_BAR; PG8_SCHED;
            PG8_LDA(At, 0, 1); PG8_STAGE(PG8_SB(0, 0), b2, voffB); PG8_STAGE(PG8_SB(0, 1), b2 + hstepB, voffB); PG8_STAGE(PG8_SA(0, 0), a2, voffA);
            PG8_WAIT_V(8); PG8_WAIT_L(0); PG8_BAR; PG8_MMA(1, 0, At, B0); PG8_MMA(1, 1, At, B1); PG8_BAR; PG8_SCHED;
            PG8_LDB(B0, 1, 0); PG8_LDB(B1, 1, 1); PG8_SCHED; PG8_LDA(At, 1, 0); PG8_STAGE(PG8_SA(0, 1), a2 + hstepA, voffA);
            PG8_WAIT_V(8); PG8_WAIT_L(0); PG8_BAR; PG8_MMA(0, 0, At, B0); PG8_MMA(0, 1, At, B1); PG8_BAR; PG8_SCHED;
            PG8_LDA(At, 1, 1); PG8_STAGE(PG8_SB(1, 0), b3, voffB); PG8_STAGE(PG8_SB(1, 1), b3 + hstepB, voffB); PG8_STAGE(PG8_SA(1, 0), a3, voffA);
            PG8_WAIT_V(8); PG8_WAIT_L(0); PG8_BAR; PG8_MMA(1, 0, At, B0); PG8_MMA(1, 1, At, B1); PG8_BAR; PG8_SCHED;
            } else {
            PG8_LDB(B0, 0, 0); PG8_SCHED; PG8_LDA(At, 0, 0); PG8_STAGE(PG8_SA(1, 1), a1 + hstepA, voffA);
            PG8_WAIT_L(8); PG8_BAR; PG8_WAIT_L(0); PG8_MMA(0, 0, At, B0); PG8_BAR; PG8_SCHED;
            PG8_LDB(B1, 0, 1); PG8_STAGE(PG8_SB(0, 0), b2, voffB);
            PG8_BAR; PG8_WAIT_L(0); PG8_MMA(0, 1, At, B1); PG8_BAR;
            PG8_LDA(At, 0, 1); PG8_STAGE(PG8_SA(0, 0), a2, voffA);
            PG8_BAR; PG8_WAIT_L(0); PG8_MMA(1, 0, At, B0); PG8_BAR; PG8_SCHED;
            PG8_STAGE(PG8_SB(0, 1), b2 + hstepB, voffB);
            PG8_WAIT_V(6); PG8_BAR; PG8_MMA(1, 1, At, B1); PG8_BAR;
            PG8_LDB(B0, 1, 0); PG8_SCHED; PG8_LDA(At, 1, 0); PG8_STAGE(PG8_SA(0, 1), a2 + hstepA, voffA);
            PG8_WAIT_L(8); PG8_BAR; PG8_WAIT_L(0); PG8_MMA(0, 0, At, B0); PG8_BAR; PG8_SCHED;
            PG8_LDB(B1, 1, 1); PG8_STAGE(PG8_SB(1, 0), b3, voffB);
            PG8_BAR; PG8_WAIT_L(0); PG8_MMA(0, 1, At, B1); PG8_BAR;
            PG8_LDA(At, 1, 1); PG8_STAGE(PG8_SA(1, 0), a3, voffA);
            PG8_BAR; PG8_WAIT_L(0); PG8_MMA(1, 0, At, B0); PG8_BAR; PG8_SCHED;
            PG8_STAGE(PG8_SB(1, 1), b3 + hstepB, voffB);
            PG8_WAIT_V(6); PG8_BAR; PG8_MMA(1, 1, At, B1); PG8_BAR;
            }
        }
        if constexpr (ALIGN_EPI) { if (wr == 0) PG8_BAR; }
        if constexpr (!Epi::AFTER_DRAIN) { E(acc, cur, wr, wc, fr, fq); S.done(cur); }
        if (!has_next) break;
#pragma unroll
        for (int a = 0; a < 2; ++a)
#pragma unroll
            for (int b = 0; b < 2; ++b)
#pragma unroll
                for (int m = 0; m < 4; ++m)
#pragma unroll
                    for (int n = 0; n < 2; ++n) acc[a][b][m][n] = (f32x4){0.f, 0.f, 0.f, 0.f};
        cur = nxt; cA = nA; cB = nB; ++ui;
        if constexpr (ALIGN_EPI) { if (wr == 1) PG8_BAR; }
    }
    PG8_WAIT_V(0);
    if constexpr (!ALIGN_EPI) { if (wr == 0) PG8_BAR; }
    PG8_BAR;
    if constexpr (Epi::AFTER_DRAIN) { E.fused(acc, cur, wr, wc, fr, fq, lds, wid, lane); S.done(cur); }
#undef PG8_SA
#undef PG8_SB
#undef PG8_STAGE
#undef PG8_LDA
#undef PG8_LDB
#undef PG8_MMA
#undef PG8_WAIT_V
#undef PG8_WAIT_L
#undef PG8_BAR
#undef PG8_SCHED
#undef PG8_APTR
#undef PG8_BPTR
}
}

#define XB_TMO      128
#define XB_XCNT(j)  (256  + 64 * (j))
#define XB_XSUB(j)  (1280 + 64 * (j))
#define XB_XGEN(j)  (2304 + 64 * (j))
#define XB_TOP      3328
#define XB_TOPGEN   3392
#define XCD_BAR_WORDS 3456
#define XB_SPIN_CAP (1u << 28)
__device__ __forceinline__ unsigned xb_ld(unsigned* p)              { return __hip_atomic_load(p, __ATOMIC_RELAXED, __HIP_MEMORY_SCOPE_AGENT); }
__device__ __forceinline__ unsigned xb_add(unsigned* p, unsigned v) { return __hip_atomic_fetch_add(p, v, __ATOMIC_RELAXED, __HIP_MEMORY_SCOPE_AGENT); }
__device__ __forceinline__ unsigned xb_xcc_id() { return (unsigned)__builtin_amdgcn_s_getreg((3 << 11) | 20) & 0xFu; }
#define XB_SPIN(cond, bar) do { unsigned _sp = 0; while (cond) { __builtin_amdgcn_s_sleep(1); \
    if ((++_sp & 255u) == 0u) { if (xb_ld(&(bar)[XB_TMO])) break; if (_sp > XB_SPIN_CAP) { atomicAdd(&(bar)[XB_TMO], 1u); break; } } } } while (0)
struct XcdBarrier { unsigned* bar; unsigned x; volatile LAS unsigned* st; };
__device__ __forceinline__ XcdBarrier xcd_barrier_post(unsigned* bar, volatile LAS unsigned* st) {
    XcdBarrier b; b.bar = bar; b.x = xb_xcc_id(); b.st = st;
    if (threadIdx.x == 0) (void)xb_add(&bar[XB_XCNT(b.x)], 1u);
    return b;
}
__device__ __forceinline__ void xcd_barrier_complete(unsigned* bar, unsigned x, unsigned& nloc, unsigned& nx) {
    const unsigned G = gridDim.x * gridDim.y * gridDim.z;
    unsigned sum, cnt, mine, sp = 0u;
    for (;;) {
        sum = 0u; cnt = 0u; mine = 0u;
#pragma unroll
        for (unsigned j = 0; j < 16; ++j) { const unsigned c = xb_ld(&bar[XB_XCNT(j)]); sum += c; cnt += (c > 0u) ? 1u : 0u; mine = (j == x) ? c : mine; }
        if (sum == G) break;
        __builtin_amdgcn_s_sleep(1);
        if ((++sp & 255u) == 0u) { if (xb_ld(&bar[XB_TMO])) break; if (sp > XB_SPIN_CAP) { atomicAdd(&bar[XB_TMO], 1u); break; } }
    }
    nloc = mine > 0u ? mine : 1u; nx = cnt > 0u ? cnt : 1u;
}
__device__ __forceinline__ void xcd_barrier(const XcdBarrier& b) {
    asm volatile("s_waitcnt vmcnt(0)" ::: "memory");
    __syncthreads();
    if (threadIdx.x == 0) {
        unsigned* bar = b.bar;
        __builtin_amdgcn_s_waitcnt(0);
        unsigned nloc = b.st[0], nx = b.st[1];
        if (nloc == 0u) { xcd_barrier_complete(bar, b.x, nloc, nx); b.st[0] = nloc; b.st[1] = nx; }
        const unsigned old = xb_add(&bar[XB_XSUB(b.x)], 1u);
        const unsigned gen = old / nloc;
        if (old + 1u == (gen + 1u) * nloc) {
            __builtin_amdgcn_fence(__ATOMIC_RELEASE, "agent");
            asm volatile("s_waitcnt vmcnt(0)" ::: "memory");
            const unsigned og = xb_add(&bar[XB_TOP], 1u);
            const unsigned tg = og / nx;
            if (og + 1u == (tg + 1u) * nx) xb_add(&bar[XB_TOPGEN], 1u);
            else XB_SPIN(xb_ld(&bar[XB_TOPGEN]) == tg, bar);
            __builtin_amdgcn_fence(__ATOMIC_ACQUIRE, "agent");
            xb_add(&bar[XB_XGEN(b.x)], 1u);
            asm volatile("s_waitcnt vmcnt(0)" ::: "memory");
        } else {
            XB_SPIN(xb_ld(&bar[XB_XGEN(b.x)]) == gen, bar);
            __builtin_amdgcn_fence(__ATOMIC_ACQUIRE, "agent");
            asm volatile("s_waitcnt vmcnt(0)" ::: "memory");
        }
    }
    __syncthreads();
}

constexpr int NWAVES = 8;
#ifndef DUP_MASK_V
#define DUP_MASK_V 0ull
#endif
constexpr unsigned long long DUP_MASK = DUP_MASK_V;
constexpr int RING_BYTES = 131072, LDSCTL_OFF = RING_BYTES, MISC_OFF = LDSCTL_OFF + 320, LDS_BYTES = 147456;
constexpr int CW_BAR = 4096;
constexpr size_t W_GU0 = 209 * MiB, W_D0 = 220 * MiB, W_OUT0 = 225 * MiB + 512 * 1024, W_XQ0 = 227 * MiB + 512 * 1024, W_XO0 = 229 * MiB + 512 * 1024;
constexpr size_t W_IN0 = 265 * MiB, W_XK0 = 272 * MiB, W_XV0 = 274 * MiB, WS_WLR = 276 * MiB;
constexpr size_t W_IN1 = 409 * MiB, W_OUT1 = 417 * MiB + 512 * 1024, W_XQ1 = 420 * MiB + 512 * 1024, W_XK1 = 422 * MiB + 512 * 1024, W_XV1 = 424 * MiB + 512 * 1024, W_XO1 = 426 * MiB + 512 * 1024;
constexpr size_t WS_MEMB = 428 * MiB + 512 * 1024, WS_KMEM0 = 429 * MiB, WS_VT0 = 429 * MiB + 512 * 1024, WS_KMEM1 = 430 * MiB, WS_VT1 = 430 * MiB + 512 * 1024;
constexpr size_t WS_HM = 65 * MiB, WS_XG = 159 * MiB, WS_YR = 227 * MiB, WS_RT = 291 * MiB, W_EGU = 292 * MiB, W_ED = 380 * MiB;
constexpr size_t EGU_STEP = 11 * MiB, ED_STEP = 5 * MiB + 512 * 1024;
constexpr size_t RT_TOPE = 0, RT_GATE = 128 * 1024, RT_ROWTOK = 256 * 1024, RT_SLOTROW = 512 * 1024, RT_TILEE = 640 * 1024, RT_META = 704 * 1024, RT_BC = 768 * 1024;

struct MArgs { const float* in[54]; float* out; unsigned char* ws; int ph_lo, ph_hi, li, pad; };
constexpr int PTAB_OFF = MISC_OFF + 128;
struct PTab { const float* const* t; int z;
    __device__ __forceinline__ const float* operator[](int i) const { return t[i + z]; } };
struct Ctx { PTab in; float* out; unsigned char* ws; };

struct CvtJob { const float* W0; const float* W1; bf16* dst; int ld, K, ndst, mode; };
__device__ __forceinline__ const float* cvt_src(const CvtJob& j, int n) {
    switch (j.mode) {
        case 0: return j.W0 + n;
        case 1: return n < 1552 ? j.W0 + n : (n < 1792 ? nullptr : j.W0 + (n - 240));
        case 2: return n < 2560 ? j.W0 + n : (n < 4096 ? j.W0 + (n + 16) : (n < 4112 ? j.W0 + (2560 + n - 4096) : nullptr));
        default: { const int pn = n >> 8, r = n & 255; return r < 128 ? j.W0 + (128 * pn + r) : j.W1 + (128 * pn + r - 128); }
    }
}
__device__ __forceinline__ void cvt_item(const CvtJob& j, LAS float* scr_f, int item, int lane) {
    LAS bf16* T = (LAS bf16*)scr_f;
    const int nblk = j.ndst / 64, kb = item / nblk, nb = item % nblk, k0 = 64 * kb, n0 = 64 * nb;
    const int n4 = lane & 15, kq = lane >> 4;
    const float* colp = cvt_src(j, n0 + 4 * n4);
#pragma unroll
    for (int i = 0; i < 8; ++i) { const int kk = 8 * i + 2 * kq;
        f32x4_t x0 = (f32x4_t){0.f, 0.f, 0.f, 0.f}, x1 = x0;
        if (colp) { x0 = *(const f32x4_t*)(colp + (size_t)(k0 + kk) * j.ld); x1 = *(const f32x4_t*)(colp + (size_t)(k0 + kk + 1) * j.ld); }
#pragma unroll
        for (int e = 0; e < 4; ++e) *(LAS unsigned*)(T + (4 * n4 + e) * 72 + kk) = pk2(x0[e], x1[e]); }
    asm volatile("s_waitcnt lgkmcnt(0)" ::: "memory");
    const int c = lane & 7;
#pragma unroll
    for (int jj = 0; jj < 8; ++jj) { const int n = (lane >> 3) + 8 * jj; const u32x4_t v = *(const LAS u32x4_t*)(T + n * 72 + 8 * c);
        *(uint4*)(j.dst + (size_t)(n0 + n) * j.K + k0 + 8 * c) = make_uint4(v[0], v[1], v[2], v[3]); }
    asm volatile("s_waitcnt lgkmcnt(0)" ::: "memory");
}
__device__ __forceinline__ CvtJob get_cvt_job(int idx, const Ctx& a) {
    unsigned char* ws = a.ws; CvtJob j; j.W1 = nullptr; j.mode = 0; j.ld = 1024; j.K = 1024; j.ndst = 1024;
    switch (idx) {
        case 0: j.W0 = a.in[2]; j.dst = (bf16*)(ws + W_IN0); j.ld = 3344; j.ndst = NP0; j.mode = 1; break;
        case 1: j.W0 = a.in[17]; j.dst = (bf16*)(ws + W_OUT0); break;
        case 2: j.W0 = a.in[20]; j.dst = (bf16*)(ws + W_XQ0); break;
        case 3: j.W0 = a.in[21]; j.dst = (bf16*)(ws + W_XK0); break;
        case 4: j.W0 = a.in[22]; j.dst = (bf16*)(ws + W_XV0); break;
        case 5: j.W0 = a.in[23]; j.dst = (bf16*)(ws + W_XO0); break;
        case 6: j.W0 = a.in[26]; j.W1 = a.in[27]; j.dst = (bf16*)(ws + W_GU0); j.ld = 2816; j.ndst = 5632; j.mode = 3; break;
        case 7: j.W0 = a.in[28]; j.dst = (bf16*)(ws + W_D0); j.K = 2816; break;
        case 8: j.W0 = a.in[31]; j.dst = (bf16*)(ws + W_IN1); j.ld = 4112; j.ndst = NP1; j.mode = 2; break;
        case 9: j.W0 = a.in[38]; j.dst = (bf16*)(ws + W_OUT1); j.K = 1536; break;
        case 10: j.W0 = a.in[41]; j.dst = (bf16*)(ws + W_XQ1); break;
        case 11: j.W0 = a.in[42]; j.dst = (bf16*)(ws + W_XK1); break;
        case 12: j.W0 = a.in[43]; j.dst = (bf16*)(ws + W_XV1); break;
        case 13: j.W0 = a.in[44]; j.dst = (bf16*)(ws + W_XO1); break;
        default: { const int e = (idx - 14) >> 1;
            if ((idx & 1) == 0) { j.W0 = a.in[49] + (size_t)e * 1024 * 2816; j.W1 = a.in[50] + (size_t)e * 1024 * 2816; j.dst = (bf16*)(ws + W_EGU + e * EGU_STEP); j.ld = 2816; j.ndst = 5632; j.mode = 3; }
            else { j.W0 = a.in[51] + (size_t)e * 2816 * 1024; j.dst = (bf16*)(ws + W_ED + e * ED_STEP); j.K = 2816; } } break;
    }
    return j;
}
__device__ __forceinline__ void cvt_jobs(int j_lo, int j_hi, const Ctx& args, LAS float* scr, int gw, int NGW, int ln) {
    int base = 0;
    for (int ji = j_lo; ji < j_hi; ++ji) {
        const CvtJob j = get_cvt_job(ji, args);
        const int nitems = (j.K / 64) * (j.ndst / 64);
        const int first = (gw - base % NGW + NGW) % NGW;
        for (int it = first; it < nitems; it += NGW) cvt_item(j, scr, it, ln);
        base += nitems;
    }
}
__device__ __forceinline__ void ln_row(const float* in, float* outf, bf16* outb, const float* g, const float* b, int lane, float4 (&o)[4]) {
    const float4* p = (const float4*)in + lane;
    float4 v[4]; float s = 0.f;
#pragma unroll
    for (int j = 0; j < 4; ++j) { v[j] = p[64 * j]; s += (v[j].x + v[j].y) + (v[j].z + v[j].w); }
    const float mean = wave_sum(s) * (1.f / D); float q = 0.f;
#pragma unroll
    for (int j = 0; j < 4; ++j) { v[j].x -= mean; v[j].y -= mean; v[j].z -= mean; v[j].w -= mean; q += (v[j].x * v[j].x + v[j].y * v[j].y) + (v[j].z * v[j].z + v[j].w * v[j].w); }
    const float rstd = 1.f / sqrtf(wave_sum(q) * (1.f / D) + 1e-5f);
#pragma unroll
    for (int j = 0; j < 4; ++j) {
        const int col = 4 * (lane + 64 * j);
        const float4 gg = *(const float4*)(g + col), bb = *(const float4*)(b + col);
        o[j].x = v[j].x * rstd * gg.x + bb.x; o[j].y = v[j].y * rstd * gg.y + bb.y; o[j].z = v[j].z * rstd * gg.z + bb.z; o[j].w = v[j].w * rstd * gg.w + bb.w;
        *(float4*)(outf + col) = o[j];
        if (outb) { uint2 w; w.x = pk2(o[j].x, o[j].y); w.y = pk2(o[j].z, o[j].w); *(uint2*)(outb + col) = w; }
    }
}
__device__ __forceinline__ int wave_sum_i(int v) {
#pragma unroll
    for (int o = 1; o < 64; o <<= 1) v += __shfl_xor(v, o);
    return v;
}

enum { K_PROLOGUE = 0, K_GEMM_BF, K_GEMM_RES, K_GEMM_SILU, K_GEMM_SOFTMAX, K_GEMM_YR, K_LN, K_L0_PREP, K_L0_SCAN, K_L0_COMB, K_L0_FIN, K_L1_PREP, K_L1_STATE, K_L1_SCAN, K_L1_FIN, K_MOE_ROUTE, K_MOE_ASSIGN, K_MOE_FINAL };
enum { F_KIND = 0, F_SYNC, F_MR, F_N, F_ROT, F_LDC, F_DYN, F_K, F_LDA, F_LDB, F_SCALE, F_PAD, F_A = 12, F_BT = 14, F_TILEE = 16, F_APN = 18, F_BTS = 20, F_BES = 22, F_O = 24, F_BASE = 26, F_OUTF = 28, F_LNG = 30, F_LNB = 32, STEP_DW = 40 };
enum StepId { S_PROLOGUE = 0, S_P0, S_KM0, S_VT0, S_KM1, S_VT1, S_L0_PREP, S_L0_SCAN, S_L0_COMB, S_L0_FIN, S_WOUT0, S_LN1_0, S_Q0, S_SM0, S_OX0, S_XO0, S_LN2_0, S_UP0, S_DOWN0, S_LN3_0,
              S_P1, S_L1_PREP, S_L1_STATE, S_L1_SCAN, S_L1_FIN, S_WOUT1, S_LN1_1, S_Q1, S_SM1, S_OX1, S_XO1, S_ROUTE, S_ASSIGN, S_UP_C0, S_DOWN_C0, S_UP_C1, S_DOWN_C1, S_FINAL, N_STEPS };
constexpr int STAB_OFF = PTAB_OFF + 576;
static_assert(STAB_OFF + 2 * N_STEPS * STEP_DW * 4 <= LDS_BYTES, "LDS control area");
struct StepW { LAS unsigned* d; const float* const* in; const unsigned char* out; const unsigned char* ws;
    __device__ __forceinline__ void i(int f, int v) const { d[f] = (unsigned)v; }
    __device__ __forceinline__ void f(int fi, float v) const { d[fi] = __float_as_uint(v); }
    __device__ __forceinline__ void p(int f, const void* v) const { const unsigned char* q = (const unsigned char*)v; unsigned id = 0xffffu, off = 0u;
        if (q >= ws && q < ws + WS_END) { id = 0u; off = (unsigned)(q - ws); }
        else if (q >= out && q < out + (size_t)M * D * 4) { id = 1u; off = (unsigned)(q - out); }
        else { for (int k = 0; k < 54; ++k) if ((const unsigned char*)in[k] == q) id = 2u + (unsigned)k; }
        d[f] = id; d[f + 1] = off; }
    __device__ __forceinline__ void u(int f, size_t q) const { d[f] = (unsigned)q; d[f + 1] = (unsigned)(q >> 32); } };
struct StepR { const LAS unsigned* d; Ctx cx;
    __device__ __forceinline__ int i(int f) const { return (int)__builtin_amdgcn_readfirstlane(d[f]); }
    __device__ __forceinline__ float f(int fi) const { return __uint_as_float(__builtin_amdgcn_readfirstlane(d[fi])); }
    __device__ __forceinline__ unsigned long long u(int f) const { const unsigned lo = __builtin_amdgcn_readfirstlane(d[f]), hi = __builtin_amdgcn_readfirstlane(d[f + 1]); return ((unsigned long long)hi << 32) | lo; }
    template <class T> __device__ __forceinline__ T* p(int f) const { const unsigned id = __builtin_amdgcn_readfirstlane(d[f]), off = __builtin_amdgcn_readfirstlane(d[f + 1]);
        if (id == 0xffffu) return nullptr;
        const unsigned char* b = id == 0u ? cx.ws : (id == 1u ? (const unsigned char*)cx.out : (const unsigned char*)cx.in[(int)id - 2]);
        return (T*)(b + off); } };
__device__ __forceinline__ void build_step(int s, int rep, LAS unsigned* d, const float* const* in, float* out, unsigned char* ws) {
    float* XFA = (float*)(ws + WS_XFA); float* XFB = out; bf16* XB = (bf16*)(ws + WS_XB); bf16* P = (bf16*)(ws + WS_P); bf16* OMIX = (bf16*)(ws + WS_OMIX);
    bf16* Q = (bf16*)(ws + WS_P); bf16* PATT = (bf16*)(ws + WS_P + 32 * MiB); bf16* OX = (bf16*)(ws + WS_P + 64 * MiB); bf16* H = (bf16*)(ws + WS_P);
    bf16* MEMB = (bf16*)(ws + WS_MEMB);
    const StepW t{d, in, (const unsigned char*)out, ws};
    for (int k = 0; k < STEP_DW; ++k) d[k] = 0u;
    t.i(F_TILEE, 0xffff); t.i(F_PAD, rep); t.i(F_KIND, K_GEMM_BF); t.i(F_SYNC, 1); t.i(F_MR, M); t.i(F_N, 1024); t.i(F_LDC, 1024); t.f(F_SCALE, 1.f);
    t.p(F_A, XB); t.u(F_BTS, (size_t)256 * 1024 * 2); t.i(F_LDA, 1024); t.i(F_LDB, 1024); t.i(F_K, 1024);
    const int L = (s >= S_P1) ? 1 : 0;
    switch (s) {
        case S_PROLOGUE: t.i(F_KIND, K_PROLOGUE); break;
        case S_P0: t.p(F_BT, ws + W_IN0); t.i(F_N, NP0); t.p(F_O, P); t.i(F_LDC, NP0); t.i(F_SYNC, 0); break;
        case S_KM0: t.p(F_A, MEMB); t.p(F_BT, ws + W_XK0); t.i(F_MR, 256); t.p(F_O, ws + WS_KMEM0); t.i(F_SYNC, 0); t.i(F_ROT, 128); break;
        case S_VT0: t.p(F_A, ws + W_XV0); t.p(F_BT, MEMB); t.i(F_MR, 1024); t.i(F_N, 256); t.p(F_O, ws + WS_VT0); t.i(F_LDC, 256); t.i(F_SYNC, 0); t.i(F_ROT, 132); break;
        case S_KM1: t.p(F_A, MEMB); t.p(F_BT, ws + W_XK1); t.i(F_MR, 256); t.p(F_O, ws + WS_KMEM1); t.i(F_SYNC, 0); t.i(F_ROT, 136); break;
        case S_VT1: t.p(F_A, ws + W_XV1); t.p(F_BT, MEMB); t.i(F_MR, 1024); t.i(F_N, 256); t.p(F_O, ws + WS_VT1); t.i(F_LDC, 256); t.i(F_ROT, 140); break;
        case S_L0_PREP: t.i(F_KIND, K_L0_PREP); break;
        case S_L0_SCAN: t.i(F_KIND, K_L0_SCAN); break;
        case S_L0_COMB: t.i(F_KIND, K_L0_COMB); break;
        case S_L0_FIN: t.i(F_KIND, K_L0_FIN); break;
        case S_WOUT0: t.i(F_KIND, K_GEMM_RES); t.p(F_A, OMIX); t.p(F_BT, ws + W_OUT0); t.p(F_BASE, in[0]); t.p(F_OUTF, XFA); break;
        case S_LN1_0: t.i(F_KIND, K_LN); t.p(F_OUTF, XFA); t.p(F_LNG, in[18]); t.p(F_LNB, in[19]); break;
        case S_Q0: case S_Q1: t.p(F_BT, ws + (L ? W_XQ1 : W_XQ0)); t.p(F_O, Q); t.f(F_SCALE, 0.0625f); break;
        case S_SM0: case S_SM1: t.i(F_KIND, K_GEMM_SOFTMAX); t.p(F_A, Q); t.u(F_APN, 512); t.p(F_BT, ws + (L ? WS_KMEM1 : WS_KMEM0)); t.u(F_BTS, 512); t.i(F_K, 256); t.p(F_O, PATT); break;
        case S_OX0: case S_OX1: t.p(F_A, PATT); t.u(F_APN, 512); t.p(F_BT, ws + (L ? WS_VT1 : WS_VT0)); t.i(F_LDB, 256); t.u(F_BTS, (size_t)256 * 256 * 2); t.i(F_K, 256); t.p(F_O, OX); break;
        case S_XO0: t.i(F_KIND, K_GEMM_RES); t.p(F_A, OX); t.p(F_BT, ws + W_XO0); t.p(F_BASE, XFA); t.p(F_OUTF, XFB); break;
        case S_LN2_0: t.i(F_KIND, K_LN); t.p(F_OUTF, XFB); t.p(F_LNG, in[24]); t.p(F_LNB, in[25]); break;
        case S_UP0: t.i(F_KIND, K_GEMM_SILU); t.p(F_BT, ws + W_GU0); t.i(F_N, 5632); t.p(F_O, H); t.i(F_LDC, 2816); break;
        case S_DOWN0: t.i(F_KIND, K_GEMM_RES); t.p(F_A, H); t.i(F_LDA, 2816); t.i(F_K, 2816); t.p(F_BT, ws + W_D0); t.i(F_LDB, 2816); t.u(F_BTS, (size_t)256 * 2816 * 2); t.p(F_BASE, XFB); t.p(F_OUTF, XFA); break;
        case S_LN3_0: t.i(F_KIND, K_LN); t.p(F_OUTF, XFA); t.p(F_LNG, in[29]); t.p(F_LNB, in[30]); break;
        case S_P1: t.p(F_BT, ws + W_IN1); t.i(F_N, NP1); t.p(F_O, P); t.i(F_LDC, NP1); break;
        case S_L1_PREP: t.i(F_KIND, K_L1_PREP); break;
        case S_L1_STATE: t.i(F_KIND, K_L1_STATE); break;
        case S_L1_SCAN: t.i(F_KIND, K_L1_SCAN); break;
        case S_L1_FIN: t.i(F_KIND, K_L1_FIN); break;
        case S_WOUT1: t.i(F_KIND, K_GEMM_RES); t.p(F_A, OMIX); t.i(F_LDA, 1536); t.i(F_K, 1536); t.p(F_BT, ws + W_OUT1); t.i(F_LDB, 1536); t.u(F_BTS, (size_t)256 * 1536 * 2); t.p(F_BASE, XFA); t.p(F_OUTF, XFB); break;
        case S_LN1_1: t.i(F_KIND, K_LN); t.p(F_OUTF, XFB); t.p(F_LNG, in[39]); t.p(F_LNB, in[40]); break;
        case S_XO1: t.i(F_KIND, K_GEMM_RES); t.p(F_A, OX); t.p(F_BT, ws + W_XO1); t.p(F_BASE, XFB); t.p(F_OUTF, XFA); break;
        case S_ROUTE: t.i(F_KIND, K_MOE_ROUTE); t.p(F_OUTF, XFA); t.p(F_LNG, in[45]); t.p(F_LNB, in[46]); break;
        case S_ASSIGN: t.i(F_KIND, K_MOE_ASSIGN); break;
        case S_UP_C0: case S_UP_C1: t.i(F_KIND, K_GEMM_SILU); t.i(F_DYN, s == S_UP_C0 ? 1 : 2); t.p(F_TILEE, ws + WS_RT + RT_TILEE); t.p(F_A, ws + WS_XG); t.p(F_BT, ws + W_EGU); t.u(F_BES, EGU_STEP); t.i(F_N, 5632); t.p(F_O, ws + WS_HM); t.i(F_LDC, 2816); break;
        case S_DOWN_C0: case S_DOWN_C1: t.i(F_KIND, K_GEMM_YR); t.i(F_DYN, s == S_DOWN_C0 ? 1 : 2); t.p(F_TILEE, ws + WS_RT + RT_TILEE); t.p(F_A, ws + WS_HM); t.i(F_LDA, 2816); t.i(F_K, 2816); t.p(F_BT, ws + W_ED); t.i(F_LDB, 2816);
            t.u(F_BTS, (size_t)256 * 2816 * 2); t.u(F_BES, ED_STEP); t.p(F_O, ws + WS_YR); break;
        default: t.i(F_KIND, K_MOE_FINAL); break;
    }
}
struct GemmSetup { pg8::Gemm g; int Mr, N, rot, row_off; };
__device__ __forceinline__ GemmSetup load_gemm(const StepR& r, const unsigned char* ws) {
    GemmSetup q; q.g.A = r.p<const bf16>(F_A); q.g.Bt = r.p<const bf16>(F_BT); q.g.tile_e = r.p<const int>(F_TILEE); q.g.a_pn_step = r.u(F_APN); q.g.b_tstep = r.u(F_BTS); q.g.b_estep = r.u(F_BES);
    q.g.lda = r.i(F_LDA); q.g.ldb = r.i(F_LDB); q.g.K = r.i(F_K); q.g.pad = 0; q.Mr = r.i(F_MR); q.N = r.i(F_N); q.rot = r.i(F_ROT); q.row_off = 0;
    const int dyn = r.i(F_DYN);
    if (dyn) {
        const int ntl = __builtin_amdgcn_readfirstlane(((const int*)(ws + WS_RT + RT_META))[16]) >> 8, T0 = (ntl + 1) >> 1, toff = (dyn == 2) ? T0 : 0, nt = (dyn == 2) ? ntl - T0 : T0;
        q.Mr = nt * 256; q.row_off = toff * 256; q.g.tile_e += toff;
        if (q.g.lda == 1024) q.g.A += (size_t)toff * 256 * 1024;
    }
    return q;
}

__global__ void __launch_bounds__(NWAVES * 64, 2) mega(MArgs args) {
    extern __shared__ __attribute__((aligned(16))) unsigned char lds_raw[];
    LAS unsigned char* lds = (LAS unsigned char*)lds_raw;
    volatile LAS unsigned* MISC = (volatile LAS unsigned*)(lds + MISC_OFF);
    const int tid = threadIdx.x, lane = tid & 63, wave = __builtin_amdgcn_readfirstlane(tid >> 6);
    const int G = gridDim.x; const int bx = blockIdx.x;
    const int vcu = (G % 8 == 0) ? (bx % 8) * (G / 8) + bx / 8 : bx;
    for (int u = tid; u < (LDS_BYTES - LDSCTL_OFF) / 4; u += NWAVES * 64) ((LAS unsigned*)(lds + LDSCTL_OFF))[u] = 0u;
    __syncthreads();
    unsigned* ctl = (unsigned*)(args.ws + WS_CTL);
    XcdBarrier bar = xcd_barrier_post(ctl + CW_BAR + args.li * XCD_BAR_WORDS, MISC + 8);
    const int gw = vcu * NWAVES + wave, NGW = G * NWAVES;
    if (tid == 64) { int k = 0;
#pragma unroll 1
        for (int sid = 0; sid < N_STEPS; ++sid) { const int reps = 1 + (int)((DUP_MASK >> sid) & 1ull);
            for (int r = 0; r < reps; ++r) { build_step(sid, r, (LAS unsigned*)(lds + STAB_OFF) + k * STEP_DW, args.in, args.out, args.ws); ++k; } }
        MISC[12] = (unsigned)k; }
    __syncthreads();
    const int ph_hi = (int)__builtin_amdgcn_readfirstlane(MISC[12]);

    for (int s = 0; s < ph_hi; ++s) {
        int z = 0; asm volatile("" : "+s"(z));
        Ctx cx; cx.in.t = args.in; cx.in.z = z; cx.out = args.out + z; cx.ws = args.ws + z;
        unsigned char* const ws = cx.ws;
        const StepR st{(const LAS unsigned*)(lds + STAB_OFF) + s * STEP_DW, cx};
        const int kind = st.i(F_KIND);
        int tl = tid; asm volatile("" : "+v"(tl));
        const int ln = tl & 63;
        const int gt = (vcu * NWAVES + wave) * 64 + ln, GT = NGW * 64;
        switch (kind) {
            case K_PROLOGUE: {
                cvt_jobs(0, 14, cx, (LAS float*)(lds + wave * 16384), gw, NGW, ln);
                const float4* x4 = (const float4*)cx.in[0]; uint2* o2 = (uint2*)(ws + WS_XB);
                for (size_t i = (size_t)gw * 64 + ln; i < (size_t)M * D / 4; i += (size_t)NGW * 64) { const float4 v = x4[i]; uint2 w; w.x = pk2(v.x, v.y); w.y = pk2(v.z, v.w); o2[i] = w; }
                for (int idx = gt; idx < 8 * 32 * 64 * 8; idx += GT) rwkv_wlr_build(idx, cx.in[8], cx.in[10], cx.in[11], (bf16*)(ws + WS_WLR));
                const float4* m4 = (const float4*)cx.in[1]; uint2* mo = (uint2*)(ws + WS_MEMB);
                for (size_t i = (size_t)gw * 64 + ln; i < (size_t)256 * D / 4; i += (size_t)NGW * 64) { const float4 v = m4[i]; uint2 w; w.x = pk2(v.x, v.y); w.y = pk2(v.z, v.w); mo[i] = w; }
            } break;
            case K_GEMM_BF: { const GemmSetup q = load_gemm(st, ws); pg8::StaticOrder S; S.init(q.Mr, q.N, G, (bx + G - q.rot) % G); pg8::EpBf E{st.p<bf16>(F_O), st.i(F_LDC), st.f(F_SCALE)};
                pg8::gemm_phase<pg8::EpBf, pg8::StaticOrder, true, true>(lds, q.g, S, E, tl); } break;
            case K_GEMM_RES: { const GemmSetup q = load_gemm(st, ws); pg8::StaticOrder S; S.init(q.Mr, q.N, G, bx); pg8::EpRes E{st.p<const float>(F_BASE), st.p<float>(F_OUTF)};
                pg8::gemm_phase<pg8::EpRes, pg8::StaticOrder, true, true>(lds, q.g, S, E, tl); } break;
            case K_GEMM_SILU: { const GemmSetup q = load_gemm(st, ws); pg8::StaticOrder S; S.init(q.Mr, q.N, G, bx); pg8::EpSilu E{st.p<bf16>(F_O), st.i(F_LDC), 0};
                pg8::gemm_phase<pg8::EpSilu, pg8::StaticOrder, true, true>(lds, q.g, S, E, tl); } break;
            case K_GEMM_SOFTMAX: { const GemmSetup q = load_gemm(st, ws); pg8::StaticOrder S; S.init(q.Mr, q.N, G, bx); pg8::EpSoftmax E{st.p<bf16>(F_O), st.i(F_LDC), 0};
                pg8::gemm_phase<pg8::EpSoftmax, pg8::StaticOrder, false, true>(lds, q.g, S, E, tl); } break;
            case K_GEMM_YR: { const GemmSetup q = load_gemm(st, ws); pg8::StaticOrder S; S.init(q.Mr, q.N, G, bx);
                pg8::EpYR E{st.p<bf16>(F_O), (const int*)(ws + WS_RT + RT_ROWTOK) + q.row_off, q.g.tile_e, (const int*)(ws + WS_RT + RT_META), q.row_off, 0};
                pg8::gemm_phase<pg8::EpYR, pg8::StaticOrder, true, true>(lds, q.g, S, E, tl); } break;
            case K_LN: {
                bf16* XB = (bf16*)(ws + WS_XB); float4 o[4];
                float* xf = st.p<float>(F_OUTF); const float* lg = st.p<const float>(F_LNG); const float* lb = st.p<const float>(F_LNB);
                for (int r = gw; r < M; r += NGW) ln_row(xf + (size_t)r * D, xf + (size_t)r * D, XB + (size_t)r * D, lg, lb, ln, o);
            } break;
            case K_L0_PREP: {
                const bf16* P = (const bf16*)(ws + WS_P);
                for (int it = bx; it < 1024; it += G) gla_state_item(it, tl, lds, P, cx.in[3], cx.in[4], (float*)cx.out, (float*)(ws + WS_CTL + 128 * 1024));
                float* VEC = (float*)(ws + WS_SCR); bf16* Gt = (bf16*)(ws + WS_XB + 16 * MiB); float* BON = (float*)(ws + WS_CTL + 512 * 1024);
                for (int grp = bx; grp < M / 16; grp += G) rwkv_prep_group(grp * 16, tl, lds, (const bf16*)(ws + WS_WLR), cx.in[7], cx.in[9], cx.in[12], cx.in[13], cx.in[14], P, cx.in[6], VEC, Gt, BON);
            } break;
            case K_L0_SCAN: {
                const bf16* P = (const bf16*)(ws + WS_P);
                if (wave < 4) rwkv_scan_half<false>(vcu * 4 + wave, ln, (LAS float*)(lds + wave * 12288), P, cx.in[6], (const float*)(ws + WS_SCR), (float*)(ws + WS_XFA), (float*)cx.out + (size_t)8 * 1024 * 1024);
                else { rwkv_scan_half<true>(vcu * 4 + (wave - 4), ln, (LAS float*)(lds + wave * 12288), P, cx.in[6], (const float*)(ws + WS_SCR), (float*)(ws + WS_XFA + 32 * MiB), (float*)cx.out + (size_t)12 * 1024 * 1024);
                    if (vcu < 128 && st.i(F_PAD) == 0) gla_state_scan((vcu * 4 + (wave - 4)) * 64 + ln, (float*)cx.out, (const float*)(ws + WS_CTL + 128 * 1024)); }
            } break;
            case K_L0_COMB: {
                if (vcu < 64) { if (st.i(F_PAD) == 0) rwkv_combine_row(vcu * 8 + wave, ln, (float*)cx.out + (size_t)8 * 1024 * 1024, (const float*)cx.out + (size_t)12 * 1024 * 1024); }
                else for (int it = vcu - 64; it < 1024; it += G - 64) gla_out_item(it, tl, lds, (const bf16*)(ws + WS_P), cx.in[3], cx.in[4], (const float*)cx.out, cx.in[5], (bf16*)(ws + WS_OMIX));
            } break;
            case K_L0_FIN: {
                const bf16* P = (const bf16*)(ws + WS_P); bf16* OMIX = (bf16*)(ws + WS_OMIX);
                for (int it = gw; it < RW_J * 64; it += NGW) rwkv_fin_item(it, ln, P, cx.in[6], (const float*)(ws + WS_XFA), (const float*)(ws + WS_XFA + 32 * MiB), (const float*)cx.out + (size_t)8 * 1024 * 1024,
                                                                              (const bf16*)(ws + WS_XB + 16 * MiB), (const float*)(ws + WS_CTL + 512 * 1024), cx.in[15], cx.in[16], OMIX);
            } break;
            case K_L1_PREP: {
                const bf16* P = (const bf16*)(ws + WS_P);
                bf16* XBC = (bf16*)(ws + WS_SCR); float* DT = (float*)(ws + WS_SCR + 48 * MiB); float* AA = (float*)(ws + WS_SCR + 49 * MiB); float* KM = (float*)(ws + WS_SCR + 50 * MiB);
                for (int idx = gt; idx < M * 192; idx += GT) ssd_prep_oct(idx, P, cx.in[32], cx.in[33], XBC);
                for (int idx = gt; idx < M * 16; idx += GT) ssd_dt_item2(idx, P, cx.in[34], cx.in[35], DT, AA);
                for (int idx = gt; idx < 8 * 64 * 64; idx += GT) moba_kmean_item(idx, P, KM);
            } break;
            case K_L1_STATE: {
                if (bx < 256) ssd_state_item(bx, tl, lds, (const bf16*)(ws + WS_SCR), (const float*)(ws + WS_SCR + 48 * MiB), (const float*)(ws + WS_SCR + 49 * MiB), (float*)cx.out, (float*)(ws + WS_SCR + 51 * MiB));
                if (st.i(F_PAD) == 0) for (int it = gw; it < 2048; it += NGW) moba_gate_item(it, ln, (const bf16*)(ws + WS_P), (const float*)(ws + WS_SCR + 50 * MiB), (int*)(ws + WS_CTL + 32768), (int*)(ws + WS_XB));
            } break;
            case K_L1_SCAN: {
                if (st.i(F_PAD) == 0) ssd_state_scan(gt, (float*)cx.out, (const float*)(ws + WS_SCR + 51 * MiB));
                moba_attn_phase(bx, G, tl, lds, (const bf16*)(ws + WS_P), (const int*)(ws + WS_CTL + 32768), (const int*)(ws + WS_XB), (float*)(ws + WS_SCR + 54 * MiB), (bf16*)(ws + WS_SCR + 58 * MiB));
            } break;
            case K_L1_FIN: {
                if (bx < 256) ssd_out_item(bx, tl, lds, (const bf16*)(ws + WS_P), (const bf16*)(ws + WS_SCR), (const float*)(ws + WS_SCR + 48 * MiB), (const float*)(ws + WS_SCR + 49 * MiB), (const float*)cx.out,
                                           cx.in[36], cx.in[37], (bf16*)(ws + WS_OMIX));
                for (int idx = gt; idx < M * 64; idx += GT) moba_merge_item(idx, (const float*)(ws + WS_SCR + 54 * MiB), (const bf16*)(ws + WS_SCR + 58 * MiB), (bf16*)(ws + WS_OMIX));
            } break;
            case K_MOE_ROUTE: {
                if (st.i(F_PAD) == 0) {
                volatile LAS int* cnt = (volatile LAS int*)(MISC + 16);
                if (tl < 8) cnt[tl] = 0;
                __syncthreads();
                bf16* XB = (bf16*)(ws + WS_XB); int* TOPE = (int*)(ws + WS_RT + RT_TOPE); float* GATE = (float*)(ws + WS_RT + RT_GATE);
                const float* wr = cx.in[47]; const float* br = cx.in[48]; float* xf = st.p<float>(F_OUTF); const float* lg = st.p<const float>(F_LNG); const float* lb = st.p<const float>(F_LNB);
                for (int k = 0; k < 8; ++k) {
                    const int r = vcu * 64 + wave * 8 + k; float4 o[4];
                    ln_row(xf + (size_t)r * D, xf + (size_t)r * D, XB + (size_t)r * D, lg, lb, ln, o);
                    float acc[8];
#pragma unroll
                    for (int e = 0; e < 8; ++e) acc[e] = 0.f;
#pragma unroll
                    for (int j = 0; j < 4; ++j) { const int col = 4 * (ln + 64 * j); const float xs[4] = {o[j].x, o[j].y, o[j].z, o[j].w};
#pragma unroll
                        for (int u = 0; u < 4; ++u) { const float4 w0 = *(const float4*)(wr + (size_t)(col + u) * 8), w1 = *(const float4*)(wr + (size_t)(col + u) * 8 + 4);
                            acc[0] += xs[u] * w0.x; acc[1] += xs[u] * w0.y; acc[2] += xs[u] * w0.z; acc[3] += xs[u] * w0.w; acc[4] += xs[u] * w1.x; acc[5] += xs[u] * w1.y; acc[6] += xs[u] * w1.z; acc[7] += xs[u] * w1.w; } }
#pragma unroll
                    for (int e = 0; e < 8; ++e) acc[e] = wave_sum(acc[e]) + br[e];
                    int e0 = 0; float l0 = acc[0];
#pragma unroll
                    for (int e = 1; e < 8; ++e) if (acc[e] > l0) { l0 = acc[e]; e0 = e; }
                    int e1 = -1; float l1 = -INFINITY;
#pragma unroll
                    for (int e = 0; e < 8; ++e) if (e != e0 && acc[e] > l1) { l1 = acc[e]; e1 = e; }
                    const float ex = __expf(l1 - l0), g0 = 1.f / (1.f + ex);
                    if (ln == 0) { TOPE[2 * r] = e0; TOPE[2 * r + 1] = e1; GATE[2 * r] = g0; GATE[2 * r + 1] = ex * g0;
                        __hip_atomic_fetch_add((int*)(cnt + e0), 1, __ATOMIC_RELAXED, __HIP_MEMORY_SCOPE_WORKGROUP); __hip_atomic_fetch_add((int*)(cnt + e1), 1, __ATOMIC_RELAXED, __HIP_MEMORY_SCOPE_WORKGROUP); }
                }
                __syncthreads();
                if (tl < 8) ((int*)(ws + WS_RT + RT_BC))[vcu * 8 + tl] = cnt[tl];
                }
                cvt_jobs(14, 30, cx, (LAS float*)(lds + wave * 16384), gw, NGW, ln);
            } break;
            case K_MOE_ASSIGN: {
                LAS int* sm = (LAS int*)lds;
                const int* BC = (const int*)(ws + WS_RT + RT_BC); const int* TOPE = (const int*)(ws + WS_RT + RT_TOPE);
                int* ROW_TOK = (int*)(ws + WS_RT + RT_ROWTOK); int* SLOT_ROW = (int*)(ws + WS_RT + RT_SLOTROW); int* TILE_E = (int*)(ws + WS_RT + RT_TILEE); int* META = (int*)(ws + WS_RT + RT_META);
                const bf16* XB = (const bf16*)(ws + WS_XB); bf16* XG = (bf16*)(ws + WS_XG);
                {   const int e = wave; int tot = 0, off = 0;
                    for (int b = ln; b < 256; b += 64) { const int c = BC[b * 8 + e]; tot += c; if (b < vcu) off += c; }
                    tot = wave_sum_i(tot); off = wave_sum_i(off);
                    if (ln == 0) { sm[e] = tot; sm[8 + e] = off; } }
                __syncthreads();
                if (tl == 0) { int p = 0, us = 0; for (int e = 0; e < 8; ++e) { sm[16 + e] = p; sm[32 + e] = us; p += (sm[e] + 255) / 256 * 256; us += sm[e]; } sm[24] = p; }
                __syncthreads();
                if (tl < 128) sm[64 + tl] = TOPE[vcu * 128 + tl];
                __syncthreads();
                if (tl < 128) { const int e = sm[64 + tl]; int rank = 0; for (int i = 0; i < tl; ++i) rank += (sm[64 + i] == e) ? 1 : 0;
                    const int pos = sm[16 + e] + sm[8 + e] + rank; SLOT_ROW[vcu * 128 + tl] = pos; ROW_TOK[pos] = vcu * 64 + (tl >> 1); sm[192 + tl] = pos; }
                __syncthreads();
                for (int i = wave; i < 128; i += 8) { const int pos = sm[192 + i], tok = vcu * 64 + (i >> 1);
                    const uint4* src = (const uint4*)(XB + (size_t)tok * D); uint4* dst = (uint4*)(XG + (size_t)pos * D); dst[ln] = src[ln]; dst[ln + 64] = src[ln + 64]; }
                for (int k = gw; k < 2048; k += NGW) { const int e = k >> 8, j = k & 255, row = sm[16 + e] + sm[e] + j;
                    if (row < sm[17 + e]) { if (ln == 0) ROW_TOK[row] = -1; uint4* dst = (uint4*)(XG + (size_t)row * D); const uint4 zz = {0u, 0u, 0u, 0u}; dst[ln] = zz; dst[ln + 64] = zz; } }
                if (bx == 0) {
                    if (tl < 8) { META[tl] = sm[16 + tl]; META[8 + tl] = sm[16 + tl] - sm[32 + tl]; }
                    if (tl == 8) META[16] = sm[24];
                    if (tl < RMAX / 256) { const int r = tl * 256; int e = 0; for (int x = 1; x < 8; ++x) if (r >= sm[16 + x]) e = x; TILE_E[tl] = e; }
                }
                __syncthreads();
            } break;
            default: {
                const float* XF = (const float*)(ws + WS_XFA); const bf16* YR = (const bf16*)(ws + WS_YR);
                const int* TOPE = (const int*)(ws + WS_RT + RT_TOPE); const float* GATE = (const float*)(ws + WS_RT + RT_GATE); const int* SLOT_ROW = (const int*)(ws + WS_RT + RT_SLOTROW); const int* META = (const int*)(ws + WS_RT + RT_META);
                const float* g = cx.in[52]; const float* b = cx.in[53];
                for (int t = gw; t < M; t += NGW) {
                    const int e0 = TOPE[2 * t], e1 = TOPE[2 * t + 1]; const float g0 = GATE[2 * t], g1 = GATE[2 * t + 1];
                    const bf16* y0 = YR + (size_t)(SLOT_ROW[2 * t] - META[8 + e0]) * D; const bf16* y1 = YR + (size_t)(SLOT_ROW[2 * t + 1] - META[8 + e1]) * D;
                    float4 v[4]; float sum = 0.f;
#pragma unroll
                    for (int j = 0; j < 4; ++j) { const int col = 4 * (ln + 64 * j); const float4 x = *(const float4*)(XF + (size_t)t * D + col);
                        const uint2 a0 = *(const uint2*)(y0 + col), a1 = *(const uint2*)(y1 + col);
                        v[j].x = ALPHA * x.x + g0 * __uint_as_float(a0.x << 16) + g1 * __uint_as_float(a1.x << 16);
                        v[j].y = ALPHA * x.y + g0 * __uint_as_float(a0.x & 0xffff0000u) + g1 * __uint_as_float(a1.x & 0xffff0000u);
                        v[j].z = ALPHA * x.z + g0 * __uint_as_float(a0.y << 16) + g1 * __uint_as_float(a1.y << 16);
                        v[j].w = ALPHA * x.w + g0 * __uint_as_float(a0.y & 0xffff0000u) + g1 * __uint_as_float(a1.y & 0xffff0000u);
                        sum += (v[j].x + v[j].y) + (v[j].z + v[j].w); }
                    const float mean = wave_sum(sum) * (1.f / D); float q = 0.f;
#pragma unroll
                    for (int j = 0; j < 4; ++j) { v[j].x -= mean; v[j].y -= mean; v[j].z -= mean; v[j].w -= mean; q += (v[j].x * v[j].x + v[j].y * v[j].y) + (v[j].z * v[j].z + v[j].w * v[j].w); }
                    const float rstd = 1.f / sqrtf(wave_sum(q) * (1.f / D) + 1e-5f);
#pragma unroll
                    for (int j = 0; j < 4; ++j) { const int col = 4 * (ln + 64 * j); const float4 gg = *(const float4*)(g + col), bb = *(const float4*)(b + col);
                        float4 o; o.x = v[j].x * rstd * gg.x + bb.x; o.y = v[j].y * rstd * gg.y + bb.y; o.z = v[j].z * rstd * gg.z + bb.z; o.w = v[j].w * rstd * gg.w + bb.w;
                        *(float4*)(cx.out + (size_t)t * D + col) = o; }
                }
            } break;
        }
        if (st.i(F_SYNC) && s + 1 < ph_hi) xcd_barrier(bar);
    }
}
}

extern "C" void kernel_launch(void* const* d_in, const int* in_sizes, int n_in, void* d_out, int out_size, void* d_ws, size_t ws_size, hipStream_t stream) {
    if (n_in != 54 || ws_size < WS_END) { fprintf(stderr, "kernel_launch: unexpected n_in %d / ws_size %zu (need %zu)\n", n_in, ws_size, (size_t)WS_END); return; }
    static int grid = 0;
    if (grid == 0) {
        int dev = 0, cus = 0;
        if (hipGetDevice(&dev) != hipSuccess || hipDeviceGetAttribute(&cus, hipDeviceAttributeMultiprocessorCount, dev) != hipSuccess) { fprintf(stderr, "kernel_launch: device query failed\n"); grid = -1; return; }
        if (hipFuncSetAttribute((const void*)mega, hipFuncAttributeMaxDynamicSharedMemorySize, LDS_BYTES) != hipSuccess) { fprintf(stderr, "kernel_launch: hipFuncSetAttribute failed\n"); grid = -1; return; }
        (void)hipGetLastError();
        grid = cus;
        if (grid != 256) fprintf(stderr, "kernel_launch: %d CUs (expected 256)\n", grid);
    }
    if (grid < 0) return;
    (void)hipMemsetAsync((unsigned char*)d_ws + WS_CTL, 0, 64 * 1024, stream);
    MArgs a{};
    for (int i = 0; i < 54; ++i) a.in[i] = (const float*)d_in[i];
    a.out = (float*)d_out; a.ws = (unsigned char*)d_ws;
    a.ph_lo = 0; a.ph_hi = N_STEPS; a.li = 0;
    hipLaunchKernelGGL(mega, dim3(grid), dim3(NWAVES * 64), LDS_BYTES, stream, a);
}
```
